# Optimizing an MI355X kernel written in HIP

```python
import math
import jax
import jax.numpy as jnp
from jax import lax
import numpy as np

D_MODEL = 1024
BATCH = 4
SEQ = 4096
DEPTH = 2

N_MIXERS = 2
N_LAYERS_A = (DEPTH + 1) // 2
N_LAYERS_B = DEPTH // 2
PLE_DIM = 256
NORM_EPS = 1e-6

SSD_D_INNER = 2 * D_MODEL
SSD_HEADDIM = 64
SSD_HEADS = SSD_D_INNER // SSD_HEADDIM
SSD_GROUPS = 4
SSD_HPG = SSD_HEADS // SSD_GROUPS
SSD_STATE = 128
SSD_CONV = 5
SSD_CHUNK = 128
SSD_BC_DIM = SSD_GROUPS * SSD_STATE
SSD_CONV_DIM = SSD_D_INNER + 2 * SSD_BC_DIM
SSD_IN_DIM = SSD_D_INNER + SSD_CONV_DIM + 2 * SSD_HEADS
SSD_DT_MIN = 1e-3
SSD_DT_MAX = 1e-1

S5_GROUP = 16
S5_GROUPS = D_MODEL // S5_GROUP
S5_STATE = 64
S5_STEP_MIN = 1e-3
S5_STEP_MAX = 1e-1

FFN_HIDDEN = 2816
FFN_CONV = 3

kernel_name = 'bidir_hybrid_ssd_s5_convffn'


def rmsnorm(x, w):
    xf = x.astype(jnp.float32)
    xf = xf * lax.rsqrt(jnp.mean(xf * xf, axis=-1, keepdims=True) + NORM_EPS)
    return (xf * w.astype(jnp.float32)).astype(x.dtype)


def dwconv_centred(u, w, b):
    k = w.shape[0]
    half = k // 2
    seq = u.shape[1]
    upad = jnp.pad(u, ((0, 0), (half, half), (0, 0)))
    out = b + upad[:, 0:seq] * w[0]
    for t in range(1, k):
        out = out + upad[:, t:t + seq] * w[t]
    return out


def segsum(a):
    cs = jnp.cumsum(a, axis=-1)
    t = a.shape[-1]
    diff = cs[..., :, None] - cs[..., None, :]
    mask = jnp.tril(jnp.ones((t, t), dtype=bool))
    return jnp.where(mask, diff, -jnp.inf)


def ssd_chunked_scan(xh, dt, a, bm, cm):
    bsz, seq = xh.shape[:2]
    nc = seq // SSD_CHUNK
    xd = (xh * dt[..., None]).reshape(bsz, nc, SSD_CHUNK, SSD_GROUPS, SSD_HPG, SSD_HEADDIM)
    ad = (dt * a).reshape(bsz, nc, SSD_CHUNK, SSD_GROUPS, SSD_HPG).transpose(0, 3, 4, 1, 2)
    bc = bm.reshape(bsz, nc, SSD_CHUNK, SSD_GROUPS, SSD_STATE)
    cc = cm.reshape(bsz, nc, SSD_CHUNK, SSD_GROUPS, SSD_STATE)
    a_cs = jnp.cumsum(ad, axis=-1)
    decay_in = jnp.exp(segsum(ad))
    cb = jnp.einsum('bclgn,bcsgn->bgcls', cc, bc)
    y_diag = jnp.einsum('bgcls,bgrcls,bcsgrp->bclgrp', cb, decay_in, xd)
    decay_to_end = jnp.exp(a_cs[..., -1:] - a_cs)
    chunk_states = jnp.einsum('bclgn,bgrcl,bclgrp->bcgrpn', bc, decay_to_end, xd)
    chunk_states = jnp.concatenate([jnp.zeros_like(chunk_states[:, :1]), chunk_states], axis=1)
    chunk_a = jnp.pad(a_cs[..., -1], ((0, 0), (0, 0), (0, 0), (1, 0)))
    decay_chunk = jnp.exp(segsum(chunk_a))
    carried = jnp.einsum('bgrzc,bcgrpn->bzgrpn', decay_chunk, chunk_states)[:, :-1]
    y_off = jnp.einsum('bclgn,bcgrpn,bgrcl->bclgrp', cc, carried, jnp.exp(a_cs))
    return (y_diag + y_off).reshape(bsz, seq, SSD_GROUPS, SSD_HPG, SSD_HEADDIM)


def _flip_seq(t):
    return jnp.flip(t, axis=1)


def ssd_mixer(u, w_in, conv_w, conv_b, dt_bias, a_log, d_skip, norm_w, w_out):
    bsz, seq, _ = u.shape
    proj = u @ w_in
    z = proj[..., :SSD_D_INNER]
    xbc = jax.nn.silu(dwconv_centred(proj[..., SSD_D_INNER:SSD_D_INNER + SSD_CONV_DIM], conv_w, conv_b))
    dt_raw = proj[..., SSD_D_INNER + SSD_CONV_DIM:].astype(jnp.float32)
    xh = xbc[..., :SSD_D_INNER].reshape(bsz, seq, SSD_GROUPS, SSD_HPG, SSD_HEADDIM)
    bm = xbc[..., SSD_D_INNER:SSD_D_INNER + SSD_BC_DIM].reshape(bsz, seq, SSD_GROUPS, SSD_STATE)
    cm = xbc[..., SSD_D_INNER + SSD_BC_DIM:].reshape(bsz, seq, SSD_GROUPS, SSD_STATE)
    dt = jax.nn.softplus(dt_raw + dt_bias.reshape(-1).astype(jnp.float32))
    dt = dt.reshape(bsz, seq, 2, SSD_GROUPS, SSD_HPG)
    a = -jnp.exp(a_log.astype(jnp.float32)).reshape(2, SSD_GROUPS, SSD_HPG)
    y_fwd = ssd_chunked_scan(xh, dt[:, :, 0], a[0], bm, cm)
    y_bwd = _flip_seq(ssd_chunked_scan(_flip_seq(xh), _flip_seq(dt[:, :, 1]), a[1], _flip_seq(bm), _flip_seq(cm)))
    y = y_fwd + y_bwd + xh * d_skip.reshape(SSD_GROUPS, SSD_HPG)[:, :, None]
    y = y.reshape(bsz, seq, SSD_D_INNER) * jax.nn.silu(z.astype(jnp.float32))
    yg = y.reshape(bsz, seq, SSD_GROUPS, SSD_D_INNER // SSD_GROUPS)
    yg = yg * lax.rsqrt(jnp.mean(yg * yg, axis=-1, keepdims=True) + NORM_EPS)
    y = yg.reshape(bsz, seq, SSD_D_INNER) * norm_w.astype(jnp.float32)
    return (y @ w_out).astype(u.dtype)


def _complex_linear_combine(e1, e2):
    a1r, a1i, b1r, b1i = e1
    a2r, a2i, b2r, b2i = e2
    return (a2r * a1r - a2i * a1i,
            a2r * a1i + a2i * a1r,
            a2r * b1r - a2i * b1i + b2r,
            a2r * b1i + a2i * b1r + b2i)


def s5_mixer(u, a_re, a_im, log_step, b_re, b_im, c_re, c_im, d_skip, w_glu, b_glu):
    bsz, seq, _ = u.shape
    uf = u.astype(jnp.float32)
    ug = uf.reshape(bsz, seq, S5_GROUPS, S5_GROUP)
    bu_re = jnp.einsum('blgh,gph->blgp', ug, b_re.astype(jnp.float32))
    bu_im = jnp.einsum('blgh,gph->blgp', ug, b_im.astype(jnp.float32))
    y_ssm = jnp.zeros((bsz, seq, S5_GROUPS, S5_GROUP), jnp.float32)
    for d in range(2):
        lr = a_re[d].astype(jnp.float32)
        li = a_im[d].astype(jnp.float32)
        step = jnp.exp(log_step[d].astype(jnp.float32))[:, None]
        mag = jnp.exp(lr * step)
        ang = li * step
        lb_re = mag * jnp.cos(ang)
        lb_im = mag * jnp.sin(ang)
        nr = lb_re - 1.0
        den = lr * lr + li * li
        q_re = (nr * lr + lb_im * li) / den
        q_im = (lb_im * lr - nr * li) / den
        drive_re = q_re * bu_re - q_im * bu_im
        drive_im = q_re * bu_im + q_im * bu_re
        dec_re = jnp.broadcast_to(lb_re, (1, seq, S5_GROUPS, S5_STATE))
        dec_im = jnp.broadcast_to(lb_im, (1, seq, S5_GROUPS, S5_STATE))
        _, _, st_re, st_im = lax.associative_scan(
            _complex_linear_combine, (dec_re, dec_im, drive_re, drive_im), axis=1, reverse=(d == 1))
        y_ssm = (y_ssm
                 + jnp.einsum('blgp,ghp->blgh', st_re, c_re[d].astype(jnp.float32))
                 - jnp.einsum('blgp,ghp->blgh', st_im, c_im[d].astype(jnp.float32)))
    y = y_ssm.reshape(bsz, seq, D_MODEL) + d_skip.astype(jnp.float32) * uf
    g = jax.nn.gelu(y)
    h = g @ w_glu + b_glu
    out = h[..., :D_MODEL] * jax.nn.sigmoid(h[..., D_MODEL:])
    return out.astype(u.dtype)


def conv_ffn(u, w_up, conv_w, conv_b, w_down):
    h = dwconv_centred(u @ w_up, conv_w, conv_b)
    gate = h[..., :FFN_HIDDEN]
    val = h[..., FFN_HIDDEN:]
    return ((jax.nn.silu(gate) * val) @ w_down).astype(u.dtype)


def per_layer_embed(h, p_i, norm_w, w_gate, w_proj):
    gate = jax.nn.sigmoid(rmsnorm(h, norm_w) @ w_gate)
    return ((p_i @ w_proj) * gate).astype(h.dtype)


def setup_inputs(seed: int = 0) -> dict:
    key = jax.random.key(seed)
    ks = iter(jax.random.split(key, 40))
    f32 = jnp.float32

    def nrm(shape, scale):
        return jax.random.normal(next(ks), shape, f32) * scale

    def gain(shape):
        return 1.0 + 0.02 * jax.random.normal(next(ks), shape, f32)

    x = nrm((BATCH, SEQ, D_MODEL), 1.0)
    p = nrm((DEPTH, BATCH, SEQ, PLE_DIM), 1.0)

    na, nb = N_LAYERS_A, N_LAYERS_B
    ssd_w_in = nrm((na, D_MODEL, SSD_IN_DIM), D_MODEL ** -0.5)
    ssd_conv_w = nrm((na, SSD_CONV, SSD_CONV_DIM), SSD_CONV ** -0.5)
    ssd_conv_b = nrm((na, SSD_CONV_DIM), 0.02)
    dt0 = jnp.exp(jax.random.uniform(next(ks), (na, 2, SSD_HEADS), f32,
                                     math.log(SSD_DT_MIN), math.log(SSD_DT_MAX)))
    ssd_dt_bias = dt0 + jnp.log(-jnp.expm1(-dt0))
    ssd_a_log = jnp.log(jax.random.uniform(next(ks), (na, 2, SSD_HEADS), f32, 1.0, 16.0))
    ssd_d = 1.0 + 0.1 * jax.random.normal(next(ks), (na, SSD_HEADS), f32)
    ssd_norm_w = gain((na, SSD_D_INNER))
    ssd_w_out = nrm((na, SSD_D_INNER, D_MODEL), SSD_D_INNER ** -0.5)

    s5_a_re = -0.5 + nrm((nb, 2, S5_GROUPS, S5_STATE), 0.01)
    s5_a_im = jnp.pi * jnp.arange(S5_STATE, dtype=f32) + nrm((nb, 2, S5_GROUPS, S5_STATE), 0.01)
    s5_log_step = jax.random.uniform(next(ks), (nb, 2, S5_GROUPS), f32,
                                     math.log(S5_STEP_MIN), math.log(S5_STEP_MAX))
    s5_b_re = nrm((nb, S5_GROUPS, S5_STATE, S5_GROUP), (2 * S5_GROUP) ** -0.5)
    s5_b_im = nrm((nb, S5_GROUPS, S5_STATE, S5_GROUP), (2 * S5_GROUP) ** -0.5)
    s5_c_re = nrm((nb, 2, S5_GROUPS, S5_GROUP, S5_STATE), 0.25)
    s5_c_im = nrm((nb, 2, S5_GROUPS, S5_GROUP, S5_STATE), 0.25)
    s5_d = 1.0 + 0.1 * jax.random.normal(next(ks), (nb, D_MODEL), f32)
    s5_w_glu = nrm((nb, D_MODEL, 2 * D_MODEL), D_MODEL ** -0.5)
    s5_b_glu = nrm((nb, 2 * D_MODEL), 0.02)

    mix_norm_w = gain((DEPTH, D_MODEL))
    ffn_norm_w = gain((DEPTH, D_MODEL))
    ffn_w_up = nrm((DEPTH, D_MODEL, 2 * FFN_HIDDEN), D_MODEL ** -0.5)
    ffn_conv_w = nrm((DEPTH, FFN_CONV, 2 * FFN_HIDDEN), FFN_CONV ** -0.5)
    ffn_conv_b = nrm((DEPTH, 2 * FFN_HIDDEN), 0.02)
    ffn_w_down = nrm((DEPTH, FFN_HIDDEN, D_MODEL), FFN_HIDDEN ** -0.5)

    ple_norm_w = gain((DEPTH, D_MODEL))
    ple_w_gate = nrm((DEPTH, D_MODEL, D_MODEL), D_MODEL ** -0.5)
    ple_w_proj = nrm((DEPTH, PLE_DIM, D_MODEL), PLE_DIM ** -0.5)
    final_norm_w = gain((D_MODEL,))

    return {
        'x': x, 'p': p,
        'ssd_w_in': ssd_w_in, 'ssd_conv_w': ssd_conv_w, 'ssd_conv_b': ssd_conv_b,
        'ssd_dt_bias': ssd_dt_bias, 'ssd_a_log': ssd_a_log, 'ssd_d': ssd_d,
        'ssd_norm_w': ssd_norm_w, 'ssd_w_out': ssd_w_out,
        's5_a_re': s5_a_re, 's5_a_im': s5_a_im, 's5_log_step': s5_log_step,
        's5_b_re': s5_b_re, 's5_b_im': s5_b_im, 's5_c_re': s5_c_re, 's5_c_im': s5_c_im,
        's5_d': s5_d, 's5_w_glu': s5_w_glu, 's5_b_glu': s5_b_glu,
        'mix_norm_w': mix_norm_w, 'ffn_norm_w': ffn_norm_w, 'ffn_w_up': ffn_w_up,
        'ffn_conv_w': ffn_conv_w, 'ffn_conv_b': ffn_conv_b, 'ffn_w_down': ffn_w_down,
        'ple_norm_w': ple_norm_w, 'ple_w_gate': ple_w_gate, 'ple_w_proj': ple_w_proj,
        'final_norm_w': final_norm_w,
    }


def reference(x, p,
              ssd_w_in, ssd_conv_w, ssd_conv_b, ssd_dt_bias, ssd_a_log, ssd_d, ssd_norm_w, ssd_w_out,
              s5_a_re, s5_a_im, s5_log_step, s5_b_re, s5_b_im, s5_c_re, s5_c_im, s5_d, s5_w_glu, s5_b_glu,
              mix_norm_w, ffn_norm_w, ffn_w_up, ffn_conv_w, ffn_conv_b, ffn_w_down,
              ple_norm_w, ple_w_gate, ple_w_proj,
              final_norm_w):
    h = x
    for i in range(DEPTH):
        u = rmsnorm(h, mix_norm_w[i])
        j = i // N_MIXERS
        if i % N_MIXERS == 0:
            mix = ssd_mixer(u, ssd_w_in[j], ssd_conv_w[j], ssd_conv_b[j], ssd_dt_bias[j],
                            ssd_a_log[j], ssd_d[j], ssd_norm_w[j], ssd_w_out[j])
        else:
            mix = s5_mixer(u, s5_a_re[j], s5_a_im[j], s5_log_step[j], s5_b_re[j], s5_b_im[j],
                           s5_c_re[j], s5_c_im[j], s5_d[j], s5_w_glu[j], s5_b_glu[j])
        h = h + mix
        h = h + conv_ffn(rmsnorm(h, ffn_norm_w[i]), ffn_w_up[i], ffn_conv_w[i], ffn_conv_b[i], ffn_w_down[i])
        h = h + per_layer_embed(h, p[i], ple_norm_w[i], ple_w_gate[i], ple_w_proj[i])
    return rmsnorm(h, final_norm_w)
```

```cpp
#include <hip/hip_runtime.h>
#include <hip/hip_cooperative_groups.h>
#include <cstdio>
namespace cg = cooperative_groups;

#ifndef COOP
#define COOP 1
#endif

typedef unsigned short bf16_t;
typedef float f32x4 __attribute__((ext_vector_type(4)));
typedef unsigned u32x4 __attribute__((ext_vector_type(4)));
typedef unsigned u32x2 __attribute__((ext_vector_type(2)));

constexpr int NT = 512;
constexpr int T_TOK = 16384, DM = 1024, SEQ = 4096, NB = 4;
constexpr int LDP = 3328;
constexpr int FH = 1408;
constexpr float EPS = 1e-6f;
constexpr size_t MiB = 1u << 20;
constexpr size_t OFF_W0 = 0;
constexpr size_t W_IN = OFF_W0, W_OUT = W_IN + (size_t)5376 * 1024 * 2, W_UP0 = W_OUT + 4 * MiB, W_DN0 = W_UP0 + 11 * MiB, W_GT0 = W_DN0 + (size_t)1024 * 2816 * 2, W_PP0 = W_GT0 + 2 * MiB;
constexpr size_t OFF_ABUF = 34 * MiB;
constexpr size_t OFF_R = 66 * MiB;
constexpr size_t OFF_G = 186 * MiB;
constexpr size_t OFF_W1 = 230 * MiB;
constexpr size_t W_GLU = OFF_W1, W_UP1 = W_GLU + 4 * MiB, W_DN1 = W_UP1 + 11 * MiB, W_GT1 = W_DN1 + (size_t)1024 * 2816 * 2, W_PP1 = W_GT1 + 2 * MiB;
constexpr size_t OFF_YF = 186 * MiB;
constexpr size_t OFF_SMALL = 253 * MiB;
constexpr size_t LDS_BYTES = 160 * 1024;

struct Params {
    const float *x, *p, *ssd_w_in, *ssd_conv_w, *ssd_conv_b, *ssd_dt_bias, *ssd_a_log, *ssd_d, *ssd_norm_w, *ssd_w_out;
    const float *s5_a_re, *s5_a_im, *s5_log_step, *s5_b_re, *s5_b_im, *s5_c_re, *s5_c_im, *s5_d, *s5_w_glu, *s5_b_glu;
    const float *mix_norm_w, *ffn_norm_w, *ffn_w_up, *ffn_conv_w, *ffn_conv_b, *ffn_w_down, *ple_norm_w, *ple_w_gate, *ple_w_proj, *final_norm_w;
    float* out; unsigned char* ws;
    int ph_lo, ph_hi;
};

__device__ __forceinline__ int otid() { int t = (int)__builtin_amdgcn_workitem_id_x(); asm volatile("" : "+v"(t)); return t & (NT - 1); }
__device__ __forceinline__ float bf2f(bf16_t b) { return __uint_as_float(((unsigned)b) << 16); }
typedef __bf16 bf16x2_t __attribute__((ext_vector_type(2)));
typedef float f32x2_t __attribute__((ext_vector_type(2)));
__device__ __forceinline__ unsigned hw_cvt_pk_bf16(float lo, float hi) { const f32x2_t v = {lo, hi}; union { bf16x2_t b; unsigned u; } r; r.b = __builtin_convertvector(v, bf16x2_t); return r.u; }
__device__ __forceinline__ bf16_t f2bf(float f) { return (bf16_t)(hw_cvt_pk_bf16(f, 0.f) & 0xffffu); }
__device__ __forceinline__ unsigned pack2(float lo, float hi) { return hw_cvt_pk_bf16(lo, hi); }
__device__ __forceinline__ float siluf(float v) { return v / (1.0f + __expf(-v)); }
__device__ __forceinline__ float sigmf(float v) { return 1.0f / (1.0f + __expf(-v)); }
__device__ __forceinline__ float wave_sum(float v) {
#pragma unroll
    for (int o = 32; o >= 1; o >>= 1) v += __shfl_xor(v, o);
    return v;
}

#define PG8_LAS __attribute__((address_space(3)))
typedef short bf16x8 __attribute__((ext_vector_type(8)));
namespace pg8 {
constexpr int BM = 256, BK = 64, HALF = 128, HTB = HALF * BK * 2, STAGE_BYTES = 8 * HTB, NXCD = 8, WGM = 8;
__device__ __forceinline__ int lds_byte(int r, int c) { const int st = (r >> 4) * 2 + (c >> 5), rr = r & 15, cc = c & 31, ob = rr * 64 + cc * 2; return st * 1024 + (ob ^ (((ob >> 9) & 1) << 5)); }
__device__ __forceinline__ void stage_rc(int b, int& R, int& C) { const int st = b / 1024, sb = b % 1024, swz = sb ^ (((sb >> 9) & 1) << 5); R = (st >> 1) * 16 + swz / 64; C = (st & 1) * 32 + (swz % 64) / 2; }
__device__ __forceinline__ int perm32(int rho) { const int n = rho >> 4, i = rho & 15; return 8 * (i >> 2) + 4 * n + (i & 3); }
struct Unit { int pm, pn; };
struct StaticOrder {
    int nM, nN, nwg, G, c;
    __device__ void init(int M, int N, int G_, int c_) { nM = M / BM; nN = N / BM; nwg = nM * nN; G = G_; c = c_; }
    __device__ bool next(int i, Unit& u) const {
        const long L = (long)i * G + c; if (L >= nwg) return false;
        int wgid = (int)L; { const int q = nwg / NXCD, r = nwg % NXCD, xcd = wgid % NXCD, off = wgid / NXCD; wgid = (xcd < r ? xcd * (q + 1) : r * (q + 1) + (xcd - r) * q) + off; }
        const int nig = WGM * nN, gid = wgid / nig, fm = gid * WGM, gsz = (nM - fm) < WGM ? (nM - fm) : WGM;
        u.pm = fm + ((wgid % nig) % gsz); u.pn = (wgid % nig) / gsz; return true;
    }
};
__device__ __forceinline__ unsigned cvt_pk_bf16(float lo, float hi) { return hw_cvt_pk_bf16(lo, hi); }
}
__device__ __forceinline__ float fsig(float v) { return __builtin_amdgcn_rcpf(1.0f + __expf(-v)); }
__device__ __forceinline__ void unpack8(const u32x4 v, float (&f)[8]) {
#pragma unroll
    for (int j = 0; j < 4; ++j) { f[2 * j] = __uint_as_float(v[j] << 16); f[2 * j + 1] = __uint_as_float(v[j] & 0xffff0000u); }
}
__device__ __forceinline__ f32x4 bf4lo(unsigned a, unsigned b) { return (f32x4){__uint_as_float(a << 16), __uint_as_float(a & 0xffff0000u), __uint_as_float(b << 16), __uint_as_float(b & 0xffff0000u)}; }

struct WDesc { const float* W; bf16_t* Wt; int K, Nsrc, Ndst, mode, H, ntiles; };
__device__ __forceinline__ void cvt_tile(const WDesc& d, int tile, float* lds) {
    const int tid = threadIdx.x, nnt = d.Ndst / 64;
    const int n0 = (tile % nnt) * 64, k0 = (tile / nnt) * 64;
    int src0;
    if (d.mode == 0) src0 = (n0 < d.Nsrc) ? n0 : -1;
    else { const int pn = n0 / 256, w = n0 % 256; src0 = (w < 128) ? pn * 128 + w : d.H + pn * 128 + (w - 128); }
    __syncthreads();
#pragma unroll
    for (int i = 0; i < 2; ++i) {
        const int r = (tid >> 4) + 32 * i, c4 = (tid & 15) * 4;
        f32x4 v = {0.f, 0.f, 0.f, 0.f};
        if (src0 >= 0) v = *(const f32x4*)(d.W + (size_t)(k0 + r) * d.Nsrc + src0 + c4);
#pragma unroll
        for (int j = 0; j < 4; ++j) lds[r * 65 + c4 + j] = v[j];
    }
    __syncthreads();
    {
        const int nr = tid >> 3, kp = (tid & 7) * 8;
        u32x4 o;
#pragma unroll
        for (int j = 0; j < 4; ++j) o[j] = pg8::cvt_pk_bf16(lds[(kp + 2 * j) * 65 + nr], lds[(kp + 2 * j + 1) * 65 + nr]);
        *(u32x4*)(d.Wt + (size_t)(n0 + nr) * d.K + k0 + kp) = o;
    }
}
__device__ __forceinline__ WDesc mkdesc(const float* W, bf16_t* Wt, int K, int Nsrc, int Ndst, int mode, int H) { WDesc d; d.W = W; d.Wt = Wt; d.K = K; d.Nsrc = Nsrc; d.Ndst = Ndst; d.mode = mode; d.H = H; d.ntiles = (K / 64) * (Ndst / 64); return d; }
#define CVT_ONE(W, Wt, K, Ns, Nd, mode, H) { const int n_ = ((K) / 64) * ((Nd) / 64); if (tt >= 0 && tt < n_) { const WDesc d_ = mkdesc(W, Wt, K, Ns, Nd, mode, H); cvt_tile(d_, tt, lds); } tt -= n_; }
__device__ __forceinline__ void cvt_weights0(const Params& P, float* lds) {
    unsigned char* ws = P.ws;
    for (int t = blockIdx.x; t < 1344 + 512 + 1408 + 704 + 256 + 64; t += gridDim.x) {
        int tt = t;
        CVT_ONE(P.ssd_w_in, (bf16_t*)(ws + W_IN), 1024, 5184, 5376, 0, 0)
        CVT_ONE(P.ssd_w_out, (bf16_t*)(ws + W_OUT), 2048, 1024, 1024, 0, 0)
        CVT_ONE(P.ffn_w_up, (bf16_t*)(ws + W_UP0), 1024, 5632, 5632, 1, 2816)
        CVT_ONE(P.ffn_w_down, (bf16_t*)(ws + W_DN0), 2816, 1024, 1024, 0, 0)
        CVT_ONE(P.ple_w_gate, (bf16_t*)(ws + W_GT0), 1024, 1024, 1024, 0, 0)
        CVT_ONE(P.ple_w_proj, (bf16_t*)(ws + W_PP0), 256, 1024, 1024, 0, 0)
    }
}
__device__ __forceinline__ void cvt_weights1(const Params& P, float* lds) {
    unsigned char* ws = P.ws;
    for (int t = blockIdx.x; t < 512 + 1408 + 704 + 256 + 64; t += gridDim.x) {
        int tt = t;
        CVT_ONE(P.s5_w_glu, (bf16_t*)(ws + W_GLU), 1024, 2048, 2048, 1, 1024)
        CVT_ONE(P.ffn_w_up + (size_t)1024 * 5632, (bf16_t*)(ws + W_UP1), 1024, 5632, 5632, 1, 2816)
        CVT_ONE(P.ffn_w_down + (size_t)2816 * 1024, (bf16_t*)(ws + W_DN1), 2816, 1024, 1024, 0, 0)
        CVT_ONE(P.ple_w_gate + (size_t)1024 * 1024, (bf16_t*)(ws + W_GT1), 1024, 1024, 1024, 0, 0)
        CVT_ONE(P.ple_w_proj + (size_t)256 * 1024, (bf16_t*)(ws + W_PP1), 256, 1024, 1024, 0, 0)
    }
}
__device__ __forceinline__ void ph_norm(const float* src, const float* w, bf16_t* dstb, float* dstf) {
    const int lane = threadIdx.x & 63, wid = threadIdx.x >> 6;
    for (int row = blockIdx.x * 8 + wid; row < T_TOK; row += gridDim.x * 8) {
        const float* s = src + (size_t)row * DM;
        f32x4 v[4]; float ss = 0.f;
#pragma unroll
        for (int i = 0; i < 4; ++i) { v[i] = *(const f32x4*)(s + lane * 4 + 256 * i); ss += v[i][0] * v[i][0] + v[i][1] * v[i][1] + v[i][2] * v[i][2] + v[i][3] * v[i][3]; }
        ss = wave_sum(ss);
        const float rstd = rsqrtf(ss * (1.0f / DM) + EPS);
#pragma unroll
        for (int i = 0; i < 4; ++i) {
            const f32x4 wv = *(const f32x4*)(w + lane * 4 + 256 * i);
            const f32x4 o = v[i] * rstd * wv;
            if (dstb) { u32x2 pk; pk.x = pack2(o[0], o[1]); pk.y = pack2(o[2], o[3]); *(u32x2*)(dstb + (size_t)row * DM + lane * 4 + 256 * i) = pk; }
            else *(f32x4*)(dstf + (size_t)row * DM + lane * 4 + 256 * i) = o;
        }
    }
}
__device__ __forceinline__ void ph_norm16(const bf16_t* src, const float* w, bf16_t* dstb, float* dstf) {
    const int lane = threadIdx.x & 63, wid = threadIdx.x >> 6;
    for (int row = blockIdx.x * 8 + wid; row < T_TOK; row += gridDim.x * 8) {
        const bf16_t* sp = src + (size_t)row * DM;
        float v[2][8]; float ss = 0.f;
#pragma unroll
        for (int i = 0; i < 2; ++i) { unpack8(*(const u32x4*)(sp + lane * 8 + 512 * i), v[i]);
#pragma unroll
            for (int j = 0; j < 8; ++j) ss += v[i][j] * v[i][j]; }
        ss = wave_sum(ss);
        const float rstd = rsqrtf(ss * (1.0f / DM) + EPS);
#pragma unroll
        for (int i = 0; i < 2; ++i) {
            const f32x4 w0 = *(const f32x4*)(w + lane * 8 + 512 * i), w1 = *(const f32x4*)(w + lane * 8 + 512 * i + 4);
            float o[8];
#pragma unroll
            for (int j = 0; j < 4; ++j) { o[j] = v[i][j] * rstd * w0[j]; o[4 + j] = v[i][4 + j] * rstd * w1[j]; }
            if (dstb) { u32x4 pk; pk.x = pg8::cvt_pk_bf16(o[0], o[1]); pk.y = pg8::cvt_pk_bf16(o[2], o[3]); pk.z = pg8::cvt_pk_bf16(o[4], o[5]); pk.w = pg8::cvt_pk_bf16(o[6], o[7]); *(u32x4*)(dstb + (size_t)row * DM + lane * 8 + 512 * i) = pk; }
            else { *(f32x4*)(dstf + (size_t)row * DM + lane * 8 + 512 * i) = (f32x4){o[0], o[1], o[2], o[3]}; *(f32x4*)(dstf + (size_t)row * DM + lane * 8 + 512 * i + 4) = (f32x4){o[4], o[5], o[6], o[7]}; }
        }
    }
}
__device__ __forceinline__ void ph_cvt_copy(const float* src, bf16_t* dst, size_t n) {
    for (size_t i = ((size_t)blockIdx.x * NT + threadIdx.x) * 4; i < n; i += (size_t)gridDim.x * NT * 4) {
        const f32x4 v = *(const f32x4*)(src + i); u32x2 pk; pk.x = pack2(v[0], v[1]); pk.y = pack2(v[2], v[3]); *(u32x2*)(dst + i) = pk;
    }
}

enum { EPI_BF16 = 0, EPI_RES = 1, EPI_F32 = 2, EPI_PLE = 3, EPI_GLU = 4, EPI_ZGATE = 5, EPI_RESX = 6, EPI_RES16 = 7, EPI_PLE16 = 8, EPI_GLU16 = 9 };
struct GemmArgs {
    const bf16_t* A; int lda; const bf16_t* Bt; int ldb; int M, N, K; int epi;
    void* out; int ldc; const float* res; const float* aux; const bf16_t* y1; const bf16_t* y2; const float* bias;
};
__device__ __forceinline__ void epi_store(const GemmArgs& g, int row, int pn, int tc, float acc, float accp) {
    const int col = pn * 256 + tc;
    switch (g.epi) {
        case EPI_BF16: ((bf16_t*)g.out)[(size_t)row * g.ldc + col] = f2bf(acc); break;
        case EPI_RES: { const size_t o = (size_t)row * g.ldc + col; ((float*)g.out)[o] = g.res[o] + acc; } break;
        case EPI_F32: ((float*)g.out)[(size_t)row * g.ldc + col] = acc; break;
        case EPI_PLE: { const size_t o = (size_t)row * g.ldc + col; ((float*)g.out)[o] = g.res[o] + g.aux[o] * sigmf(acc); } break;
        case EPI_GLU: { const int oc = pn * 128 + tc; const size_t o = (size_t)row * g.ldc + oc; ((float*)g.out)[o] = g.res[o] + (acc + g.bias[oc]) * sigmf(accp + g.bias[1024 + oc]); } break;
        case EPI_ZGATE: { const size_t yo = (size_t)row * 2048 + col; ((bf16_t*)g.out)[(size_t)row * g.ldc + col] = f2bf((bf2f(g.y1[yo]) + bf2f(g.y2[yo])) * siluf(acc)); } break;
    }
}
__device__ __forceinline__ void gemm_naive(const GemmArgs& g, float* lds) {
    float* As = lds;
    float* Bs = lds + 32 * 132;
    const int tid = threadIdx.x, ty = tid >> 4, tx = tid & 15;
    const int nM = g.M / 128, nN = g.N / 256;
    for (int tile = blockIdx.x; tile < nM * nN; tile += gridDim.x) {
        const int pm = tile % nM, pn = tile / nM;
        float acc[4][16];
#pragma unroll
        for (int i = 0; i < 4; ++i)
#pragma unroll
            for (int j = 0; j < 16; ++j) acc[i][j] = 0.f;
        for (int k0 = 0; k0 < g.K; k0 += 32) {
            __syncthreads();
            { const int r = tid >> 2, kk = (tid & 3) * 8;
              const u32x4 v = *(const u32x4*)(g.A + (size_t)(pm * 128 + r) * g.lda + k0 + kk);
#pragma unroll
              for (int j = 0; j < 4; ++j) { As[(kk + 2 * j) * 132 + r] = __uint_as_float(v[j] << 16); As[(kk + 2 * j + 1) * 132 + r] = __uint_as_float(v[j] & 0xffff0000u); } }
#pragma unroll
            for (int h = 0; h < 2; ++h) { const int r = (tid >> 2) + 128 * h, kk = (tid & 3) * 8;
              const u32x4 v = *(const u32x4*)(g.Bt + (size_t)(pn * 256 + r) * g.ldb + k0 + kk);
#pragma unroll
              for (int j = 0; j < 4; ++j) { Bs[(kk + 2 * j) * 260 + r] = __uint_as_float(v[j] << 16); Bs[(kk + 2 * j + 1) * 260 + r] = __uint_as_float(v[j] & 0xffff0000u); } }
            __syncthreads();
#pragma unroll 4
            for (int kk = 0; kk < 32; ++kk) {
                const f32x4 a = *(const f32x4*)(As + kk * 132 + ty * 4);
                const f32x4 b0 = *(const f32x4*)(Bs + kk * 260 + tx * 8), b1 = *(const f32x4*)(Bs + kk * 260 + tx * 8 + 4);
                const f32x4 b2 = *(const f32x4*)(Bs + kk * 260 + 128 + tx * 8), b3 = *(const f32x4*)(Bs + kk * 260 + 128 + tx * 8 + 4);
#pragma unroll
                for (int i = 0; i < 4; ++i)
#pragma unroll
                    for (int j = 0; j < 4; ++j) { acc[i][j] += a[i] * b0[j]; acc[i][4 + j] += a[i] * b1[j]; acc[i][8 + j] += a[i] * b2[j]; acc[i][12 + j] += a[i] * b3[j]; }
            }
        }
#pragma unroll
        for (int i = 0; i < 4; ++i) {
            const int row = pm * 128 + ty * 4 + i;
#pragma unroll
            for (int j = 0; j < 8; ++j) {
                if (g.epi == EPI_GLU) epi_store(g, row, pn, tx * 8 + j, acc[i][j], acc[i][8 + j]);
                else { epi_store(g, row, pn, tx * 8 + j, acc[i][j], 0.f); epi_store(g, row, pn, 128 + tx * 8 + j, acc[i][8 + j], 0.f); }
            }
        }
    }
}
__device__ __forceinline__ GemmArgs mkgemm(const bf16_t* A, int lda, const bf16_t* Bt, int ldb, int M, int N, int K, int epi, void* out, int ldc,
                                           const float* res = nullptr, const float* aux = nullptr, const bf16_t* y1 = nullptr, const bf16_t* y2 = nullptr, const float* bias = nullptr) {
    GemmArgs g; g.A = A; g.lda = lda; g.Bt = Bt; g.ldb = ldb; g.M = M; g.N = N; g.K = K; g.epi = epi; g.out = out; g.ldc = ldc; g.res = res; g.aux = aux; g.y1 = y1; g.y2 = y2; g.bias = bias; return g;
}

template <int EPI>
__device__ __forceinline__ void epi_tile(const GemmArgs& g, const f32x4 (&acc)[2][2][4][2], const pg8::Unit& u, int wr, int wc, int fr, int fq) {
    const int row0 = u.pm * 256 + wr * 64 + fr;
    if constexpr (EPI == EPI_RESX || EPI == EPI_RES16 || EPI == EPI_PLE16 || EPI == EPI_GLU16) {
        constexpr int NBJ = (EPI == EPI_GLU16) ? 1 : 2;
        const int col0 = (EPI == EPI_GLU16 ? u.pn * 128 : u.pn * 256) + wc * 32 + 8 * fq;
        f32x4 bv[2] = {{0.f, 0.f, 0.f, 0.f}, {0.f, 0.f, 0.f, 0.f}}, bg[2] = {{0.f, 0.f, 0.f, 0.f}, {0.f, 0.f, 0.f, 0.f}};
        if constexpr (EPI == EPI_GLU16) {
#pragma unroll
            for (int n = 0; n < 2; ++n) { bv[n] = *(const f32x4*)(g.bias + col0 + 4 * n); bg[n] = *(const f32x4*)(g.bias + 1024 + col0 + 4 * n); }
        }
#pragma unroll
        for (int ai = 0; ai < 2; ++ai)
#pragma unroll
            for (int m = 0; m < 4; ++m) {
                const int row = row0 + ai * 128 + m * 16;
#pragma unroll
                for (int bj = 0; bj < NBJ; ++bj) {
                    const size_t o = (size_t)row * g.ldc + col0 + bj * 128;
                    f32x4 r0, r1;
                    if constexpr (EPI == EPI_RESX) { r0 = *(const f32x4*)(g.res + o); r1 = *(const f32x4*)(g.res + o + 4); }
                    else { const u32x4 rr = *(const u32x4*)((const bf16_t*)g.res + o); r0 = bf4lo(rr[0], rr[1]); r1 = bf4lo(rr[2], rr[3]); }
                    f32x4 v0 = acc[ai][bj][m][0], v1 = acc[ai][bj][m][1];
                    if constexpr (EPI == EPI_PLE16) {
                        const u32x4 aa = *(const u32x4*)((const bf16_t*)g.aux + o); const f32x4 a0 = bf4lo(aa[0], aa[1]), a1 = bf4lo(aa[2], aa[3]);
#pragma unroll
                        for (int j = 0; j < 4; ++j) { v0[j] = a0[j] * fsig(v0[j]); v1[j] = a1[j] * fsig(v1[j]); }
                    }
                    if constexpr (EPI == EPI_GLU16) {
                        const f32x4 g0 = acc[ai][1][m][0] + bg[0], g1 = acc[ai][1][m][1] + bg[1];
                        v0 += bv[0]; v1 += bv[1];
#pragma unroll
                        for (int j = 0; j < 4; ++j) { v0[j] *= fsig(g0[j]); v1[j] *= fsig(g1[j]); }
                    }
                    v0 += r0; v1 += r1;
                    u32x4 w; w.x = pg8::cvt_pk_bf16(v0[0], v0[1]); w.y = pg8::cvt_pk_bf16(v0[2], v0[3]); w.z = pg8::cvt_pk_bf16(v1[0], v1[1]); w.w = pg8::cvt_pk_bf16(v1[2], v1[3]);
                    *(u32x4*)((bf16_t*)g.out + o) = w;
                }
                asm volatile("" ::: "memory");
            }
    } else if constexpr (EPI == EPI_BF16 || EPI == EPI_ZGATE) {
        const int col0 = u.pn * 256 + wc * 32 + 8 * fq;
#pragma unroll
        for (int ai = 0; ai < 2; ++ai)
#pragma unroll
            for (int m = 0; m < 4; ++m) {
                const int row = row0 + ai * 128 + m * 16;
#pragma unroll
                for (int bj = 0; bj < 2; ++bj) {
                    f32x4 v0 = acc[ai][bj][m][0], v1 = acc[ai][bj][m][1];
                    const int col = col0 + bj * 128;
                    if constexpr (EPI == EPI_ZGATE) {
                        const u32x4 a = *(const u32x4*)(g.y1 + (size_t)row * 2048 + col), b = *(const u32x4*)(g.y2 + (size_t)row * 2048 + col);
                        const f32x4 y0 = bf4lo(a[0], a[1]) + bf4lo(b[0], b[1]), y1v = bf4lo(a[2], a[3]) + bf4lo(b[2], b[3]);
#pragma unroll
                        for (int j = 0; j < 4; ++j) { v0[j] = y0[j] * v0[j] * fsig(v0[j]); v1[j] = y1v[j] * v1[j] * fsig(v1[j]); }
                    }
                    u32x4 w; w.x = pg8::cvt_pk_bf16(v0[0], v0[1]); w.y = pg8::cvt_pk_bf16(v0[2], v0[3]); w.z = pg8::cvt_pk_bf16(v1[0], v1[1]); w.w = pg8::cvt_pk_bf16(v1[2], v1[3]);
                    *(u32x4*)((bf16_t*)g.out + (size_t)row * g.ldc + col) = w;
                }
                if constexpr (EPI == EPI_ZGATE) asm volatile("" ::: "memory");
            }
    } else if constexpr (EPI == EPI_GLU) {
        const int col0 = u.pn * 128 + wc * 32 + 4 * fq;
        f32x4 bv[2], bg[2];
#pragma unroll
        for (int n = 0; n < 2; ++n) { bv[n] = *(const f32x4*)(g.bias + col0 + 16 * n); bg[n] = *(const f32x4*)(g.bias + 1024 + col0 + 16 * n); }
#pragma unroll
        for (int ai = 0; ai < 2; ++ai)
#pragma unroll
            for (int m = 0; m < 4; ++m) {
                const int row = row0 + ai * 128 + m * 16;
#pragma unroll
                for (int n = 0; n < 2; ++n) {
                    const size_t o = (size_t)row * g.ldc + col0 + 16 * n;
                    const f32x4 r = *(const f32x4*)(g.res + o), v = acc[ai][0][m][n] + bv[n], gt = acc[ai][1][m][n] + bg[n];
                    f32x4 ov;
#pragma unroll
                    for (int j = 0; j < 4; ++j) ov[j] = r[j] + v[j] * fsig(gt[j]);
                    *(f32x4*)((float*)g.out + o) = ov;
                }
                asm volatile("" ::: "memory");
            }
    } else {
        const int col0 = u.pn * 256 + wc * 32 + 4 * fq;
#pragma unroll
        for (int ai = 0; ai < 2; ++ai)
#pragma unroll
            for (int m = 0; m < 4; ++m) {
                const int row = row0 + ai * 128 + m * 16;
#pragma unroll
                for (int bj = 0; bj < 2; ++bj)
#pragma unroll
                    for (int n = 0; n < 2; ++n) {
                        const size_t o = (size_t)row * g.ldc + col0 + bj * 128 + n * 16;
                        f32x4 ov = acc[ai][bj][m][n];
                        if constexpr (EPI == EPI_RES) ov += *(const f32x4*)(g.res + o);
                        if constexpr (EPI == EPI_PLE) { const f32x4 r = *(const f32x4*)(g.res + o), a = *(const f32x4*)(g.aux + o);
#pragma unroll
                            for (int j = 0; j < 4; ++j) ov[j] = r[j] + a[j] * fsig(ov[j]); }
                        *(f32x4*)((float*)g.out + o) = ov;
                    }
                if constexpr (EPI != EPI_F32) asm volatile("" ::: "memory");
            }
    }
}

template <int EPI>
__device__ __forceinline__ void gemm_pg8(PG8_LAS unsigned char* lds, const GemmArgs g) {
    using namespace pg8;
    constexpr bool PERM = (EPI == EPI_BF16 || EPI == EPI_ZGATE || EPI == EPI_RESX || EPI == EPI_RES16 || EPI == EPI_PLE16 || EPI == EPI_GLU16);
    const int tid = otid(), wid = __builtin_amdgcn_readfirstlane(tid >> 6), lane = tid & 63, wr = wid >> 2, wc = wid & 3, fr = lane & 15, fq = lane >> 4;
    const int K = g.K, nt = K / BK;
    StaticOrder S; S.init(g.M, g.N, (int)gridDim.x, (int)blockIdx.x);
    unsigned voffA[2], voffB[2];
#pragma unroll
    for (int i = 0; i < 2; ++i) { int R, C; stage_rc(tid * 16 + i * 8192, R, C); const int Rb = PERM ? ((R & ~31) + perm32(R & 31)) : R;
        voffA[i] = (unsigned)(R * g.lda + C) * 2u; voffB[i] = (unsigned)(Rb * g.ldb + C) * 2u; }
    const size_t kstep = (size_t)(BK * 2);
    const size_t hstepA = (size_t)HALF * g.lda * 2, hstepB = (size_t)HALF * g.ldb * 2;
    const size_t tstepA = 2 * hstepA, tstepB = 2 * hstepB;
    const unsigned ldsw = (unsigned)wid * 1024u;
    const int aoff = lds_byte(wr * 64 + fr, fq * 8), boff = lds_byte(wc * 32 + fr, fq * 8);
#define PG8_SA(b, h) (((b) * 2 + (h)) * HTB)
#define PG8_SB(b, h) ((4 + (b) * 2 + (h)) * HTB)
#define PG8_STAGE(bufoff, gbase, voff) do { _Pragma("unroll") for (int _i = 0; _i < 2; ++_i) \
        __builtin_amdgcn_global_load_lds((const unsigned*)((const char*)(gbase) + (voff)[_i]), (PG8_LAS unsigned*)(lds + (bufoff) + ldsw + _i * 8192), 16, 0, 0); } while (0)
#define PG8_LDA(dst, b, h) do { _Pragma("unroll") for (int m = 0; m < 4; ++m) _Pragma("unroll") for (int k = 0; k < 2; ++k) dst[m][k] = *(const PG8_LAS bf16x8*)(lds + PG8_SA(b, h) + aoff + m * 2048 + k * 1024); } while (0)
#define PG8_LDB(dst, b, h) do { _Pragma("unroll") for (int n = 0; n < 2; ++n) _Pragma("unroll") for (int k = 0; k < 2; ++k) dst[n][k] = *(const PG8_LAS bf16x8*)(lds + PG8_SB(b, h) + boff + n * 2048 + k * 1024); } while (0)
#define PG8_MMA(ai, bj, At, Bt) do { __builtin_amdgcn_s_setprio(1); _Pragma("unroll") for (int m = 0; m < 4; ++m) _Pragma("unroll") for (int n = 0; n < 2; ++n) _Pragma("unroll") for (int k = 0; k < 2; ++k) \
        acc[ai][bj][m][n] = __builtin_amdgcn_mfma_f32_16x16x32_bf16(Bt[n][k], At[m][k], acc[ai][bj][m][n], 0, 0, 0); __builtin_amdgcn_s_setprio(0); } while (0)
#define PG8_WAIT_V(n) asm volatile("s_waitcnt vmcnt(" #n ")" ::: "memory")
#define PG8_WAIT_L(n) asm volatile("s_waitcnt lgkmcnt(" #n ")" ::: "memory")
#define PG8_BAR __builtin_amdgcn_s_barrier()
#define PG8_SCHED __builtin_amdgcn_sched_barrier(0)
    Unit cur, nxt; int ui = 0;
    if (!S.next(0, cur)) return;
    f32x4 acc[2][2][4][2];
#pragma unroll
    for (int a = 0; a < 2; ++a)
#pragma unroll
        for (int b = 0; b < 2; ++b)
#pragma unroll
            for (int m = 0; m < 4; ++m)
#pragma unroll
                for (int n = 0; n < 2; ++n) acc[a][b][m][n] = (f32x4){0.f, 0.f, 0.f, 0.f};
    bf16x8 At[4][2], B0[2][2], B1[2][2];
    const char* cA = (const char*)g.A + (size_t)cur.pm * tstepA; const char* cB = (const char*)g.Bt + (size_t)cur.pn * tstepB;
    PG8_STAGE(PG8_SB(0, 0), cB, voffB); PG8_STAGE(PG8_SA(0, 0), cA, voffA); PG8_STAGE(PG8_SB(0, 1), cB + hstepB, voffB); PG8_STAGE(PG8_SA(0, 1), cA + hstepA, voffA);
    if (wr == 1) PG8_BAR;
    PG8_WAIT_V(4); PG8_BAR;
    PG8_STAGE(PG8_SB(1, 0), cB + kstep, voffB); PG8_STAGE(PG8_SA(1, 0), cA + kstep, voffA); PG8_STAGE(PG8_SB(1, 1), cB + hstepB + kstep, voffB);
    PG8_WAIT_V(6); PG8_BAR;
    for (;;) {
        const bool has_next = S.next(ui + 1, nxt);
        const char* nA = has_next ? (const char*)g.A + (size_t)nxt.pm * tstepA : cA; const char* nB = has_next ? (const char*)g.Bt + (size_t)nxt.pn * tstepB : cB;
        for (int t = 0; t < nt; t += 2) {
            const bool last = (t == nt - 2);
            const char* a1 = cA + (size_t)(t + 1) * kstep;
            const char* a2 = last ? nA : cA + (size_t)(t + 2) * kstep; const char* b2 = last ? nB : cB + (size_t)(t + 2) * kstep;
            const char* a3 = a2 + kstep; const char* b3 = b2 + kstep;
            PG8_LDB(B0, 0, 0); PG8_SCHED; PG8_LDA(At, 0, 0); PG8_STAGE(PG8_SA(1, 1), a1 + hstepA, voffA);
            PG8_WAIT_L(8); PG8_BAR; PG8_WAIT_L(0); PG8_MMA(0, 0, At, B0); PG8_BAR; PG8_SCHED;
            PG8_LDB(B1, 0, 1); PG8_STAGE(PG8_SB(0, 0), b2, voffB);
            PG8_BAR; PG8_WAIT_L(0); PG8_MMA(0, 1, At, B1); PG8_BAR;
            PG8_LDA(At, 0, 1); PG8_STAGE(PG8_SA(0, 0), a2, voffA);
            PG8_BAR; PG8_WAIT_L(0); PG8_MMA(1, 0, At, B0); PG8_BAR; PG8_SCHED;
            PG8_STAGE(PG8_SB(0, 1), b2 + hstepB, voffB);
            PG8_WAIT_V(6); PG8_BAR; PG8_MMA(1, 1, At, B1); PG8_BAR;
            PG8_LDB(B0, 1, 0); PG8_SCHED; PG8_LDA(At, 1, 0); PG8_STAGE(PG8_SA(0, 1), a2 + hstepA, voffA);
            PG8_WAIT_L(8); PG8_BAR; PG8_WAIT_L(0); PG8_MMA(0, 0, At, B0); PG8_BAR; PG8_SCHED;
            PG8_LDB(B1, 1, 1); PG8_STAGE(PG8_SB(1, 0), b3, voffB);
            PG8_BAR; PG8_WAIT_L(0); PG8_MMA(0, 1, At, B1); PG8_BAR;
            PG8_LDA(At, 1, 1); PG8_STAGE(PG8_SA(1, 0), a3, voffA);
            PG8_BAR; PG8_WAIT_L(0); PG8_MMA(1, 0, At, B0); PG8_BAR; PG8_SCHED;
            PG8_STAGE(PG8_SB(1, 1), b3 + hstepB, voffB);
            PG8_WAIT_V(6); PG8_BAR; PG8_MMA(1, 1, At, B1); PG8_BAR;
        }
        epi_tile<EPI>(g, acc, cur, wr, wc, fr, fq);
        if (!has_next) break;
#pragma unroll
        for (int a = 0; a < 2; ++a)
#pragma unroll
            for (int b = 0; b < 2; ++b)
#pragma unroll
                for (int m = 0; m < 4; ++m)
#pragma unroll
                    for (int n = 0; n < 2; ++n) acc[a][b][m][n] = (f32x4){0.f, 0.f, 0.f, 0.f};
        cur = nxt; cA = nA; cB = nB; ++ui;
    }
    PG8_WAIT_V(0);
    if (wr == 0) PG8_BAR;
    PG8_BAR;
#undef PG8_SA
#undef PG8_SB
#undef PG8_STAGE
#undef PG8_LDA
#undef PG8_LDB
#undef PG8_MMA
#undef PG8_WAIT_V
#undef PG8_WAIT_L
#undef PG8_BAR
#undef PG8_SCHED
}

__device__ __forceinline__ void ph_ssd_halo(const Params& P) {
    bf16_t* proj = (bf16_t*)(P.ws + OFF_R); bf16_t* halo = (bf16_t*)(P.ws + OFF_SMALL);
    const int gt = blockIdx.x * NT + threadIdx.x, gs = gridDim.x * NT;
    for (int i = gt; i < 512 * 4 * 256; i += gs) {
        const int ch = i & 255, hr = (i >> 8) & 3, item = i >> 10;
        const int g = item & 3, c = (item >> 2) & 31, b = item >> 7;
        const int lt = c * 128 + (hr < 2 ? hr - 2 : 126 + hr);
        const int col = 2048 + (ch >> 7) * 512 + g * 128 + (ch & 127);
        bf16_t v = 0;
        if (lt >= 0 && lt < SEQ) v = proj[(size_t)(b * SEQ + lt) * LDP + col];
        halo[i] = v;
    }
    for (int i = gt; i < T_TOK * 64; i += gs) {
        const int j = i & 63, t = i >> 6;
        const float xr = bf2f(proj[(size_t)t * LDP + 3072 + j]) + P.ssd_dt_bias[j];
        const float sp = fmaxf(xr, 0.f) + log1pf(__expf(-fabsf(xr)));
        ((float*)(proj + (size_t)t * LDP + 3136))[j] = sp;
    }
}
constexpr size_t OFF_CB = OFF_R + 104 * MiB;
__device__ __forceinline__ void ph_ssd_bcconv(const Params& P, unsigned char* ldsraw) {
    bf16_t* proj = (bf16_t*)(P.ws + OFF_R); const bf16_t* halo = (const bf16_t*)(P.ws + OFF_SMALL); bf16_t* CBg = (bf16_t*)(P.ws + OFF_CB);
    bf16_t* tile = (bf16_t*)ldsraw;
    bf16_t* cv = tile + 132 * 256;
    const int tid = threadIdx.x, lane = tid & 63, wid = tid >> 6, fr = lane & 15, q = lane >> 4;
    for (int item = blockIdx.x; item < 512; item += gridDim.x) {
        const int g = item & 3, c = (item >> 2) & 31, b = item >> 7;
        const size_t r0 = (size_t)b * SEQ + c * 128;
        __syncthreads();
        for (int i = tid; i < 132 * 32; i += NT) {
            const int co = i & 31, r = i >> 5, ch = co * 8;
            const int col = 2048 + (ch >> 7) * 512 + g * 128 + (ch & 127);
            u32x4 v;
            if (r < 2) v = *(const u32x4*)(halo + (size_t)item * 1024 + r * 256 + ch);
            else if (r >= 130) v = *(const u32x4*)(halo + (size_t)item * 1024 + (r - 128) * 256 + ch);
            else v = *(const u32x4*)(proj + (r0 + r - 2) * LDP + col);
            *(u32x4*)(tile + r * 256 + ch) = v;
        }
        __syncthreads();
        for (int i = tid; i < 128 * 32; i += NT) {
            const int co = i & 31, r = i >> 5, ch = co * 8;
            const int col = 2048 + (ch >> 7) * 512 + g * 128 + (ch & 127);
            float acc[8];
            { const f32x4 b0 = *(const f32x4*)(P.ssd_conv_b + col), b1 = *(const f32x4*)(P.ssd_conv_b + col + 4);
#pragma unroll
              for (int j = 0; j < 4; ++j) { acc[j] = b0[j]; acc[4 + j] = b1[j]; } }
#pragma unroll
            for (int k = 0; k < 5; ++k) {
                float xv[8]; unpack8(*(const u32x4*)(tile + (r + k) * 256 + ch), xv);
                const f32x4 w0 = *(const f32x4*)(P.ssd_conv_w + k * 3072 + col), w1 = *(const f32x4*)(P.ssd_conv_w + k * 3072 + col + 4);
#pragma unroll
                for (int j = 0; j < 4; ++j) { acc[j] += xv[j] * w0[j]; acc[4 + j] += xv[4 + j] * w1[j]; }
            }
            u32x4 o;
#pragma unroll
            for (int j = 0; j < 4; ++j) o[j] = pg8::cvt_pk_bf16(acc[2 * j] * fsig(acc[2 * j]), acc[2 * j + 1] * fsig(acc[2 * j + 1]));
            *(u32x4*)(cv + r * 264 + ch) = o;
            if (ch >= 128) *(u32x4*)(proj + (r0 + r) * LDP + col) = o;
        }
        __syncthreads();
        for (int i = tid; i < 2048; i += NT) {
            const int n = i >> 4, to = (i & 15) * 8; u32x4 o;
#pragma unroll
            for (int j = 0; j < 4; ++j) o[j] = (unsigned)cv[(to + 2 * j) * 264 + n] | ((unsigned)cv[(to + 2 * j + 1) * 264 + n] << 16);
            *(u32x4*)(proj + (r0 + n) * LDP + 2048 + g * 128 + to) = o;
        }
        bf16x8 af[4];
#pragma unroll
        for (int ks = 0; ks < 4; ++ks) af[ks] = *(const bf16x8*)(cv + (16 * wid + fr) * 264 + 32 * ks + 8 * q);
        bf16_t* cbo = CBg + (size_t)item * 16384;
#pragma unroll
        for (int lt = 0; lt < 8; ++lt) {
            f32x4 acc = {0.f, 0.f, 0.f, 0.f};
#pragma unroll
            for (int ks = 0; ks < 4; ++ks) { const bf16x8 bfr = *(const bf16x8*)(cv + (16 * lt + fr) * 264 + 128 + 32 * ks + 8 * q); acc = __builtin_amdgcn_mfma_f32_16x16x32_bf16(af[ks], bfr, acc, 0, 0, 0); }
            u32x2 o; o.x = pg8::cvt_pk_bf16(acc[0], acc[1]); o.y = pg8::cvt_pk_bf16(acc[2], acc[3]);
            *(u32x2*)(cbo + (16 * lt + fr) * 128 + 16 * wid + 4 * q) = o;
        }
    }
}
__device__ __forceinline__ void ph_ssd_scan_naive(const Params& P, unsigned char* ldsraw) {
    const bf16_t* proj = (const bf16_t*)(P.ws + OFF_R);
    bf16_t* Bs = (bf16_t*)ldsraw;
    bf16_t* Cs = Bs + 64 * 128;
    float* xs = (float*)(Cs + 64 * 128);
    float* dts = xs + 64 * 64;
    const int tid = threadIdx.x, p = tid >> 3, ng = tid & 7;
    for (int item = blockIdx.x; item < 256; item += gridDim.x) {
        const int d = item & 1, hh = (item >> 1) & 31, b = item >> 6, g = hh >> 3;
        const float a = -__expf(P.ssd_a_log[d * 32 + hh]), dsk = P.ssd_d[hh];
        bf16_t* Y = d ? (bf16_t*)P.out : (bf16_t*)(P.ws + OFF_YF);
        float h[16];
#pragma unroll
        for (int j = 0; j < 16; ++j) h[j] = 0.f;
        for (int blk = 0; blk < SEQ / 64; ++blk) {
            __syncthreads();
            for (int i = tid; i < 64 * 128; i += NT) {
                const int n = i & 127, r = i >> 7; const int lt = d ? SEQ - 1 - (blk * 64 + r) : blk * 64 + r;
                const size_t ro = (size_t)(b * SEQ + lt) * LDP;
                Bs[i] = proj[(size_t)(b * SEQ + (lt & ~127) + n) * LDP + 2048 + g * 128 + (lt & 127)]; Cs[i] = proj[ro + 2560 + g * 128 + n];
            }
            for (int i = tid; i < 64 * 64; i += NT) {
                const int pp = i & 63, r = i >> 6; const int lt = d ? SEQ - 1 - (blk * 64 + r) : blk * 64 + r;
                const int col = hh * 64 + pp;
                float acc = P.ssd_conv_b[col];
#pragma unroll
                for (int k = 0; k < 5; ++k) { const int l2 = lt + k - 2; if (l2 >= 0 && l2 < SEQ) acc += bf2f(proj[(size_t)(b * SEQ + l2) * LDP + col]) * P.ssd_conv_w[k * 3072 + col]; }
                xs[i] = siluf(acc);
            }
            if (tid < 64) { const int lt = d ? SEQ - 1 - (blk * 64 + tid) : blk * 64 + tid; dts[tid] = ((const float*)(proj + (size_t)(b * SEQ + lt) * LDP + 3136))[d * 32 + hh]; }
            __syncthreads();
            for (int r = 0; r < 64; ++r) {
                const float dt = dts[r], xv = xs[r * 64 + p], dA = __expf(dt * a), dx = dt * xv;
                float part = 0.f;
#pragma unroll
                for (int j = 0; j < 16; ++j) { h[j] = h[j] * dA + dx * bf2f(Bs[r * 128 + ng * 16 + j]); part += bf2f(Cs[r * 128 + ng * 16 + j]) * h[j]; }
                part += __shfl_xor(part, 1); part += __shfl_xor(part, 2); part += __shfl_xor(part, 4);
                if (ng == 0) { const int lt = d ? SEQ - 1 - (blk * 64 + r) : blk * 64 + r; Y[(size_t)(b * SEQ + lt) * 2048 + hh * 64 + p] = f2bf(part + (d == 0 ? dsk * xv : 0.f)); }
            }
        }
    }
}
#define LDS_BAR() do { asm volatile("s_waitcnt lgkmcnt(0)" ::: "memory"); __builtin_amdgcn_s_barrier(); asm volatile("" ::: "memory"); } while (0)
__device__ __forceinline__ void ph_ssd_scan(const Params& P, unsigned char* ldsraw) {
    const bf16_t* proj = (const bf16_t*)(P.ws + OFF_R); const bf16_t* CBg = (const bf16_t*)(P.ws + OFF_CB);
    bf16_t* xdT = (bf16_t*)ldsraw;
    bf16_t* xdwT = xdT + 64 * 136;
    bf16_t* stb = xdwT + 64 * 136;
    bf16_t* xraw = stb + 64 * 136;
    float* cs = (float*)(xraw + 132 * 72);
    float* dts = cs + 128;
    float* tot = dts + 128;
    float* cwl = tot + 4;
    float* csA = cwl + 384;
    float* dtsA = csA + 32 * 128;
    float* totA = dtsA + 32 * 128;
    const int tid = threadIdx.x, lane = tid & 63, wid = tid >> 6, fr = lane & 15, q = lane >> 4;
    const int ltile = (wid < 4) ? wid : 11 - wid;
    for (int item = blockIdx.x; item < 256; item += gridDim.x) {
        const int d = item & 1, hh = (item >> 1) & 31, b = item >> 6, g = hh >> 3;
        const float a = -__expf(P.ssd_a_log[d * 32 + hh]), dsk = P.ssd_d[hh];
        bf16_t* Y = d ? (bf16_t*)P.out : (bf16_t*)(P.ws + OFF_YF);
        __syncthreads();
        for (int i = tid; i < 384; i += NT) cwl[i] = (i < 320) ? P.ssd_conv_w[(i >> 6) * 3072 + hh * 64 + (i & 63)] : P.ssd_conv_b[hh * 64 + i - 320];
        for (int k4 = 0; k4 < 4; ++k4) {
            const int cc = wid + 8 * k4; const size_t t0_ = (size_t)b * SEQ + cc * 128;
            const float dta = ((const float*)(proj + (t0_ + 2 * lane) * LDP + 3136))[d * 32 + hh], dtb = ((const float*)(proj + (t0_ + 2 * lane + 1) * LDP + 3136))[d * 32 + hh];
            const float ad0 = dta * a, ad1 = dtb * a, v = ad0 + ad1; float inc = v;
#pragma unroll
            for (int o = 1; o < 64; o <<= 1) { const float t = __shfl_up(inc, o); if (lane >= o) inc += t; }
            const float excl = inc - v, totl = __shfl(inc, 63);
            if (d == 0) { csA[cc * 128 + 2 * lane] = excl + ad0; csA[cc * 128 + 2 * lane + 1] = inc; } else { csA[cc * 128 + 2 * lane] = totl - excl; csA[cc * 128 + 2 * lane + 1] = totl - excl - ad0; }
            dtsA[cc * 128 + 2 * lane] = dta; dtsA[cc * 128 + 2 * lane + 1] = dtb; if (lane == 0) totA[cc] = totl;
        }
        f32x4 st[4];
#pragma unroll
        for (int pt = 0; pt < 4; ++pt) st[pt] = (f32x4){0.f, 0.f, 0.f, 0.f};
        u32x4 xp[3]; u32x4 cbv[4]; bf16x8 cmf[4], btf[4];
#define SCAN_LOAD_A(cc) do { const size_t t0_ = (size_t)b * SEQ + (cc) * 128; \
            _Pragma("unroll") for (int e_ = 0; e_ < 3; ++e_) { const int i_ = tid + e_ * NT; const int r_ = i_ >> 3, pc_ = (i_ & 7) * 8; const int lt_ = (cc) * 128 + r_ - 2; \
                xp[e_] = (u32x4){0u, 0u, 0u, 0u}; if (i_ < 132 * 8 && lt_ >= 0 && lt_ < SEQ) xp[e_] = *(const u32x4*)(proj + ((size_t)b * SEQ + lt_) * LDP + hh * 64 + pc_); } } while (0)
#define SCAN_LOAD_C(cc) do { const size_t t0_ = (size_t)b * SEQ + (cc) * 128; const int l_ = 16 * ltile + fr, n_ = 16 * wid + fr; \
            const bf16_t* cbrow_ = CBg + (size_t)((b * 32 + (cc)) * 4 + g) * 16384 + l_ * 128 + 8 * q; const bf16_t* cmrow_ = proj + (t0_ + l_) * LDP + 2560 + g * 128 + 8 * q; \
            const bf16_t* btrow_ = proj + (t0_ + n_) * LDP + 2048 + g * 128 + 8 * q; \
            _Pragma("unroll") for (int ks_ = 0; ks_ < 4; ++ks_) { cbv[ks_] = *(const u32x4*)(cbrow_ + 32 * ks_); cmf[ks_] = *(const bf16x8*)(cmrow_ + 32 * ks_); btf[ks_] = *(const bf16x8*)(btrow_ + 32 * ks_); } } while (0)
#define SCAN_CH(i_) (d ? 31 - ((i_) < 31 ? (i_) : 31) : ((i_) < 31 ? (i_) : 31))
#define SCAN_XRAW_WRITE() do { _Pragma("unroll") for (int e = 0; e < 3; ++e) { const int i = tid + e * NT; if (i < 132 * 8) *(u32x4*)(xraw + (i >> 3) * 72 + (i & 7) * 8) = xp[e]; } } while (0)
        { const int c0_ = SCAN_CH(0), c1_ = SCAN_CH(1); SCAN_LOAD_A(c0_); SCAN_LOAD_C(c0_); SCAN_XRAW_WRITE(); SCAN_LOAD_A(c1_); }
        __syncthreads();
        for (int ci = 0; ci < 32; ++ci) {
            const int c = d ? 31 - ci : ci; const size_t tok0 = (size_t)b * SEQ + c * 128;
            const int cn = SCAN_CH(ci + 1), cnn = SCAN_CH(ci + 2);
            const float* cs = csA + c * 128; const float* dts = dtsA + c * 128;
#pragma unroll
            for (int pt = 0; pt < 4; ++pt) { u32x2 o; o.x = pg8::cvt_pk_bf16(st[pt][0], st[pt][1]); o.y = pg8::cvt_pk_bf16(st[pt][2], st[pt][3]); *(u32x2*)(stb + (16 * pt + fr) * 136 + 16 * wid + 4 * q) = o; }
            const float total = totA[c];
            {
                const int tp = tid & 63, oc = (tid >> 6) * 8;
                float w5[5][8], accA[8], accB[8];
#pragma unroll
                for (int k = 0; k < 5; ++k) { const f32x4 w0 = *(const f32x4*)(cwl + k * 64 + oc), w1 = *(const f32x4*)(cwl + k * 64 + oc + 4);
#pragma unroll
                    for (int j = 0; j < 4; ++j) { w5[k][j] = w0[j]; w5[k][4 + j] = w1[j]; } }
                { const f32x4 b0 = *(const f32x4*)(cwl + 320 + oc), b1 = *(const f32x4*)(cwl + 320 + oc + 4);
#pragma unroll
                  for (int j = 0; j < 4; ++j) { accA[j] = b0[j]; accA[4 + j] = b1[j]; accB[j] = b0[j]; accB[4 + j] = b1[j]; } }
#pragma unroll
                for (int k = 0; k < 6; ++k) {
                    float xr[8]; unpack8(*(const u32x4*)(xraw + (2 * tp + k) * 72 + oc), xr);
#pragma unroll
                    for (int j = 0; j < 8; ++j) { if (k < 5) accA[j] += xr[j] * w5[k < 5 ? k : 0][j]; if (k > 0) accB[j] += xr[j] * w5[k > 0 ? k - 1 : 0][j]; }
                }
                const float dtA = dts[2 * tp], dtB = dts[2 * tp + 1], wA = __expf(total - cs[2 * tp]), wB = __expf(total - cs[2 * tp + 1]);
#pragma unroll
                for (int j = 0; j < 8; ++j) {
                    const float xa = accA[j] * fsig(accA[j]) * dtA, xb_ = accB[j] * fsig(accB[j]) * dtB;
                    ((unsigned*)(xdT + (oc + j) * 136))[tp] = pg8::cvt_pk_bf16(xa, xb_);
                    ((unsigned*)(xdwT + (oc + j) * 136))[tp] = pg8::cvt_pk_bf16(xa * wA, xb_ * wB);
                }
            }
            LDS_BAR();
            {
                int l = 16 * ltile + fr; asm volatile("" : "+v"(l));
                const float csl = cs[l], el = __expf(csl), ddt = dsk * __builtin_amdgcn_rcpf(dts[l]);
                f32x4 y2[4], y3[4];
#pragma unroll
                for (int pt = 0; pt < 4; ++pt) { y2[pt] = (f32x4){0.f, 0.f, 0.f, 0.f}; y3[pt] = (f32x4){0.f, 0.f, 0.f, 0.f}; }
                const int whalf = __builtin_amdgcn_readfirstlane(ltile) >> 1;
#pragma unroll
                for (int ks = 0; ks < 4; ++ks) {
                  if (d ? (ks >= whalf) : (ks <= whalf)) {
                    const f32x4 c0 = *(const f32x4*)(cs + 32 * ks + 8 * q), c1 = *(const f32x4*)(cs + 32 * ks + 8 * q + 4);
                    float gv[8];
#pragma unroll
                    for (int j = 0; j < 8; ++j) {
                        const int sx = 32 * ks + 8 * q + j; const float cb = (j & 1) ? __uint_as_float(cbv[ks][j >> 1] & 0xffff0000u) : __uint_as_float(cbv[ks][j >> 1] << 16);
                        const float css = (j < 4) ? c0[j & 3] : c1[j & 3]; const bool keep = d ? (sx >= l) : (sx <= l);
                        float val = keep ? cb * __expf(csl - css) : 0.f;
                        if (d == 0 && sx == l) val += ddt;
                        gv[j] = val;
                    }
                    union { u32x4 u; bf16x8 h; } gf; gf.u = (u32x4){pg8::cvt_pk_bf16(gv[0], gv[1]), pg8::cvt_pk_bf16(gv[2], gv[3]), pg8::cvt_pk_bf16(gv[4], gv[5]), pg8::cvt_pk_bf16(gv[6], gv[7])};
#pragma unroll
                    for (int pt = 0; pt < 4; ++pt) { const bf16x8 xf = *(const bf16x8*)(xdT + (16 * pt + fr) * 136 + 32 * ks + 8 * q); y2[pt] = __builtin_amdgcn_mfma_f32_16x16x32_bf16(xf, gf.h, y2[pt], 0, 0, 0); }
                  }
#pragma unroll
                    for (int pt = 0; pt < 4; ++pt) { const bf16x8 sf = *(const bf16x8*)(stb + (16 * pt + fr) * 136 + 32 * ks + 8 * q); y3[pt] = __builtin_amdgcn_mfma_f32_16x16x32_bf16(sf, cmf[ks], y3[pt], 0, 0, 0); }
                }
#pragma unroll
                for (int pt = 0; pt < 4; ++pt) {
                    const f32x4 v = y2[pt] + el * y3[pt]; u32x2 o; o.x = pg8::cvt_pk_bf16(v[0], v[1]); o.y = pg8::cvt_pk_bf16(v[2], v[3]);
                    *(u32x2*)(Y + (tok0 + l) * 2048 + hh * 64 + 16 * pt + 4 * q) = o;
                }
                const float etot = __expf(total);
#pragma unroll
                for (int pt = 0; pt < 4; ++pt) st[pt] *= etot;
#pragma unroll
                for (int ks = 0; ks < 4; ++ks) {
#pragma unroll
                    for (int pt = 0; pt < 4; ++pt) { const bf16x8 xf = *(const bf16x8*)(xdwT + (16 * pt + fr) * 136 + 32 * ks + 8 * q); st[pt] = __builtin_amdgcn_mfma_f32_16x16x32_bf16(btf[ks], xf, st[pt], 0, 0, 0); }
                }
            }
            SCAN_LOAD_C(cn);
            SCAN_XRAW_WRITE();
            SCAN_LOAD_A(cnn);
            LDS_BAR();
        }
#undef SCAN_LOAD_A
#undef SCAN_CH
#undef SCAN_XRAW_WRITE
#undef SCAN_LOAD_C
    }
}
__device__ __forceinline__ void ph_gn_scale(const Params& P) {
    bf16_t* proj = (bf16_t*)(P.ws + OFF_R);
    const int lane = threadIdx.x & 63, wid = threadIdx.x >> 6;
    for (int it = blockIdx.x * 8 + wid; it < T_TOK * 4; it += gridDim.x * 8) {
        const int row = it >> 2, grp = it & 3;
        bf16_t* ptr = proj + (size_t)row * LDP + grp * 512 + lane * 8;
        const u32x4 v = *(const u32x4*)ptr; float f[8]; float ss = 0.f;
#pragma unroll
        for (int j = 0; j < 4; ++j) { f[2 * j] = __uint_as_float(v[j] << 16); f[2 * j + 1] = __uint_as_float(v[j] & 0xffff0000u); ss += f[2 * j] * f[2 * j] + f[2 * j + 1] * f[2 * j + 1]; }
        ss = wave_sum(ss);
        const float rstd = rsqrtf(ss * (1.0f / 512.f) + EPS);
        const float* w = P.ssd_norm_w + grp * 512 + lane * 8; u32x4 o;
#pragma unroll
        for (int j = 0; j < 4; ++j) o[j] = pack2(f[2 * j] * rstd * w[2 * j], f[2 * j + 1] * rstd * w[2 * j + 1]);
        *(u32x4*)ptr = o;
    }
}
__device__ __forceinline__ void ph_ffn_conv(const Params& P, int layer, int half) {
    const bf16_t* hup = (const bf16_t*)(P.ws + OFF_R); bf16_t* gout = (bf16_t*)(P.ws + OFF_G);
    const float* cw = P.ffn_conv_w + (size_t)layer * 3 * 5632; const float* cb = P.ffn_conv_b + (size_t)layer * 5632;
    for (int it = blockIdx.x * NT + threadIdx.x; it < (T_TOK / 16) * (FH / 8); it += gridDim.x * NT) {
        const int oc = (it % (FH / 8)) * 8, t0 = (it / (FH / 8)) * 16, lt0 = t0 & (SEQ - 1);
        const int pn = oc >> 7, w = oc & 127, gcol = pn * 256 + w, vcol = gcol + 128;
        const int gch = half * FH + oc, vch = 2816 + gch;
        float wg[3][8], wv[3][8], bg[8], bv[8];
#pragma unroll
        for (int k = 0; k < 3; ++k) {
            const f32x4 a0 = *(const f32x4*)(cw + k * 5632 + gch), a1 = *(const f32x4*)(cw + k * 5632 + gch + 4), c0 = *(const f32x4*)(cw + k * 5632 + vch), c1 = *(const f32x4*)(cw + k * 5632 + vch + 4);
#pragma unroll
            for (int j = 0; j < 4; ++j) { wg[k][j] = a0[j]; wg[k][4 + j] = a1[j]; wv[k][j] = c0[j]; wv[k][4 + j] = c1[j]; }
        }
        { const f32x4 a0 = *(const f32x4*)(cb + gch), a1 = *(const f32x4*)(cb + gch + 4), c0 = *(const f32x4*)(cb + vch), c1 = *(const f32x4*)(cb + vch + 4);
#pragma unroll
          for (int j = 0; j < 4; ++j) { bg[j] = a0[j]; bg[4 + j] = a1[j]; bv[j] = c0[j]; bv[4 + j] = c1[j]; } }
        const bf16_t* base = hup + (size_t)t0 * 2816;
        float gp[8], vp[8], gc[8], vc[8];
        const u32x4 z4 = {0u, 0u, 0u, 0u};
        unpack8(lt0 > 0 ? *(const u32x4*)(base - 2816 + gcol) : z4, gp); unpack8(lt0 > 0 ? *(const u32x4*)(base - 2816 + vcol) : z4, vp);
        unpack8(*(const u32x4*)(base + gcol), gc); unpack8(*(const u32x4*)(base + vcol), vc);
#pragma unroll
        for (int i = 0; i < 16; ++i) {
            float gn[8], vn[8];
            const bool has = (lt0 + i + 1 < SEQ);
            unpack8(has ? *(const u32x4*)(base + (size_t)(i + 1) * 2816 + gcol) : z4, gn); unpack8(has ? *(const u32x4*)(base + (size_t)(i + 1) * 2816 + vcol) : z4, vn);
            u32x4 o;
#pragma unroll
            for (int j = 0; j < 4; ++j) {
                const float g0 = bg[2 * j] + wg[0][2 * j] * gp[2 * j] + wg[1][2 * j] * gc[2 * j] + wg[2][2 * j] * gn[2 * j];
                const float g1 = bg[2 * j + 1] + wg[0][2 * j + 1] * gp[2 * j + 1] + wg[1][2 * j + 1] * gc[2 * j + 1] + wg[2][2 * j + 1] * gn[2 * j + 1];
                const float v0 = bv[2 * j] + wv[0][2 * j] * vp[2 * j] + wv[1][2 * j] * vc[2 * j] + wv[2][2 * j] * vn[2 * j];
                const float v1 = bv[2 * j + 1] + wv[0][2 * j + 1] * vp[2 * j + 1] + wv[1][2 * j + 1] * vc[2 * j + 1] + wv[2][2 * j + 1] * vn[2 * j + 1];
                o[j] = pg8::cvt_pk_bf16(g0 * fsig(g0) * v0, g1 * fsig(g1) * v1);
            }
            *(u32x4*)(gout + (size_t)(t0 + i) * FH + oc) = o;
#pragma unroll
            for (int j = 0; j < 8; ++j) { gp[j] = gc[j]; vp[j] = vc[j]; gc[j] = gn[j]; vc[j] = vn[j]; }
        }
    }
}
__device__ __forceinline__ void ph_s5_naive(const Params& P) {
    const bf16_t* u = (const bf16_t*)(P.ws + OFF_ABUF); float* scr = (float*)(P.ws + OFF_R); bf16_t* gout = (bf16_t*)(P.ws + OFF_G);
    const int lane = threadIdx.x & 63, wid = threadIdx.x >> 6;
    for (int item = blockIdx.x + gridDim.x * wid; item < 256; item += gridDim.x * 8) {
        const int g = item & 63, b = item >> 6;
        for (int d = 0; d < 2; ++d) {
            const float lr = P.s5_a_re[(d * 64 + g) * 64 + lane], li = P.s5_a_im[(d * 64 + g) * 64 + lane];
            const float step = expf(P.s5_log_step[d * 64 + g]);
            const float mag = expf(lr * step), ang = li * step;
            const double angd = (double)ang, two_pi = 6.283185307179586476925;
            const float angr = (float)(angd - two_pi * rint(angd / two_pi));
            const float lbr = mag * cosf(angr), lbi = mag * sinf(angr);
            const float nr = lbr - 1.0f, den = lr * lr + li * li;
            const float qr = (nr * lr + lbi * li) / den, qi = (lbi * lr - nr * li) / den;
            float Br[16], Bi[16], Cr[16], Ci[16];
#pragma unroll
            for (int h = 0; h < 16; ++h) {
                const float br = P.s5_b_re[(g * 64 + lane) * 16 + h], bi = P.s5_b_im[(g * 64 + lane) * 16 + h];
                Br[h] = qr * br - qi * bi; Bi[h] = qr * bi + qi * br;
                Cr[h] = P.s5_c_re[((d * 64 + g) * 16 + h) * 64 + lane]; Ci[h] = P.s5_c_im[((d * 64 + g) * 16 + h) * 64 + lane];
            }
            float hr = 0.f, hi = 0.f;
            for (int s = 0; s < SEQ; ++s) {
                const int lt = d ? SEQ - 1 - s : s; const size_t tok = (size_t)b * SEQ + lt;
                const float uv = bf2f(u[tok * DM + g * 16 + (lane & 15)]);
                float dr = 0.f, di = 0.f;
#pragma unroll
                for (int h = 0; h < 16; ++h) { const float uh = __shfl(uv, h); dr += Br[h] * uh; di += Bi[h] * uh; }
                const float nhr = lbr * hr - lbi * hi + dr, nhi = lbr * hi + lbi * hr + di; hr = nhr; hi = nhi;
                float yv = 0.f;
#pragma unroll
                for (int h = 0; h < 16; ++h) { const float s1 = wave_sum(hr * Cr[h] - hi * Ci[h]); if ((lane & 15) == h) yv = s1; }
                if (lane < 16) {
                    if (d == 0) scr[tok * DM + g * 16 + lane] = yv;
                    else { const float y = scr[tok * DM + g * 16 + lane] + yv + P.s5_d[g * 16 + lane] * uv;
                           const float ge = 0.5f * y * (1.0f + tanhf(0.7978845608028654f * (y + 0.044715f * y * y * y)));
                           gout[tok * DM + g * 16 + lane] = f2bf(ge); }
                }
            }
        }
    }
}

constexpr size_t OFF_S5M = OFF_R + 96 * MiB;
__device__ __forceinline__ void s5_lambda(const Params& P, int d, int g, int p, float& lbr, float& lbi, float& qr, float& qi) {
    const float lr = P.s5_a_re[(d * 64 + g) * 64 + p], li = P.s5_a_im[(d * 64 + g) * 64 + p];
    const float step = expf(P.s5_log_step[d * 64 + g]);
    const float mag = expf(lr * step), ang = li * step;
    const double angd = (double)ang, two_pi = 6.283185307179586476925;
    const float angr = (float)(angd - two_pi * rint(angd / two_pi));
    lbr = mag * cosf(angr); lbi = mag * sinf(angr);
    const float nr = lbr - 1.0f, den = lr * lr + li * li;
    qr = (nr * lr + lbi * li) / den; qi = (lbi * lr - nr * li) / den;
}
__device__ __forceinline__ void ph_s5_setup(const Params& P, unsigned char* ldsraw) {
    float* pw = (float*)ldsraw;
    float* Bb = pw + 2 * 17 * 64 * 2;
    float* Cc = Bb + 2 * 64 * 16 * 2;
    float* Kt = Cc + 2 * 16 * 64 * 2;
    const int tid = threadIdx.x;
    for (int item = blockIdx.x; item < 256; item += gridDim.x) {
        const int g = item >> 2, part = item & 3;
        bf16_t* A1 = (bf16_t*)(P.ws + OFF_S5M) + (size_t)g * (65536 + 131072); bf16_t* A2 = A1 + 65536;
        __syncthreads();
        if (tid < 128) {
            const int d = tid >> 6, p = tid & 63; float lbr, lbi, qr, qi; s5_lambda(P, d, g, p, lbr, lbi, qr, qi);
            float pr = 1.f, pi = 0.f;
            for (int j = 0; j <= 16; ++j) { pw[((d * 17 + j) * 64 + p) * 2] = pr; pw[((d * 17 + j) * 64 + p) * 2 + 1] = pi; const float t = pr * lbr - pi * lbi; pi = pr * lbi + pi * lbr; pr = t; }
            for (int h = 0; h < 16; ++h) {
                const float br = P.s5_b_re[(g * 64 + p) * 16 + h], bi = P.s5_b_im[(g * 64 + p) * 16 + h];
                Bb[((d * 64 + p) * 16 + h) * 2] = qr * br - qi * bi; Bb[((d * 64 + p) * 16 + h) * 2 + 1] = qr * bi + qi * br;
                Cc[((d * 16 + h) * 64 + p) * 2] = P.s5_c_re[((d * 64 + g) * 16 + h) * 64 + p]; Cc[((d * 16 + h) * 64 + p) * 2 + 1] = P.s5_c_im[((d * 64 + g) * 16 + h) * 64 + p];
            }
        }
        __syncthreads();
        for (int i = tid; i < 16384; i += NT) {
            const int k = i & 255, R = 64 * part + (i >> 8), sx = k >> 4, hp = k & 15, d = R >> 7, ri = (R >> 6) & 1, p = R & 63;
            const int e = d ? sx : 15 - sx;
            const float pr = pw[((d * 17 + e) * 64 + p) * 2], pi = pw[((d * 17 + e) * 64 + p) * 2 + 1], br = Bb[((d * 64 + p) * 16 + hp) * 2], bi = Bb[((d * 64 + p) * 16 + hp) * 2 + 1];
            A1[(size_t)R * 256 + k] = f2bf(ri ? (pr * bi + pi * br) : (pr * br - pi * bi));
        }
        for (int i = tid; i < 2048; i += NT) {
            const int hp = i & 15, hl = (i >> 4) & 3, j = (i >> 6) & 15, d = i >> 10, h = 4 * part + hl;
            float acc = 0.f;
            for (int p = 0; p < 64; ++p) {
                const float pr = pw[((d * 17 + j) * 64 + p) * 2], pi = pw[((d * 17 + j) * 64 + p) * 2 + 1], br = Bb[((d * 64 + p) * 16 + hp) * 2], bi = Bb[((d * 64 + p) * 16 + hp) * 2 + 1];
                const float er = pr * br - pi * bi, ei = pr * bi + pi * br;
                acc += Cc[((d * 16 + h) * 64 + p) * 2] * er - Cc[((d * 16 + h) * 64 + p) * 2 + 1] * ei;
            }
            Kt[i] = acc;
        }
        __syncthreads();
        for (int i = tid; i < 16384; i += NT) {
            const int k = i & 255, rr = i >> 8, tau = rr >> 2, hl = rr & 3, h = 4 * part + hl, row = tau * 16 + h, sx = k >> 4, hp = k & 15;
            float v = 0.f;
            if (sx <= tau) v += Kt[(((tau - sx)) * 4 + hl) * 16 + hp];
            if (sx >= tau) v += Kt[((16 + sx - tau) * 4 + hl) * 16 + hp];
            if (sx == tau && hp == h) v += P.s5_d[g * 16 + h];
            A2[(size_t)row * 512 + k] = f2bf(v);
        }
        for (int i = tid; i < 16384; i += NT) {
            const int kk = i & 255, rr = i >> 8, tau = rr >> 2, h = 4 * part + (rr & 3), row = tau * 16 + h, d = kk >> 7, ri = (kk >> 6) & 1, p = kk & 63;
            const int e = d ? 16 - tau : tau + 1;
            const float pr = pw[((d * 17 + e) * 64 + p) * 2], pi = pw[((d * 17 + e) * 64 + p) * 2 + 1], cr = Cc[((d * 16 + h) * 64 + p) * 2], ci = Cc[((d * 16 + h) * 64 + p) * 2 + 1];
            A2[(size_t)row * 512 + 256 + kk] = f2bf(ri ? -(cr * pi + ci * pr) : (cr * pr - ci * pi));
        }
    }
}
__device__ __forceinline__ void ph_s5_main(const Params& P, unsigned char* ldsraw) {
    const bf16_t* u = (const bf16_t*)(P.ws + OFF_ABUF); float* scr = (float*)(P.ws + OFF_R); bf16_t* gout = (bf16_t*)(P.ws + OFF_G);
    bf16_t* Sc = (bf16_t*)ldsraw;
    float* tbuf = (float*)(ldsraw + 256 * 264 * 2);
    bf16_t* atile = (bf16_t*)(ldsraw + 256 * 264 * 2 + 8192);
    const int tid = threadIdx.x, lane = tid & 63, wid = tid >> 6, fr = lane & 15, q = lane >> 4;
    for (int item = blockIdx.x; item < 256; item += gridDim.x) {
        const int g = (item & 7) + 8 * (item >> 5), b = (item >> 3) & 3;
        const bf16_t* A1 = (const bf16_t*)(P.ws + OFF_S5M) + (size_t)g * (65536 + 131072); const bf16_t* A2 = A1 + 65536;
        float* sl = scr + (size_t)item * 65536;
        bf16x8 uf[2][8];
#pragma unroll
        for (int ct = 0; ct < 2; ++ct)
#pragma unroll
            for (int ks = 0; ks < 8; ++ks) {
                const int c = 32 * wid + 16 * ct + fr; const size_t tok = (size_t)b * SEQ + c * 16 + 2 * ks + (q >> 1);
                uf[ct][ks] = *(const bf16x8*)(u + tok * DM + g * 16 + 8 * (q & 1));
            }
        {
            const int srow = tid >> 5, spc = (tid & 31) * 8;
            *(u32x4*)(atile + srow * 264 + spc) = *(const u32x4*)(A1 + (size_t)srow * 256 + spc);
            u32x4 r0, r1 = *(const u32x4*)(A1 + (size_t)(16 + srow) * 256 + spc), r2 = *(const u32x4*)(A1 + (size_t)(32 + srow) * 256 + spc), r3 = *(const u32x4*)(A1 + (size_t)(48 + srow) * 256 + spc);
            __syncthreads();
#define S5A_STEP(Rt, RL, RW) do { \
                RL = *(const u32x4*)(A1 + (size_t)((((Rt) + 4) & 15) * 16 + srow) * 256 + spc); \
                const bf16_t* at = atile + ((Rt) & 1) * (16 * 264) + fr * 264 + 8 * q; \
                f32x4 a0 = {0.f, 0.f, 0.f, 0.f}, a1 = {0.f, 0.f, 0.f, 0.f}; \
                _Pragma("unroll") for (int ks = 0; ks < 8; ++ks) { const bf16x8 af = *(const bf16x8*)(at + ks * 32); \
                    a0 = __builtin_amdgcn_mfma_f32_16x16x32_bf16(af, uf[0][ks], a0, 0, 0, 0); a1 = __builtin_amdgcn_mfma_f32_16x16x32_bf16(af, uf[1][ks], a1, 0, 0, 0); } \
                *(f32x4*)(sl + (size_t)(32 * wid + fr) * 256 + (Rt) * 16 + 4 * q) = a0; \
                *(f32x4*)(sl + (size_t)(32 * wid + 16 + fr) * 256 + (Rt) * 16 + 4 * q) = a1; \
                *(u32x4*)(atile + (((Rt) + 1) & 1) * (16 * 264) + srow * 264 + spc) = RW; \
                LDS_BAR(); } while (0)
            for (int R4 = 0; R4 < 16; R4 += 4) { S5A_STEP(R4, r0, r1); S5A_STEP(R4 + 1, r1, r2); S5A_STEP(R4 + 2, r2, r3); S5A_STEP(R4 + 3, r3, r0); }
#undef S5A_STEP
        }
        asm volatile("s_waitcnt vmcnt(0)" ::: "memory");
        __syncthreads();
        {
            float L0r, L0i, L1r, L1i, qr_, qi_;
            s5_lambda(P, 0, g, lane, L0r, L0i, qr_, qi_); s5_lambda(P, 1, g, lane, L1r, L1i, qr_, qi_);
#pragma unroll
            for (int i = 0; i < 4; ++i) { float t = L0r * L0r - L0i * L0i; L0i = 2.f * L0r * L0i; L0r = t; t = L1r * L1r - L1i * L1i; L1i = 2.f * L1r * L1i; L1r = t; }
            float h0r = 0.f, h0i = 0.f, h1r = 0.f, h1i = 0.f;
            for (int j0 = 0; j0 < 32; j0 += 8) {
                float x0r[8], x0i[8], x1r[8], x1i[8];
#pragma unroll
                for (int i = 0; i < 8; ++i) { const int j = 32 * wid + j0 + i, c0 = j, c1 = 255 - j;
                    x0r[i] = sl[(size_t)c0 * 256 + lane]; x0i[i] = sl[(size_t)c0 * 256 + 64 + lane]; x1r[i] = sl[(size_t)c1 * 256 + 128 + lane]; x1i[i] = sl[(size_t)c1 * 256 + 192 + lane]; }
#pragma unroll
                for (int i = 0; i < 8; ++i) { float t = L0r * h0r - L0i * h0i + x0r[i]; h0i = L0r * h0i + L0i * h0r + x0i[i]; h0r = t; t = L1r * h1r - L1i * h1i + x1r[i]; h1i = L1r * h1i + L1i * h1r + x1i[i]; h1r = t; }
            }
            *(f32x4*)(tbuf + ((wid * 64 + lane) * 4)) = (f32x4){h0r, h0i, h1r, h1i};
            __syncthreads();
            float P0r = L0r, P0i = L0i, P1r = L1r, P1i = L1i;
#pragma unroll
            for (int i = 0; i < 5; ++i) { float t = P0r * P0r - P0i * P0i; P0i = 2.f * P0r * P0i; P0r = t; t = P1r * P1r - P1i * P1i; P1i = 2.f * P1r * P1i; P1r = t; }
            h0r = 0.f; h0i = 0.f; h1r = 0.f; h1i = 0.f;
            for (int w2 = 0; w2 < wid; ++w2) { const f32x4 tv = *(const f32x4*)(tbuf + ((w2 * 64 + lane) * 4));
                float t = P0r * h0r - P0i * h0i + tv[0]; h0i = P0r * h0i + P0i * h0r + tv[1]; h0r = t; t = P1r * h1r - P1i * h1i + tv[2]; h1i = P1r * h1i + P1i * h1r + tv[3]; h1r = t; }
            for (int j0 = 0; j0 < 32; j0 += 8) {
                float x0r[8], x0i[8], x1r[8], x1i[8];
#pragma unroll
                for (int i = 0; i < 8; ++i) { const int j = 32 * wid + j0 + i, c0 = j, c1 = 255 - j;
                    x0r[i] = sl[(size_t)c0 * 256 + lane]; x0i[i] = sl[(size_t)c0 * 256 + 64 + lane]; x1r[i] = sl[(size_t)c1 * 256 + 128 + lane]; x1i[i] = sl[(size_t)c1 * 256 + 192 + lane]; }
#pragma unroll
                for (int i = 0; i < 8; ++i) { const int j = 32 * wid + j0 + i, c0 = j, c1 = 255 - j;
                    Sc[c0 * 264 + lane] = f2bf(h0r); Sc[c0 * 264 + 64 + lane] = f2bf(h0i); Sc[c1 * 264 + 128 + lane] = f2bf(h1r); Sc[c1 * 264 + 192 + lane] = f2bf(h1i);
                    float t = L0r * h0r - L0i * h0i + x0r[i]; h0i = L0r * h0i + L0i * h0r + x0i[i]; h0r = t; t = L1r * h1r - L1i * h1i + x1r[i]; h1i = L1r * h1i + L1i * h1r + x1i[i]; h1r = t; }
            }
        }
        __syncthreads();
        {
            const int srow = tid >> 5, spc = (tid & 31) * 8;
#define S5C_SRC(h) (A2 + (size_t)((((h) & 31) >> 1) * 16 + srow) * 512 + ((h) & 1) * 256 + spc)
            *(u32x4*)(atile + srow * 264 + spc) = *(const u32x4*)S5C_SRC(0);
            u32x4 r0, r1 = *(const u32x4*)S5C_SRC(1), r2 = *(const u32x4*)S5C_SRC(2), r3 = *(const u32x4*)S5C_SRC(3);
            __syncthreads();
            f32x4 a0 = {0.f, 0.f, 0.f, 0.f}, a1 = {0.f, 0.f, 0.f, 0.f};
#define S5C_STEP(hs, RL, RW) do { \
                RL = *(const u32x4*)S5C_SRC((hs) + 4); \
                const bf16_t* at = atile + ((hs) & 1) * (16 * 264) + fr * 264 + 8 * q; \
                if (((hs) & 1) == 0) { \
                    _Pragma("unroll") for (int ks = 0; ks < 8; ++ks) { const bf16x8 af = *(const bf16x8*)(at + ks * 32); \
                        a0 = __builtin_amdgcn_mfma_f32_16x16x32_bf16(af, uf[0][ks], a0, 0, 0, 0); a1 = __builtin_amdgcn_mfma_f32_16x16x32_bf16(af, uf[1][ks], a1, 0, 0, 0); } \
                } else { \
                    _Pragma("unroll") for (int ks = 0; ks < 8; ++ks) { const bf16x8 af = *(const bf16x8*)(at + ks * 32); \
                        const bf16x8 b0 = *(const bf16x8*)(Sc + (32 * wid + fr) * 264 + ks * 32 + 8 * q), b1 = *(const bf16x8*)(Sc + (32 * wid + 16 + fr) * 264 + ks * 32 + 8 * q); \
                        a0 = __builtin_amdgcn_mfma_f32_16x16x32_bf16(af, b0, a0, 0, 0, 0); a1 = __builtin_amdgcn_mfma_f32_16x16x32_bf16(af, b1, a1, 0, 0, 0); } \
                    const int ch = g * 16 + 4 * q, rt = (hs) >> 1; \
                    _Pragma("unroll") for (int ct = 0; ct < 2; ++ct) { \
                        const int c = 32 * wid + 16 * ct + fr; const size_t tok = (size_t)b * SEQ + c * 16 + rt; \
                        const f32x4 av = ct ? a1 : a0; float y[4]; \
                        _Pragma("unroll") for (int r = 0; r < 4; ++r) { const float yy = av[r]; y[r] = yy * fsig(1.5957691216057308f * (yy + 0.044715f * yy * yy * yy)); } \
                        u32x2 o; o.x = pg8::cvt_pk_bf16(y[0], y[1]); o.y = pg8::cvt_pk_bf16(y[2], y[3]); \
                        *(u32x2*)(gout + tok * DM + ch) = o; } \
                    a0 = (f32x4){0.f, 0.f, 0.f, 0.f}; a1 = (f32x4){0.f, 0.f, 0.f, 0.f}; \
                } \
                *(u32x4*)(atile + (((hs) + 1) & 1) * (16 * 264) + srow * 264 + spc) = RW; \
                LDS_BAR(); } while (0)
            for (int h4 = 0; h4 < 32; h4 += 4) { S5C_STEP(h4, r0, r1); S5C_STEP(h4 + 1, r1, r2); S5C_STEP(h4 + 2, r2, r3); S5C_STEP(h4 + 3, r3, r0); }
#undef S5C_STEP
#undef S5C_SRC
        }
        __syncthreads();
    }
}

#define XB_TMO      128
#define XB_XCNT(j)  (256  + 64 * (j))
#define XB_XSUB(j)  (1280 + 64 * (j))
#define XB_XGEN(j)  (2304 + 64 * (j))
#define XB_TOP      3328
#define XB_TOPGEN   3392
#define XCD_BAR_WORDS 3456
#define XB_SPIN_CAP (1u << 18)
constexpr size_t OFF_BAR = 255 * MiB;
constexpr int LDS_ST_OFF = (int)LDS_BYTES - 16;
__device__ __forceinline__ unsigned xb_ld(unsigned* p)              { return __hip_atomic_load(p, __ATOMIC_RELAXED, __HIP_MEMORY_SCOPE_AGENT); }
__device__ __forceinline__ unsigned xb_add(unsigned* p, unsigned v) { return __hip_atomic_fetch_add(p, v, __ATOMIC_RELAXED, __HIP_MEMORY_SCOPE_AGENT); }
__device__ __forceinline__ unsigned xb_xcc_id() { return (unsigned)__builtin_amdgcn_s_getreg((3 << 11) | 20) & 0xFu; }
#define XB_SPIN(cond, bar) do { unsigned _sp = 0; while (cond) { __builtin_amdgcn_s_sleep(1); \
    if ((++_sp & 255u) == 0u) { if (xb_ld(&(bar)[XB_TMO])) break; if (_sp > XB_SPIN_CAP) { atomicAdd(&(bar)[XB_TMO], 1u); break; } } } } while (0)
struct XcdBarrier { unsigned* bar; unsigned x; volatile PG8_LAS unsigned* st; };
__device__ __forceinline__ XcdBarrier xcd_barrier_post(unsigned* bar, volatile PG8_LAS unsigned* st) {
    XcdBarrier b; b.bar = bar; b.x = xb_xcc_id(); b.st = st;
    if (threadIdx.x == 0) (void)xb_add(&bar[XB_XCNT(b.x)], 1u);
    return b;
}
__device__ __forceinline__ void xcd_barrier_complete(unsigned* bar, unsigned x, unsigned& nloc, unsigned& nx) {
    const unsigned G = gridDim.x * gridDim.y * gridDim.z;
    unsigned sum, cnt, mine, sp = 0u;
    for (;;) {
        sum = 0u; cnt = 0u; mine = 0u;
#pragma unroll
        for (unsigned j = 0; j < 16; ++j) { const unsigned c = xb_ld(&bar[XB_XCNT(j)]); sum += c; cnt += (c > 0u) ? 1u : 0u; mine = (j == x) ? c : mine; }
        if (sum == G) break;
        __builtin_amdgcn_s_sleep(1);
        if ((++sp & 255u) == 0u) { if (xb_ld(&bar[XB_TMO])) break; if (sp > XB_SPIN_CAP) { atomicAdd(&bar[XB_TMO], 1u); break; } }
    }
    nloc = mine > 0u ? mine : 1u; nx = cnt > 0u ? cnt : 1u;
}
__device__ __forceinline__ void xcd_barrier(const XcdBarrier& b) {
    asm volatile("s_waitcnt vmcnt(0)" ::: "memory");
    __syncthreads();
    if (threadIdx.x == 0) {
        unsigned* bar = b.bar;
        __builtin_amdgcn_s_waitcnt(0);
        unsigned nloc = b.st[0], nx = b.st[1];
        if (nloc == 0u) { xcd_barrier_complete(bar, b.x, nloc, nx); b.st[0] = nloc; b.st[1] = nx; }
        const unsigned old = xb_add(&bar[XB_XSUB(b.x)], 1u);
        const unsigned gen = old / nloc;
        if (old + 1u == (gen + 1u) * nloc) {
            __builtin_amdgcn_fence(__ATOMIC_RELEASE, "agent");
            asm volatile("s_waitcnt vmcnt(0)" ::: "memory");
            const unsigned og = xb_add(&bar[XB_TOP], 1u);
            const unsigned tg = og / nx;
            if (og + 1u == (tg + 1u) * nx) xb_add(&bar[XB_TOPGEN], 1u);
            else XB_SPIN(xb_ld(&bar[XB_TOPGEN]) == tg, bar);
            __builtin_amdgcn_fence(__ATOMIC_ACQUIRE, "agent");
            xb_add(&bar[XB_XGEN(b.x)], 1u);
            asm volatile("s_waitcnt vmcnt(0)" ::: "memory");
        } else {
            XB_SPIN(xb_ld(&bar[XB_XGEN(b.x)]) == gen, bar);
            __builtin_amdgcn_fence(__ATOMIC_ACQUIRE, "agent");
            asm volatile("s_waitcnt vmcnt(0)" ::: "memory");
        }
    }
    __syncthreads();
}

constexpr int NPH = 32;
#define PH(k, body) if (lo <= (k) && (k) < hi) { { unsigned char* ws = P.ws; bf16_t* abuf = (bf16_t*)(ws + OFF_ABUF); bf16_t* proj = (bf16_t*)(ws + OFF_R); bf16_t* gbuf = (bf16_t*)(ws + OFF_G); bf16_t* hbuf = (bf16_t*)P.out; (void)abuf; (void)proj; (void)gbuf; (void)hbuf; body; } if ((k) + 1 < hi) xcd_barrier(xbar); }
#ifndef USE_NAIVE_GEMM
#define USE_NAIVE_GEMM 0
#endif
#define GEMM(A_, lda_, B_, ldb_, M_, N_, K_, EPI_, ...) { const GemmArgs g_ = mkgemm(A_, lda_, B_, ldb_, M_, N_, K_, EPI_, __VA_ARGS__); if (USE_NAIVE_GEMM) gemm_naive(g_, (float*)lds); else gemm_pg8<EPI_>((PG8_LAS unsigned char*)lds, g_); }
#define W_UPL ((bf16_t*)(ws + (layer ? W_UP1 : W_UP0)))
#define W_DNL ((bf16_t*)(ws + (layer ? W_DN1 : W_DN0)))
#define W_GTL ((bf16_t*)(ws + (layer ? W_GT1 : W_GT0)))
#define W_PPL ((bf16_t*)(ws + (layer ? W_PP1 : W_PP0)))
#define PPBUF ((bf16_t*)(ws + OFF_R))
#define PBF ((bf16_t*)(ws + OFF_R + 64 * MiB))
__device__ __forceinline__ void ffn_section(const Params& P, const int layer, const int base, const int lo, const int hi, const XcdBarrier& xbar, unsigned char* lds) {
    PH(base + 0, { if (layer == 0) ph_s5_setup(P, lds); ph_norm16(hbuf, P.ffn_norm_w + layer * DM, abuf, nullptr); })
    PH(base + 1, GEMM(abuf, DM, W_UPL, DM, T_TOK, 2816, DM, EPI_BF16, proj, 2816))
    PH(base + 2, ph_ffn_conv(P, layer, 0))
    PH(base + 3, GEMM(abuf, DM, W_UPL + (size_t)2816 * DM, DM, T_TOK, 2816, DM, EPI_BF16, proj, 2816))
    PH(base + 4, GEMM(gbuf, FH, W_DNL, 2816, T_TOK, DM, FH, EPI_RES16, hbuf, DM, (const float*)hbuf))
    PH(base + 5, ph_ffn_conv(P, layer, 1))
    PH(base + 6, GEMM(gbuf, FH, W_DNL + FH, 2816, T_TOK, DM, FH, EPI_RES16, hbuf, DM, (const float*)hbuf))
    PH(base + 7, { ph_norm16(hbuf, P.ple_norm_w + layer * DM, abuf, nullptr); ph_cvt_copy(P.p + (size_t)layer * T_TOK * 256, PBF, (size_t)T_TOK * 256); })
    PH(base + 8, { GEMM(PBF, 256, W_PPL, 256, T_TOK, DM, 256, EPI_BF16, PPBUF, DM) GEMM(abuf, DM, W_GTL, DM, T_TOK, DM, DM, EPI_PLE16, (layer ? gbuf : hbuf), DM, (const float*)hbuf, (const float*)PPBUF) })
}

__global__ void __launch_bounds__(NT, 2) mega(Params P) {
    extern __shared__ __attribute__((aligned(16))) unsigned char lds[];
    cg::grid_group grid = cg::this_grid();
    const int lo = P.ph_lo, hi = P.ph_hi;
    if (lo < 0) grid.sync();
    volatile PG8_LAS unsigned* xst = (volatile PG8_LAS unsigned*)((PG8_LAS unsigned char*)lds + LDS_ST_OFF);
    if (threadIdx.x < 4) xst[threadIdx.x] = 0u;
    __syncthreads();
    const XcdBarrier xbar = xcd_barrier_post((unsigned*)(P.ws + OFF_BAR), xst);
    PH(0, { cvt_weights0(P, (float*)lds); ph_norm(P.x, P.mix_norm_w, abuf, nullptr); })
    PH(1, GEMM(abuf, DM, (bf16_t*)(ws + W_IN) + (size_t)2048 * DM, DM, T_TOK, LDP, DM, EPI_BF16, proj, LDP))
    PH(2, ph_ssd_halo(P))
    PH(3, ph_ssd_bcconv(P, lds))
    PH(4, ph_ssd_scan(P, lds))
    PH(5, GEMM(abuf, DM, (bf16_t*)(ws + W_IN), DM, T_TOK, 2048, DM, EPI_ZGATE, proj, LDP, nullptr, nullptr, (const bf16_t*)(ws + OFF_YF), (const bf16_t*)P.out))
    PH(6, { ph_gn_scale(P); cvt_weights1(P, (float*)lds); })
    PH(7, GEMM(proj, LDP, (bf16_t*)(ws + W_OUT), 2048, T_TOK, DM, 2048, EPI_RESX, hbuf, DM, P.x))
    ffn_section(P, 0, 8, lo, hi, xbar, lds);
    PH(18, ph_norm16(hbuf, P.mix_norm_w + DM, abuf, nullptr))
    PH(19, ph_s5_main(P, lds))
    PH(20, GEMM(gbuf, DM, (bf16_t*)(ws + W_GLU), DM, T_TOK, 2048, DM, EPI_GLU16, hbuf, DM, (const float*)hbuf, nullptr, nullptr, nullptr, P.s5_b_glu))
    ffn_section(P, 1, 21, lo, hi, xbar, lds);
    PH(31, ph_norm16(gbuf, P.final_norm_w, nullptr, P.out))
}

extern "C" void kernel_launch(void* const* d_in, const int* in_sizes, int n_in, void* d_out, int out_size, void* d_ws, size_t ws_size, hipStream_t stream) {
    static int grid_blocks = 0;
    if (!grid_blocks) {
        int dev = 0, cus = 0, per_cu = 0;
        hipGetDevice(&dev);
        hipDeviceGetAttribute(&cus, hipDeviceAttributeMultiprocessorCount, dev);
        hipFuncSetAttribute((const void*)mega, hipFuncAttributeMaxDynamicSharedMemorySize, (int)LDS_BYTES);
        hipOccupancyMaxActiveBlocksPerMultiprocessor(&per_cu, (const void*)mega, NT, LDS_BYTES);
        if (per_cu < 1) per_cu = 1;
        grid_blocks = cus * per_cu;
        if (ws_size < 256 * MiB) fprintf(stderr, "workspace too small: %zu\n", ws_size);
    }
    Params P{};
    const float** pp = (const float**)&P;
    for (int i = 0; i < 30; ++i) pp[i] = (const float*)d_in[i];
    P.out = (float*)d_out; P.ws = (unsigned char*)d_ws;
#if COOP
    (void)hipMemsetAsync((unsigned char*)d_ws + OFF_BAR, 0, XCD_BAR_WORDS * 4, stream);
    P.ph_lo = 0; P.ph_hi = NPH;
    void* args[] = {&P};
    hipError_t e = hipLaunchCooperativeKernel((const void*)mega, dim3(grid_blocks), dim3(NT), args, LDS_BYTES, stream);
    if (e != hipSuccess) fprintf(stderr, "cooperative launch failed: %s (grid %d)\n", hipGetErrorString(e), grid_blocks);
#else
    for (int ph = 0; ph < NPH; ++ph) {
        P.ph_lo = ph; P.ph_hi = ph + 1;
        hipLaunchKernelGGL(mega, dim3(grid_blocks), dim3(NT), LDS_BYTES, stream, P);
    }
#endif
}
```

```cpp
#include <hip/hip_runtime.h>
#include <hip/hip_cooperative_groups.h>
#include <cstdio>
namespace cg = cooperative_groups;

#ifndef COOP
#define COOP 1
#endif

typedef unsigned short bf16_t;
typedef float f32x4 __attribute__((ext_vector_type(4)));
typedef unsigned u32x4 __attribute__((ext_vector_type(4)));
typedef unsigned u32x2 __attribute__((ext_vector_type(2)));

constexpr int NT = 512;
constexpr int T_TOK = 16384, DM = 1024, SEQ = 4096, NB = 4;
constexpr int LDP = 3328;
constexpr int FH = 1408;
constexpr float EPS = 1e-6f;
constexpr size_t MiB = 1u << 20;
constexpr size_t OFF_W0 = 0;
constexpr size_t W_IN = OFF_W0, W_OUT = W_IN + (size_t)5376 * 1024 * 2, W_UP0 = W_OUT + 4 * MiB, W_DN0 = W_UP0 + 11 * MiB, W_GT0 = W_DN0 + (size_t)1024 * 2816 * 2, W_PP0 = W_GT0 + 2 * MiB;
constexpr size_t OFF_ABUF = 34 * MiB;
constexpr size_t OFF_R = 66 * MiB;
constexpr size_t OFF_G = 186 * MiB;
constexpr size_t OFF_W1 = 230 * MiB;
constexpr size_t W_GLU = OFF_W1, W_UP1 = W_GLU + 4 * MiB, W_DN1 = W_UP1 + 11 * MiB, W_GT1 = W_DN1 + (size_t)1024 * 2816 * 2, W_PP1 = W_GT1 + 2 * MiB;
constexpr size_t OFF_YF = 186 * MiB;
constexpr size_t OFF_SMALL = 253 * MiB;
constexpr size_t LDS_BYTES = 160 * 1024;

struct Params {
    const float *x, *p, *ssd_w_in, *ssd_conv_w, *ssd_conv_b, *ssd_dt_bias, *ssd_a_log, *ssd_d, *ssd_norm_w, *ssd_w_out;
    const float *s5_a_re, *s5_a_im, *s5_log_step, *s5_b_re, *s5_b_im, *s5_c_re, *s5_c_im, *s5_d, *s5_w_glu, *s5_b_glu;
    const float *mix_norm_w, *ffn_norm_w, *ffn_w_up, *ffn_conv_w, *ffn_conv_b, *ffn_w_down, *ple_norm_w, *ple_w_gate, *ple_w_proj, *final_norm_w;
    float* out; unsigned char* ws;
    int ph_lo, ph_hi;
};

__device__ __forceinline__ int otid() { int t = (int)__builtin_amdgcn_workitem_id_x(); asm volatile("" : "+v"(t)); return t & (NT - 1); }
__device__ __forceinline__ float bf2f(bf16_t b) { return __uint_as_float(((unsigned)b) << 16); }
__device__ __forceinline__ bf16_t f2bf(float f) { unsigned u = __float_as_uint(f); u += 0x7FFFu + ((u >> 16) & 1u); return (bf16_t)(u >> 16); }
__device__ __forceinline__ unsigned pack2(float lo, float hi) { return (unsigned)f2bf(lo) | ((unsigned)f2bf(hi) << 16); }
__device__ __forceinline__ float siluf(float v) { return v / (1.0f + __expf(-v)); }
__device__ __forceinline__ float sigmf(float v) { return 1.0f / (1.0f + __expf(-v)); }
__device__ __forceinline__ float wave_sum(float v) {
#pragma unroll
    for (int o = 32; o >= 1; o >>= 1) v += __shfl_xor(v, o);
    return v;
}

#define PG8_LAS __attribute__((address_space(3)))
typedef short bf16x8 __attribute__((ext_vector_type(8)));
namespace pg8 {
constexpr int BM = 256, BK = 64, HALF = 128, HTB = HALF * BK * 2, STAGE_BYTES = 8 * HTB, NXCD = 8, WGM = 8;
__device__ __forceinline__ int lds_byte(int r, int c) { const int st = (r >> 4) * 2 + (c >> 5), rr = r & 15, cc = c & 31, ob = rr * 64 + cc * 2; return st * 1024 + (ob ^ (((ob >> 9) & 1) << 5)); }
__device__ __forceinline__ void stage_rc(int b, int& R, int& C) { const int st = b / 1024, sb = b % 1024, swz = sb ^ (((sb >> 9) & 1) << 5); R = (st >> 1) * 16 + swz / 64; C = (st & 1) * 32 + (swz % 64) / 2; }
__device__ __forceinline__ int perm32(int rho) { const int n = rho >> 4, i = rho & 15; return 8 * (i >> 2) + 4 * n + (i & 3); }
struct Unit { int pm, pn; };
struct StaticOrder {
    int nM, nN, nwg, G, c;
    __device__ void init(int M, int N, int G_, int c_) { nM = M / BM; nN = N / BM; nwg = nM * nN; G = G_; c = c_; }
    __device__ bool next(int i, Unit& u) const {
        const long L = (long)i * G + c; if (L >= nwg) return false;
        int wgid = (int)L; { const int q = nwg / NXCD, r = nwg % NXCD, xcd = wgid % NXCD, off = wgid / NXCD; wgid = (xcd < r ? xcd * (q + 1) : r * (q + 1) + (xcd - r) * q) + off; }
        const int nig = WGM * nN, gid = wgid / nig, fm = gid * WGM, gsz = (nM - fm) < WGM ? (nM - fm) : WGM;
        u.pm = fm + ((wgid % nig) % gsz); u.pn = (wgid % nig) / gsz; return true;
    }
};
typedef __bf16 bf16x2_t __attribute__((ext_vector_type(2)));
typedef float f32x2_t __attribute__((ext_vector_type(2)));
__device__ __forceinline__ unsigned cvt_pk_bf16(float lo, float hi) { const f32x2_t v = {lo, hi}; union { bf16x2_t b; unsigned u; } r; r.b = __builtin_convertvector(v, bf16x2_t); return r.u; }
}
__device__ __forceinline__ float fsig(float v) { return __builtin_amdgcn_rcpf(1.0f + __expf(-v)); }
__device__ __forceinline__ void unpack8(const u32x4 v, float (&f)[8]) {
#pragma unroll
    for (int j = 0; j < 4; ++j) { f[2 * j] = __uint_as_float(v[j] << 16); f[2 * j + 1] = __uint_as_float(v[j] & 0xffff0000u); }
}
__device__ __forceinline__ f32x4 bf4lo(unsigned a, unsigned b) { return (f32x4){__uint_as_float(a << 16), __uint_as_float(a & 0xffff0000u), __uint_as_float(b << 16), __uint_as_float(b & 0xffff0000u)}; }

struct WDesc { const float* W; bf16_t* Wt; int K, Nsrc, Ndst, mode, H, ntiles; };
__device__ __forceinline__ void cvt_tile(const WDesc& d, int tile, float* lds) {
    const int tid = threadIdx.x, nnt = d.Ndst / 64;
    const int n0 = (tile % nnt) * 64, k0 = (tile / nnt) * 64;
    int src0;
    if (d.mode == 0) src0 = (n0 < d.Nsrc) ? n0 : -1;
    else { const int pn = n0 / 256, w = n0 % 256; src0 = (w < 128) ? pn * 128 + w : d.H + pn * 128 + (w - 128); }
    __syncthreads();
#pragma unroll
    for (int i = 0; i < 2; ++i) {
        const int r = (tid >> 4) + 32 * i, c4 = (tid & 15) * 4;
        f32x4 v = {0.f, 0.f, 0.f, 0.f};
        if (src0 >= 0) v = *(const f32x4*)(d.W + (size_t)(k0 + r) * d.Nsrc + src0 + c4);
#pragma unroll
        for (int j = 0; j < 4; ++j) lds[r * 65 + c4 + j] = v[j];
    }
    __syncthreads();
    {
        const int nr = tid >> 3, kp = (tid & 7) * 8;
        u32x4 o;
#pragma unroll
        for (int j = 0; j < 4; ++j) o[j] = pg8::cvt_pk_bf16(lds[(kp + 2 * j) * 65 + nr], lds[(kp + 2 * j + 1) * 65 + nr]);
        *(u32x4*)(d.Wt + (size_t)(n0 + nr) * d.K + k0 + kp) = o;
    }
}
__device__ __forceinline__ WDesc mkdesc(const float* W, bf16_t* Wt, int K, int Nsrc, int Ndst, int mode, int H) { WDesc d; d.W = W; d.Wt = Wt; d.K = K; d.Nsrc = Nsrc; d.Ndst = Ndst; d.mode = mode; d.H = H; d.ntiles = (K / 64) * (Ndst / 64); return d; }
#define CVT_ONE(W, Wt, K, Ns, Nd, mode, H) { const int n_ = ((K) / 64) * ((Nd) / 64); if (tt >= 0 && tt < n_) { const WDesc d_ = mkdesc(W, Wt, K, Ns, Nd, mode, H); cvt_tile(d_, tt, lds); } tt -= n_; }
__device__ __forceinline__ void cvt_weights0(const Params& P, float* lds) {
    unsigned char* ws = P.ws;
    for (int t = blockIdx.x; t < 1344 + 512 + 1408 + 704 + 256 + 64; t += gridDim.x) {
        int tt = t;
        CVT_ONE(P.ssd_w_in, (bf16_t*)(ws + W_IN), 1024, 5184, 5376, 0, 0)
        CVT_ONE(P.ssd_w_out, (bf16_t*)(ws + W_OUT), 2048, 1024, 1024, 0, 0)
        CVT_ONE(P.ffn_w_up, (bf16_t*)(ws + W_UP0), 1024, 5632, 5632, 1, 2816)
        CVT_ONE(P.ffn_w_down, (bf16_t*)(ws + W_DN0), 2816, 1024, 1024, 0, 0)
        CVT_ONE(P.ple_w_gate, (bf16_t*)(ws + W_GT0), 1024, 1024, 1024, 0, 0)
        CVT_ONE(P.ple_w_proj, (bf16_t*)(ws + W_PP0), 256, 1024, 1024, 0, 0)
    }
}
__device__ __forceinline__ void cvt_weights1(const Params& P, float* lds) {
    unsigned char* ws = P.ws;
    for (int t = blockIdx.x; t < 512 + 1408 + 704 + 256 + 64; t += gridDim.x) {
        int tt = t;
        CVT_ONE(P.s5_w_glu, (bf16_t*)(ws + W_GLU), 1024, 2048, 2048, 1, 1024)
        CVT_ONE(P.ffn_w_up + (size_t)1024 * 5632, (bf16_t*)(ws + W_UP1), 1024, 5632, 5632, 1, 2816)
        CVT_ONE(P.ffn_w_down + (size_t)2816 * 1024, (bf16_t*)(ws + W_DN1), 2816, 1024, 1024, 0, 0)
        CVT_ONE(P.ple_w_gate + (size_t)1024 * 1024, (bf16_t*)(ws + W_GT1), 1024, 1024, 1024, 0, 0)
        CVT_ONE(P.ple_w_proj + (size_t)256 * 1024, (bf16_t*)(ws + W_PP1), 256, 1024, 1024, 0, 0)
    }
}
__device__ __forceinline__ void ph_norm(const float* src, const float* w, bf16_t* dstb, float* dstf) {
    const int lane = threadIdx.x & 63, wid = threadIdx.x >> 6;
    for (int row = blockIdx.x * 8 + wid; row < T_TOK; row += gridDim.x * 8) {
        const float* s = src + (size_t)row * DM;
        f32x4 v[4]; float ss = 0.f;
#pragma unroll
        for (int i = 0; i < 4; ++i) { v[i] = *(const f32x4*)(s + lane * 4 + 256 * i); ss += v[i][0] * v[i][0] + v[i][1] * v[i][1] + v[i][2] * v[i][2] + v[i][3] * v[i][3]; }
        ss = wave_sum(ss);
        const float rstd = rsqrtf(ss * (1.0f / DM) + EPS);
#pragma unroll
        for (int i = 0; i < 4; ++i) {
            const f32x4 wv = *(const f32x4*)(w + lane * 4 + 256 * i);
            const f32x4 o = v[i] * rstd * wv;
            if (dstb) { u32x2 pk; pk.x = pack2(o[0], o[1]); pk.y = pack2(o[2], o[3]); *(u32x2*)(dstb + (size_t)row * DM + lane * 4 + 256 * i) = pk; }
            else *(f32x4*)(dstf + (size_t)row * DM + lane * 4 + 256 * i) = o;
        }
    }
}
__device__ __forceinline__ void ph_norm16(const bf16_t* src, const float* w, bf16_t* dstb, float* dstf) {
    const int lane = threadIdx.x & 63, wid = threadIdx.x >> 6;
    for (int row = blockIdx.x * 8 + wid; row < T_TOK; row += gridDim.x * 8) {
        const bf16_t* sp = src + (size_t)row * DM;
        float v[2][8]; float ss = 0.f;
#pragma unroll
        for (int i = 0; i < 2; ++i) { unpack8(*(const u32x4*)(sp + lane * 8 + 512 * i), v[i]);
#pragma unroll
            for (int j = 0; j < 8; ++j) ss += v[i][j] * v[i][j]; }
        ss = wave_sum(ss);
        const float rstd = rsqrtf(ss * (1.0f / DM) + EPS);
#pragma unroll
        for (int i = 0; i < 2; ++i) {
            const f32x4 w0 = *(const f32x4*)(w + lane * 8 + 512 * i), w1 = *(const f32x4*)(w + lane * 8 + 512 * i + 4);
            float o[8];
#pragma unroll
            for (int j = 0; j < 4; ++j) { o[j] = v[i][j] * rstd * w0[j]; o[4 + j] = v[i][4 + j] * rstd * w1[j]; }
            if (dstb) { u32x4 pk; pk.x = pg8::cvt_pk_bf16(o[0], o[1]); pk.y = pg8::cvt_pk_bf16(o[2], o[3]); pk.z = pg8::cvt_pk_bf16(o[4], o[5]); pk.w = pg8::cvt_pk_bf16(o[6], o[7]); *(u32x4*)(dstb + (size_t)row * DM + lane * 8 + 512 * i) = pk; }
            else { *(f32x4*)(dstf + (size_t)row * DM + lane * 8 + 512 * i) = (f32x4){o[0], o[1], o[2], o[3]}; *(f32x4*)(dstf + (size_t)row * DM + lane * 8 + 512 * i + 4) = (f32x4){o[4], o[5], o[6], o[7]}; }
        }
    }
}
__device__ __forceinline__ void ph_cvt_copy(const float* src, bf16_t* dst, size_t n) {
    for (size_t i = ((size_t)blockIdx.x * NT + threadIdx.x) * 4; i < n; i += (size_t)gridDim.x * NT * 4) {
        const f32x4 v = *(const f32x4*)(src + i); u32x2 pk; pk.x = pack2(v[0], v[1]); pk.y = pack2(v[2], v[3]); *(u32x2*)(dst + i) = pk;
    }
}

enum { EPI_BF16 = 0, EPI_RES = 1, EPI_F32 = 2, EPI_PLE = 3, EPI_GLU = 4, EPI_ZGATE = 5, EPI_RESX = 6, EPI_RES16 = 7, EPI_PLE16 = 8, EPI_GLU16 = 9 };
struct GemmArgs {
    const bf16_t* A; int lda; const bf16_t* Bt; int ldb; int M, N, K; int epi;
    void* out; int ldc; const float* res; const float* aux; const bf16_t* y1; const bf16_t* y2; const float* bias;
};
__device__ __forceinline__ void epi_store(const GemmArgs& g, int row, int pn, int tc, float acc, float accp) {
    const int col = pn * 256 + tc;
    switch (g.epi) {
        case EPI_BF16: ((bf16_t*)g.out)[(size_t)row * g.ldc + col] = f2bf(acc); break;
        case EPI_RES: { const size_t o = (size_t)row * g.ldc + col; ((float*)g.out)[o] = g.res[o] + acc; } break;
        case EPI_F32: ((float*)g.out)[(size_t)row * g.ldc + col] = acc; break;
        case EPI_PLE: { const size_t o = (size_t)row * g.ldc + col; ((float*)g.out)[o] = g.res[o] + g.aux[o] * sigmf(acc); } break;
        case EPI_GLU: { const int oc = pn * 128 + tc; const size_t o = (size_t)row * g.ldc + oc; ((float*)g.out)[o] = g.res[o] + (acc + g.bias[oc]) * sigmf(accp + g.bias[1024 + oc]); } break;
        case EPI_ZGATE: { const size_t yo = (size_t)row * 2048 + col; ((bf16_t*)g.out)[(size_t)row * g.ldc + col] = f2bf((bf2f(g.y1[yo]) + bf2f(g.y2[yo])) * siluf(acc)); } break;
    }
}
__device__ __forceinline__ void gemm_naive(const GemmArgs& g, float* lds) {
    float* As = lds;
    float* Bs = lds + 32 * 132;
    const int tid = threadIdx.x, ty = tid >> 4, tx = tid & 15;
    const int nM = g.M / 128, nN = g.N / 256;
    for (int tile = blockIdx.x; tile < nM * nN; tile += gridDim.x) {
        const int pm = tile % nM, pn = tile / nM;
        float acc[4][16];
#pragma unroll
        for (int i = 0; i < 4; ++i)
#pragma unroll
            for (int j = 0; j < 16; ++j) acc[i][j] = 0.f;
        for (int k0 = 0; k0 < g.K; k0 += 32) {
            __syncthreads();
            { const int r = tid >> 2, kk = (tid & 3) * 8;
              const u32x4 v = *(const u32x4*)(g.A + (size_t)(pm * 128 + r) * g.lda + k0 + kk);
#pragma unroll
              for (int j = 0; j < 4; ++j) { As[(kk + 2 * j) * 132 + r] = __uint_as_float(v[j] << 16); As[(kk + 2 * j + 1) * 132 + r] = __uint_as_float(v[j] & 0xffff0000u); } }
#pragma unroll
            for (int h = 0; h < 2; ++h) { const int r = (tid >> 2) + 128 * h, kk = (tid & 3) * 8;
              const u32x4 v = *(const u32x4*)(g.Bt + (size_t)(pn * 256 + r) * g.ldb + k0 + kk);
#pragma unroll
              for (int j = 0; j < 4; ++j) { Bs[(kk + 2 * j) * 260 + r] = __uint_as_float(v[j] << 16); Bs[(kk + 2 * j + 1) * 260 + r] = __uint_as_float(v[j] & 0xffff0000u); } }
            __syncthreads();
#pragma unroll 4
            for (int kk = 0; kk < 32; ++kk) {
                const f32x4 a = *(const f32x4*)(As + kk * 132 + ty * 4);
                const f32x4 b0 = *(const f32x4*)(Bs + kk * 260 + tx * 8), b1 = *(const f32x4*)(Bs + kk * 260 + tx * 8 + 4);
                const f32x4 b2 = *(const f32x4*)(Bs + kk * 260 + 128 + tx * 8), b3 = *(const f32x4*)(Bs + kk * 260 + 128 + tx * 8 + 4);
#pragma unroll
                for (int i = 0; i < 4; ++i)
#pragma unroll
                    for (int j = 0; j < 4; ++j) { acc[i][j] += a[i] * b0[j]; acc[i][4 + j] += a[i] * b1[j]; acc[i][8 + j] += a[i] * b2[j]; acc[i][12 + j] += a[i] * b3[j]; }
            }
        }
#pragma unroll
        for (int i = 0; i < 4; ++i) {
            const int row = pm * 128 + ty * 4 + i;
#pragma unroll
            for (int j = 0; j < 8; ++j) {
                if (g.epi == EPI_GLU) epi_store(g, row, pn, tx * 8 + j, acc[i][j], acc[i][8 + j]);
                else { epi_store(g, row, pn, tx * 8 + j, acc[i][j], 0.f); epi_store(g, row, pn, 128 + tx * 8 + j, acc[i][8 + j], 0.f); }
            }
        }
    }
}
__device__ __forceinline__ GemmArgs mkgemm(const bf16_t* A, int lda, const bf16_t* Bt, int ldb, int M, int N, int K, int epi, void* out, int ldc,
                                           const float* res = nullptr, const float* aux = nullptr, const bf16_t* y1 = nullptr, const bf16_t* y2 = nullptr, const float* bias = nullptr) {
    GemmArgs g; g.A = A; g.lda = lda; g.Bt = Bt; g.ldb = ldb; g.M = M; g.N = N; g.K = K; g.epi = epi; g.out = out; g.ldc = ldc; g.res = res; g.aux = aux; g.y1 = y1; g.y2 = y2; g.bias = bias; return g;
}

template <int EPI>
__device__ __forceinline__ void epi_tile(const GemmArgs& g, const f32x4 (&acc)[2][2][4][2], const pg8::Unit& u, int wr, int wc, int fr, int fq) {
    const int row0 = u.pm * 256 + wr * 64 + fr;
    if constexpr (EPI == EPI_RESX || EPI == EPI_RES16 || EPI == EPI_PLE16 || EPI == EPI_GLU16) {
        constexpr int NBJ = (EPI == EPI_GLU16) ? 1 : 2;
        const int col0 = (EPI == EPI_GLU16 ? u.pn * 128 : u.pn * 256) + wc * 32 + 8 * fq;
        f32x4 bv[2] = {{0.f, 0.f, 0.f, 0.f}, {0.f, 0.f, 0.f, 0.f}}, bg[2] = {{0.f, 0.f, 0.f, 0.f}, {0.f, 0.f, 0.f, 0.f}};
        if constexpr (EPI == EPI_GLU16) {
#pragma unroll
            for (int n = 0; n < 2; ++n) { bv[n] = *(const f32x4*)(g.bias + col0 + 4 * n); bg[n] = *(const f32x4*)(g.bias + 1024 + col0 + 4 * n); }
        }
#pragma unroll
        for (int ai = 0; ai < 2; ++ai)
#pragma unroll
            for (int m = 0; m < 4; ++m) {
                const int row = row0 + ai * 128 + m * 16;
#pragma unroll
                for (int bj = 0; bj < NBJ; ++bj) {
                    const size_t o = (size_t)row * g.ldc + col0 + bj * 128;
                    f32x4 r0, r1;
                    if constexpr (EPI == EPI_RESX) { r0 = *(const f32x4*)(g.res + o); r1 = *(const f32x4*)(g.res + o + 4); }
                    else { const u32x4 rr = *(const u32x4*)((const bf16_t*)g.res + o); r0 = bf4lo(rr[0], rr[1]); r1 = bf4lo(rr[2], rr[3]); }
                    f32x4 v0 = acc[ai][bj][m][0], v1 = acc[ai][bj][m][1];
                    if constexpr (EPI == EPI_PLE16) {
                        const u32x4 aa = *(const u32x4*)((const bf16_t*)g.aux + o); const f32x4 a0 = bf4lo(aa[0], aa[1]), a1 = bf4lo(aa[2], aa[3]);
#pragma unroll
                        for (int j = 0; j < 4; ++j) { v0[j] = a0[j] * fsig(v0[j]); v1[j] = a1[j] * fsig(v1[j]); }
                    }
                    if constexpr (EPI == EPI_GLU16) {
                        const f32x4 g0 = acc[ai][1][m][0] + bg[0], g1 = acc[ai][1][m][1] + bg[1];
                        v0 += bv[0]; v1 += bv[1];
#pragma unroll
                        for (int j = 0; j < 4; ++j) { v0[j] *= fsig(g0[j]); v1[j] *= fsig(g1[j]); }
                    }
                    v0 += r0; v1 += r1;
                    u32x4 w; w.x = pg8::cvt_pk_bf16(v0[0], v0[1]); w.y = pg8::cvt_pk_bf16(v0[2], v0[3]); w.z = pg8::cvt_pk_bf16(v1[0], v1[1]); w.w = pg8::cvt_pk_bf16(v1[2], v1[3]);
                    *(u32x4*)((bf16_t*)g.out + o) = w;
                }
                asm volatile("" ::: "memory");
            }
    } else if constexpr (EPI == EPI_BF16 || EPI == EPI_ZGATE) {
        const int col0 = u.pn * 256 + wc * 32 + 8 * fq;
#pragma unroll
        for (int ai = 0; ai < 2; ++ai)
#pragma unroll
            for (int m = 0; m < 4; ++m) {
                const int row = row0 + ai * 128 + m * 16;
#pragma unroll
                for (int bj = 0; bj < 2; ++bj) {
                    f32x4 v0 = acc[ai][bj][m][0], v1 = acc[ai][bj][m][1];
                    const int col = col0 + bj * 128;
                    if constexpr (EPI == EPI_ZGATE) {
                        const u32x4 a = *(const u32x4*)(g.y1 + (size_t)row * 2048 + col), b = *(const u32x4*)(g.y2 + (size_t)row * 2048 + col);
                        const f32x4 y0 = bf4lo(a[0], a[1]) + bf4lo(b[0], b[1]), y1v = bf4lo(a[2], a[3]) + bf4lo(b[2], b[3]);
#pragma unroll
                        for (int j = 0; j < 4; ++j) { v0[j] = y0[j] * v0[j] * fsig(v0[j]); v1[j] = y1v[j] * v1[j] * fsig(v1[j]); }
                    }
                    u32x4 w; w.x = pg8::cvt_pk_bf16(v0[0], v0[1]); w.y = pg8::cvt_pk_bf16(v0[2], v0[3]); w.z = pg8::cvt_pk_bf16(v1[0], v1[1]); w.w = pg8::cvt_pk_bf16(v1[2], v1[3]);
                    *(u32x4*)((bf16_t*)g.out + (size_t)row * g.ldc + col) = w;
                }
                if constexpr (EPI == EPI_ZGATE) asm volatile("" ::: "memory");
            }
    } else if constexpr (EPI == EPI_GLU) {
        const int col0 = u.pn * 128 + wc * 32 + 4 * fq;
        f32x4 bv[2], bg[2];
#pragma unroll
        for (int n = 0; n < 2; ++n) { bv[n] = *(const f32x4*)(g.bias + col0 + 16 * n); bg[n] = *(const f32x4*)(g.bias + 1024 + col0 + 16 * n); }
#pragma unroll
        for (int ai = 0; ai < 2; ++ai)
#pragma unroll
            for (int m = 0; m < 4; ++m) {
                const int row = row0 + ai * 128 + m * 16;
#pragma unroll
                for (int n = 0; n < 2; ++n) {
                    const size_t o = (size_t)row * g.ldc + col0 + 16 * n;
                    const f32x4 r = *(const f32x4*)(g.res + o), v = acc[ai][0][m][n] + bv[n], gt = acc[ai][1][m][n] + bg[n];
                    f32x4 ov;
#pragma unroll
                    for (int j = 0; j < 4; ++j) ov[j] = r[j] + v[j] * fsig(gt[j]);
                    *(f32x4*)((float*)g.out + o) = ov;
                }
                asm volatile("" ::: "memory");
            }
    } else {
        const int col0 = u.pn * 256 + wc * 32 + 4 * fq;
#pragma unroll
        for (int ai = 0; ai < 2; ++ai)
#pragma unroll
            for (int m = 0; m < 4; ++m) {
                const int row = row0 + ai * 128 + m * 16;
#pragma unroll
                for (int bj = 0; bj < 2; ++bj)
#pragma unroll
                    for (int n = 0; n < 2; ++n) {
                        const size_t o = (size_t)row * g.ldc + col0 + bj * 128 + n * 16;
                        f32x4 ov = acc[ai][bj][m][n];
                        if constexpr (EPI == EPI_RES) ov += *(const f32x4*)(g.res + o);
                        if constexpr (EPI == EPI_PLE) { const f32x4 r = *(const f32x4*)(g.res + o), a = *(const f32x4*)(g.aux + o);
#pragma unroll
                            for (int j = 0; j < 4; ++j) ov[j] = r[j] + a[j] * fsig(ov[j]); }
                        *(f32x4*)((float*)g.out + o) = ov;
                    }
                if constexpr (EPI != EPI_F32) asm volatile("" ::: "memory");
            }
    }
}

template <int EPI>
__device__ __forceinline__ void gemm_pg8(PG8_LAS unsigned char* lds, const GemmArgs g) {
    using namespace pg8;
    constexpr bool PERM = (EPI == EPI_BF16 || EPI == EPI_ZGATE || EPI == EPI_RESX || EPI == EPI_RES16 || EPI == EPI_PLE16 || EPI == EPI_GLU16);
    const int tid = otid(), wid = __builtin_amdgcn_readfirstlane(tid >> 6), lane = tid & 63, wr = wid >> 2, wc = wid & 3, fr = lane & 15, fq = lane >> 4;
    const int K = g.K, nt = K / BK;
    StaticOrder S; S.init(g.M, g.N, (int)gridDim.x, (int)blockIdx.x);
    unsigned voffA[2], voffB[2];
#pragma unroll
    for (int i = 0; i < 2; ++i) { int R, C; stage_rc(tid * 16 + i * 8192, R, C); const int Rb = PERM ? ((R & ~31) + perm32(R & 31)) : R;
        voffA[i] = (unsigned)(R * g.lda + C) * 2u; voffB[i] = (unsigned)(Rb * g.ldb + C) * 2u; }
    const size_t kstep = (size_t)(BK * 2);
    const size_t hstepA = (size_t)HALF * g.lda * 2, hstepB = (size_t)HALF * g.ldb * 2;
    const size_t tstepA = 2 * hstepA, tstepB = 2 * hstepB;
    const unsigned ldsw = (unsigned)wid * 1024u;
    const int aoff = lds_byte(wr * 64 + fr, fq * 8), boff = lds_byte(wc * 32 + fr, fq * 8);
#define PG8_SA(b, h) (((b) * 2 + (h)) * HTB)
#define PG8_SB(b, h) ((4 + (b) * 2 + (h)) * HTB)
#define PG8_STAGE(bufoff, gbase, voff) do { _Pragma("unroll") for (int _i = 0; _i < 2; ++_i) \
        __builtin_amdgcn_global_load_lds((const unsigned*)((const char*)(gbase) + (voff)[_i]), (PG8_LAS unsigned*)(lds + (bufoff) + ldsw + _i * 8192), 16, 0, 0); } while (0)
#define PG8_LDA(dst, b, h) do { _Pragma("unroll") for (int m = 0; m < 4; ++m) _Pragma("unroll") for (int k = 0; k < 2; ++k) dst[m][k] = *(const PG8_LAS bf16x8*)(lds + PG8_SA(b, h) + aoff + m * 2048 + k * 1024); } while (0)
#define PG8_LDB(dst, b, h) do { _Pragma("unroll") for (int n = 0; n < 2; ++n) _Pragma("unroll") for (int k = 0; k < 2; ++k) dst[n][k] = *(const PG8_LAS bf16x8*)(lds + PG8_SB(b, h) + boff + n * 2048 + k * 1024); } while (0)
#define PG8_MMA(ai, bj, At, Bt) do { __builtin_amdgcn_s_setprio(1); _Pragma("unroll") for (int m = 0; m < 4; ++m) _Pragma("unroll") for (int n = 0; n < 2; ++n) _Pragma("unroll") for (int k = 0; k < 2; ++k) \
        acc[ai][bj][m][n] = __builtin_amdgcn_mfma_f32_16x16x32_bf16(Bt[n][k], At[m][k], acc[ai][bj][m][n], 0, 0, 0); __builtin_amdgcn_s_setprio(0); } while (0)
#define PG8_WAIT_V(n) asm volatile("s_waitcnt vmcnt(" #n ")" ::: "memory")
#define PG8_WAIT_L(n) asm volatile("s_waitcnt lgkmcnt(" #n ")" ::: "memory")
#define PG8_BAR __builtin_amdgcn_s_barrier()
#define PG8_SCHED __builtin_amdgcn_sched_barrier(0)
    Unit cur, nxt; int ui = 0;
    if (!S.next(0, cur)) return;
    f32x4 acc[2][2][4][2];
#pragma unroll
    for (int a = 0; a < 2; ++a)
#pragma unroll
        for (int b = 0; b < 2; ++b)
#pragma unroll
            for (int m = 0; m < 4; ++m)
#pragma unroll
                for (int n = 0; n < 2; ++n) acc[a][b][m][n] = (f32x4){0.f, 0.f, 0.f, 0.f};
    bf16x8 At[4][2], B0[2][2], B1[2][2];
    const char* cA = (const char*)g.A + (size_t)cur.pm * tstepA; const char* cB = (const char*)g.Bt + (size_t)cur.pn * tstepB;
    PG8_STAGE(PG8_SB(0, 0), cB, voffB); PG8_STAGE(PG8_SA(0, 0), cA, voffA); PG8_STAGE(PG8_SB(0, 1), cB + hstepB, voffB); PG8_STAGE(PG8_SA(0, 1), cA + hstepA, voffA);
    if (wr == 1) PG8_BAR;
    PG8_WAIT_V(4); PG8_BAR;
    PG8_STAGE(PG8_SB(1, 0), cB + kstep, voffB); PG8_STAGE(PG8_SA(1, 0), cA + kstep, voffA); PG8_STAGE(PG8_SB(1, 1), cB + hstepB + kstep, voffB);
    PG8_WAIT_V(6); PG8_BAR;
    for (;;) {
        const bool has_next = S.next(ui + 1, nxt);
        const char* nA = has_next ? (const char*)g.A + (size_t)nxt.pm * tstepA : cA; const char* nB = has_next ? (const char*)g.Bt + (size_t)nxt.pn * tstepB : cB;
        for (int t = 0; t < nt; t += 2) {
            const bool last = (t == nt - 2);
            const char* a1 = cA + (size_t)(t + 1) * kstep;
            const char* a2 = last ? nA : cA + (size_t)(t + 2) * kstep; const char* b2 = last ? nB : cB + (size_t)(t + 2) * kstep;
            const char* a3 = a2 + kstep; const char* b3 = b2 + kstep;
            PG8_LDB(B0, 0, 0); PG8_SCHED; PG8_LDA(At, 0, 0); PG8_STAGE(PG8_SA(1, 1), a1 + hstepA, voffA);
            PG8_WAIT_L(8); PG8_BAR; PG8_WAIT_L(0); PG8_MMA(0, 0, At, B0); PG8_BAR; PG8_SCHED;
            PG8_LDB(B1, 0, 1); PG8_STAGE(PG8_SB(0, 0), b2, voffB);
            PG8_BAR; PG8_WAIT_L(0); PG8_MMA(0, 1, At, B1); PG8_BAR;
            PG8_LDA(At, 0, 1); PG8_STAGE(PG8_SA(0, 0), a2, voffA);
            PG8_BAR; PG8_WAIT_L(0); PG8_MMA(1, 0, At, B0); PG8_BAR; PG8_SCHED;
            PG8_STAGE(PG8_SB(0, 1), b2 + hstepB, voffB);
            PG8_WAIT_V(6); PG8_BAR; PG8_MMA(1, 1, At, B1); PG8_BAR;
            PG8_LDB(B0, 1, 0); PG8_SCHED; PG8_LDA(At, 1, 0); PG8_STAGE(PG8_SA(0, 1), a2 + hstepA, voffA);
            PG8_WAIT_L(8); PG8_BAR; PG8_WAIT_L(0); PG8_MMA(0, 0, At, B0); PG8_BAR; PG8_SCHED;
            PG8_LDB(B1, 1, 1); PG8_STAGE(PG8_SB(1, 0), b3, voffB);
            PG8_BAR; PG8_WAIT_L(0); PG8_MMA(0, 1, At, B1); PG8_BAR;
            PG8_LDA(At, 1, 1); PG8_STAGE(PG8_SA(1, 0), a3, voffA);
            PG8_BAR; PG8_WAIT_L(0); PG8_MMA(1, 0, At, B0); PG8_BAR; PG8_SCHED;
            PG8_STAGE(PG8_SB(1, 1), b3 + hstepB, voffB);
            PG8_WAIT_V(6); PG8_BAR; PG8_MMA(1, 1, At, B1); PG8_BAR;
        }
        epi_tile<EPI>(g, acc, cur, wr, wc, fr, fq);
        if (!has_next) break;
#pragma unroll
        for (int a = 0; a < 2; ++a)
#pragma unroll
            for (int b = 0; b < 2; ++b)
#pragma unroll
                for (int m = 0; m < 4; ++m)
#pragma unroll
                    for (int n = 0; n < 2; ++n) acc[a][b][m][n] = (f32x4){0.f, 0.f, 0.f, 0.f};
        cur = nxt; cA = nA; cB = nB; ++ui;
    }
    PG8_WAIT_V(0);
    if (wr == 0) PG8_BAR;
    PG8_BAR;
#undef PG8_SA
#undef PG8_SB
#undef PG8_STAGE
#undef PG8_LDA
#undef PG8_LDB
#undef PG8_MMA
#undef PG8_WAIT_V
#undef PG8_WAIT_L
#undef PG8_BAR
#undef PG8_SCHED
}

__device__ __forceinline__ void ph_ssd_halo(const Params& P) {
    bf16_t* proj = (bf16_t*)(P.ws + OFF_R); bf16_t* halo = (bf16_t*)(P.ws + OFF_SMALL);
    const int gt = blockIdx.x * NT + threadIdx.x, gs = gridDim.x * NT;
    for (int i = gt; i < 512 * 4 * 256; i += gs) {
        const int ch = i & 255, hr = (i >> 8) & 3, item = i >> 10;
        const int g = item & 3, c = (item >> 2) & 31, b = item >> 7;
        const int lt = c * 128 + (hr < 2 ? hr - 2 : 126 + hr);
        const int col = 2048 + (ch >> 7) * 512 + g * 128 + (ch & 127);
        bf16_t v = 0;
        if (lt >= 0 && lt < SEQ) v = proj[(size_t)(b * SEQ + lt) * LDP + col];
        halo[i] = v;
    }
    for (int i = gt; i < T_TOK * 64; i += gs) {
        const int j = i & 63, t = i >> 6;
        const float xr = bf2f(proj[(size_t)t * LDP + 3072 + j]) + P.ssd_dt_bias[j];
        const float sp = fmaxf(xr, 0.f) + log1pf(__expf(-fabsf(xr)));
        ((float*)(proj + (size_t)t * LDP + 3136))[j] = sp;
    }
}
constexpr size_t OFF_CB = OFF_R + 104 * MiB;
__device__ __forceinline__ void ph_ssd_bcconv(const Params& P, unsigned char* ldsraw) {
    bf16_t* proj = (bf16_t*)(P.ws + OFF_R); const bf16_t* halo = (const bf16_t*)(P.ws + OFF_SMALL); bf16_t* CBg = (bf16_t*)(P.ws + OFF_CB);
    bf16_t* tile = (bf16_t*)ldsraw;
    bf16_t* cv = tile + 132 * 256;
    const int tid = threadIdx.x, lane = tid & 63, wid = tid >> 6, fr = lane & 15, q = lane >> 4;
    for (int item = blockIdx.x; item < 512; item += gridDim.x) {
        const int g = item & 3, c = (item >> 2) & 31, b = item >> 7;
        const size_t r0 = (size_t)b * SEQ + c * 128;
        __syncthreads();
        for (int i = tid; i < 132 * 32; i += NT) {
            const int co = i & 31, r = i >> 5, ch = co * 8;
            const int col = 2048 + (ch >> 7) * 512 + g * 128 + (ch & 127);
            u32x4 v;
            if (r < 2) v = *(const u32x4*)(halo + (size_t)item * 1024 + r * 256 + ch);
            else if (r >= 130) v = *(const u32x4*)(halo + (size_t)item * 1024 + (r - 128) * 256 + ch);
            else v = *(const u32x4*)(proj + (r0 + r - 2) * LDP + col);
            *(u32x4*)(tile + r * 256 + ch) = v;
        }
        __syncthreads();
        for (int i = tid; i < 128 * 32; i += NT) {
            const int co = i & 31, r = i >> 5, ch = co * 8;
            const int col = 2048 + (ch >> 7) * 512 + g * 128 + (ch & 127);
            float acc[8];
            { const f32x4 b0 = *(const f32x4*)(P.ssd_conv_b + col), b1 = *(const f32x4*)(P.ssd_conv_b + col + 4);
#pragma unroll
              for (int j = 0; j < 4; ++j) { acc[j] = b0[j]; acc[4 + j] = b1[j]; } }
#pragma unroll
            for (int k = 0; k < 5; ++k) {
                float xv[8]; unpack8(*(const u32x4*)(tile + (r + k) * 256 + ch), xv);
                const f32x4 w0 = *(const f32x4*)(P.ssd_conv_w + k * 3072 + col), w1 = *(const f32x4*)(P.ssd_conv_w + k * 3072 + col + 4);
#pragma unroll
                for (int j = 0; j < 4; ++j) { acc[j] += xv[j] * w0[j]; acc[4 + j] += xv[4 + j] * w1[j]; }
            }
            u32x4 o;
#pragma unroll
            for (int j = 0; j < 4; ++j) o[j] = pg8::cvt_pk_bf16(acc[2 * j] * fsig(acc[2 * j]), acc[2 * j + 1] * fsig(acc[2 * j + 1]));
            *(u32x4*)(cv + r * 264 + ch) = o;
            if (ch >= 128) *(u32x4*)(proj + (r0 + r) * LDP + col) = o;
        }
        __syncthreads();
        for (int i = tid; i < 2048; i += NT) {
            const int n = i >> 4, to = (i & 15) * 8; u32x4 o;
#pragma unroll
            for (int j = 0; j < 4; ++j) o[j] = (unsigned)cv[(to + 2 * j) * 264 + n] | ((unsigned)cv[(to + 2 * j + 1) * 264 + n] << 16);
            *(u32x4*)(proj + (r0 + n) * LDP + 2048 + g * 128 + to) = o;
        }
        bf16x8 af[4];
#pragma unroll
        for (int ks = 0; ks < 4; ++ks) af[ks] = *(const bf16x8*)(cv + (16 * wid + fr) * 264 + 32 * ks + 8 * q);
        bf16_t* cbo = CBg + (size_t)item * 16384;
#pragma unroll
        for (int lt = 0; lt < 8; ++lt) {
            f32x4 acc = {0.f, 0.f, 0.f, 0.f};
#pragma unroll
            for (int ks = 0; ks < 4; ++ks) { const bf16x8 bfr = *(const bf16x8*)(cv + (16 * lt + fr) * 264 + 128 + 32 * ks + 8 * q); acc = __builtin_amdgcn_mfma_f32_16x16x32_bf16(af[ks], bfr, acc, 0, 0, 0); }
            u32x2 o; o.x = pg8::cvt_pk_bf16(acc[0], acc[1]); o.y = pg8::cvt_pk_bf16(acc[2], acc[3]);
            *(u32x2*)(cbo + (16 * lt + fr) * 128 + 16 * wid + 4 * q) = o;
        }
    }
}
__device__ __forceinline__ void ph_ssd_scan_naive(const Params& P, unsigned char* ldsraw) {
    const bf16_t* proj = (const bf16_t*)(P.ws + OFF_R);
    bf16_t* Bs = (bf16_t*)ldsraw;
    bf16_t* Cs = Bs + 64 * 128;
    float* xs = (float*)(Cs + 64 * 128);
    float* dts = xs + 64 * 64;
    const int tid = threadIdx.x, p = tid >> 3, ng = tid & 7;
    for (int item = blockIdx.x; item < 256; item += gridDim.x) {
        const int d = item & 1, hh = (item >> 1) & 31, b = item >> 6, g = hh >> 3;
        const float a = -__expf(P.ssd_a_log[d * 32 + hh]), dsk = P.ssd_d[hh];
        bf16_t* Y = d ? (bf16_t*)P.out : (bf16_t*)(P.ws + OFF_YF);
        float h[16];
#pragma unroll
        for (int j = 0; j < 16; ++j) h[j] = 0.f;
        for (int blk = 0; blk < SEQ / 64; ++blk) {
            __syncthreads();
            for (int i = tid; i < 64 * 128; i += NT) {
                const int n = i & 127, r = i >> 7; const int lt = d ? SEQ - 1 - (blk * 64 + r) : blk * 64 + r;
                const size_t ro = (size_t)(b * SEQ + lt) * LDP;
                Bs[i] = proj[(size_t)(b * SEQ + (lt & ~127) + n) * LDP + 2048 + g * 128 + (lt & 127)]; Cs[i] = proj[ro + 2560 + g * 128 + n];
            }
            for (int i = tid; i < 64 * 64; i += NT) {
                const int pp = i & 63, r = i >> 6; const int lt = d ? SEQ - 1 - (blk * 64 + r) : blk * 64 + r;
                const int col = hh * 64 + pp;
                float acc = P.ssd_conv_b[col];
#pragma unroll
                for (int k = 0; k < 5; ++k) { const int l2 = lt + k - 2; if (l2 >= 0 && l2 < SEQ) acc += bf2f(proj[(size_t)(b * SEQ + l2) * LDP + col]) * P.ssd_conv_w[k * 3072 + col]; }
                xs[i] = siluf(acc);
            }
            if (tid < 64) { const int lt = d ? SEQ - 1 - (blk * 64 + tid) : blk * 64 + tid; dts[tid] = ((const float*)(proj + (size_t)(b * SEQ + lt) * LDP + 3136))[d * 32 + hh]; }
            __syncthreads();
            for (int r = 0; r < 64; ++r) {
                const float dt = dts[r], xv = xs[r * 64 + p], dA = __expf(dt * a), dx = dt * xv;
                float part = 0.f;
#pragma unroll
                for (int j = 0; j < 16; ++j) { h[j] = h[j] * dA + dx * bf2f(Bs[r * 128 + ng * 16 + j]); part += bf2f(Cs[r * 128 + ng * 16 + j]) * h[j]; }
                part += __shfl_xor(part, 1); part += __shfl_xor(part, 2); part += __shfl_xor(part, 4);
                if (ng == 0) { const int lt = d ? SEQ - 1 - (blk * 64 + r) : blk * 64 + r; Y[(size_t)(b * SEQ + lt) * 2048 + hh * 64 + p] = f2bf(part + (d == 0 ? dsk * xv : 0.f)); }
            }
        }
    }
}
#define LDS_BAR() do { asm volatile("s_waitcnt lgkmcnt(0)" ::: "memory"); __builtin_amdgcn_s_barrier(); asm volatile("" ::: "memory"); } while (0)
__device__ __forceinline__ void ph_ssd_scan(const Params& P, unsigned char* ldsraw) {
    const bf16_t* proj = (const bf16_t*)(P.ws + OFF_R); const bf16_t* CBg = (const bf16_t*)(P.ws + OFF_CB);
    bf16_t* xdT = (bf16_t*)ldsraw;
    bf16_t* xdwT = xdT + 64 * 136;
    bf16_t* stb = xdwT + 64 * 136;
    bf16_t* xraw = stb + 64 * 136;
    float* cs = (float*)(xraw + 132 * 72);
    float* dts = cs + 128;
    float* tot = dts + 128;
    float* cwl = tot + 4;
    float* csA = cwl + 384;
    float* dtsA = csA + 32 * 128;
    float* totA = dtsA + 32 * 128;
    const int tid = threadIdx.x, lane = tid & 63, wid = tid >> 6, fr = lane & 15, q = lane >> 4;
    const int ltile = (wid < 4) ? wid : 11 - wid;
    for (int item = blockIdx.x; item < 256; item += gridDim.x) {
        const int d = item & 1, hh = (item >> 1) & 31, b = item >> 6, g = hh >> 3;
        const float a = -__expf(P.ssd_a_log[d * 32 + hh]), dsk = P.ssd_d[hh];
        bf16_t* Y = d ? (bf16_t*)P.out : (bf16_t*)(P.ws + OFF_YF);
        __syncthreads();
        for (int i = tid; i < 384; i += NT) cwl[i] = (i < 320) ? P.ssd_conv_w[(i >> 6) * 3072 + hh * 64 + (i & 63)] : P.ssd_conv_b[hh * 64 + i - 320];
        for (int k4 = 0; k4 < 4; ++k4) {
            const int cc = wid + 8 * k4; const size_t t0_ = (size_t)b * SEQ + cc * 128;
            const float dta = ((const float*)(proj + (t0_ + 2 * lane) * LDP + 3136))[d * 32 + hh], dtb = ((const float*)(proj + (t0_ + 2 * lane + 1) * LDP + 3136))[d * 32 + hh];
            const float ad0 = dta * a * 1.4426950408889634f, ad1 = dtb * a * 1.4426950408889634f, v = ad0 + ad1; float inc = v;
#pragma unroll
            for (int o = 1; o < 64; o <<= 1) { const float t = __shfl_up(inc, o); if (lane >= o) inc += t; }
            const float excl = inc - v, totl = __shfl(inc, 63);
            if (d == 0) { csA[cc * 128 + 2 * lane] = excl + ad0; csA[cc * 128 + 2 * lane + 1] = inc; } else { csA[cc * 128 + 2 * lane] = totl - excl; csA[cc * 128 + 2 * lane + 1] = totl - excl - ad0; }
            dtsA[cc * 128 + 2 * lane] = dta; dtsA[cc * 128 + 2 * lane + 1] = dtb; if (lane == 0) totA[cc] = totl;
        }
        f32x4 st[4];
#pragma unroll
        for (int pt = 0; pt < 4; ++pt) st[pt] = (f32x4){0.f, 0.f, 0.f, 0.f};
        u32x4 xp[3]; u32x4 cbv[4]; bf16x8 cmf[4], btf[4];
#define SCAN_LOAD_A(cc) do { const size_t t0_ = (size_t)b * SEQ + (cc) * 128; \
            _Pragma("unroll") for (int e_ = 0; e_ < 3; ++e_) { const int i_ = tid + e_ * NT; const int r_ = i_ >> 3, pc_ = (i_ & 7) * 8; const int lt_ = (cc) * 128 + r_ - 2; \
                xp[e_] = (u32x4){0u, 0u, 0u, 0u}; if (i_ < 132 * 8 && lt_ >= 0 && lt_ < SEQ) xp[e_] = *(const u32x4*)(proj + ((size_t)b * SEQ + lt_) * LDP + hh * 64 + pc_); } } while (0)
#define SCAN_LOAD_C(cc) do { const size_t t0_ = (size_t)b * SEQ + (cc) * 128; const int l_ = 16 * ltile + fr, n_ = 16 * wid + fr; \
            const bf16_t* cbrow_ = CBg + (size_t)((b * 32 + (cc)) * 4 + g) * 16384 + l_ * 128 + 8 * q; const bf16_t* cmrow_ = proj + (t0_ + l_) * LDP + 2560 + g * 128 + 8 * q; \
            const bf16_t* btrow_ = proj + (t0_ + n_) * LDP + 2048 + g * 128 + 8 * q; \
            _Pragma("unroll") for (int ks_ = 0; ks_ < 4; ++ks_) { cbv[ks_] = *(const u32x4*)(cbrow_ + 32 * ks_); cmf[ks_] = *(const bf16x8*)(cmrow_ + 32 * ks_); btf[ks_] = *(const bf16x8*)(btrow_ + 32 * ks_); } } while (0)
#define SCAN_CH(i_) (d ? 31 - ((i_) < 31 ? (i_) : 31) : ((i_) < 31 ? (i_) : 31))
#define SCAN_XRAW_WRITE() do { _Pragma("unroll") for (int e = 0; e < 3; ++e) { const int i = tid + e * NT; if (i < 132 * 8) *(u32x4*)(xraw + (i >> 3) * 72 + (i & 7) * 8) = xp[e]; } } while (0)
        { const int c0_ = SCAN_CH(0), c1_ = SCAN_CH(1); SCAN_LOAD_A(c0_); SCAN_LOAD_C(c0_); SCAN_XRAW_WRITE(); SCAN_LOAD_A(c1_); }
        __syncthreads();
        for (int ci = 0; ci < 32; ++ci) {
            const int c = d ? 31 - ci : ci; const size_t tok0 = (size_t)b * SEQ + c * 128;
            const int cn = SCAN_CH(ci + 1), cnn = SCAN_CH(ci + 2);
            const float* cs = csA + c * 128; const float* dts = dtsA + c * 128;
#pragma unroll
            for (int pt = 0; pt < 4; ++pt) { u32x2 o; o.x = pg8::cvt_pk_bf16(st[pt][0], st[pt][1]); o.y = pg8::cvt_pk_bf16(st[pt][2], st[pt][3]); *(u32x2*)(stb + (16 * pt + fr) * 136 + 16 * wid + 4 * q) = o; }
            const float total = totA[c];
            {
                const int tp = tid & 63, oc = (tid >> 6) * 8;
                float w5[5][8], accA[8], accB[8];
#pragma unroll
                for (int k = 0; k < 5; ++k) { const f32x4 w0 = *(const f32x4*)(cwl + k * 64 + oc), w1 = *(const f32x4*)(cwl + k * 64 + oc + 4);
#pragma unroll
                    for (int j = 0; j < 4; ++j) { w5[k][j] = w0[j]; w5[k][4 + j] = w1[j]; } }
                { const f32x4 b0 = *(const f32x4*)(cwl + 320 + oc), b1 = *(const f32x4*)(cwl + 320 + oc + 4);
#pragma unroll
                  for (int j = 0; j < 4; ++j) { accA[j] = b0[j]; accA[4 + j] = b1[j]; accB[j] = b0[j]; accB[4 + j] = b1[j]; } }
#pragma unroll
                for (int k = 0; k < 6; ++k) {
                    float xr[8]; unpack8(*(const u32x4*)(xraw + (2 * tp + k) * 72 + oc), xr);
#pragma unroll
                    for (int j = 0; j < 8; ++j) { if (k < 5) accA[j] += xr[j] * w5[k < 5 ? k : 0][j]; if (k > 0) accB[j] += xr[j] * w5[k > 0 ? k - 1 : 0][j]; }
                }
                const float dtA = dts[2 * tp], dtB = dts[2 * tp + 1], wA = __builtin_amdgcn_exp2f(total - cs[2 * tp]), wB = __builtin_amdgcn_exp2f(total - cs[2 * tp + 1]);
#pragma unroll
                for (int j = 0; j < 8; ++j) {
                    const float xa = accA[j] * fsig(accA[j]) * dtA, xb_ = accB[j] * fsig(accB[j]) * dtB;
                    ((unsigned*)(xdT + (oc + j) * 136))[tp] = pg8::cvt_pk_bf16(xa, xb_);
                    ((unsigned*)(xdwT + (oc + j) * 136))[tp] = pg8::cvt_pk_bf16(xa * wA, xb_ * wB);
                }
            }
            LDS_BAR();
            {
                int l = 16 * ltile + fr; asm volatile("" : "+v"(l));
                const float csl = cs[l], el = __builtin_amdgcn_exp2f(csl), ddt = dsk * __builtin_amdgcn_rcpf(dts[l]);
                f32x4 y2[4], y3[4];
#pragma unroll
                for (int pt = 0; pt < 4; ++pt) { y2[pt] = (f32x4){0.f, 0.f, 0.f, 0.f}; y3[pt] = (f32x4){0.f, 0.f, 0.f, 0.f}; }
                const int whalf = __builtin_amdgcn_readfirstlane(ltile) >> 1;
#pragma unroll
                for (int ks = 0; ks < 4; ++ks) {
                  if (d ? (ks >= whalf) : (ks <= whalf)) {
                    const f32x4 c0 = *(const f32x4*)(cs + 32 * ks + 8 * q), c1 = *(const f32x4*)(cs + 32 * ks + 8 * q + 4);
                    float gv[8];
#pragma unroll
                    for (int j = 0; j < 8; ++j) {
                        const int sx = 32 * ks + 8 * q + j; const float cb = (j & 1) ? __uint_as_float(cbv[ks][j >> 1] & 0xffff0000u) : __uint_as_float(cbv[ks][j >> 1] << 16);
                        const float css = (j < 4) ? c0[j & 3] : c1[j & 3]; const bool keep = d ? (sx >= l) : (sx <= l);
                        float val = keep ? cb * __builtin_amdgcn_exp2f(csl - css) : 0.f;
                        if (d == 0 && sx == l) val += ddt;
                        gv[j] = val;
                    }
                    union { u32x4 u; bf16x8 h; } gf; gf.u = (u32x4){pg8::cvt_pk_bf16(gv[0], gv[1]), pg8::cvt_pk_bf16(gv[2], gv[3]), pg8::cvt_pk_bf16(gv[4], gv[5]), pg8::cvt_pk_bf16(gv[6], gv[7])};
#pragma unroll
                    for (int pt = 0; pt < 4; ++pt) { const bf16x8 xf = *(const bf16x8*)(xdT + (16 * pt + fr) * 136 + 32 * ks + 8 * q); y2[pt] = __builtin_amdgcn_mfma_f32_16x16x32_bf16(xf, gf.h, y2[pt], 0, 0, 0); }
                  }
#pragma unroll
                    for (int pt = 0; pt < 4; ++pt) { const bf16x8 sf = *(const bf16x8*)(stb + (16 * pt + fr) * 136 + 32 * ks + 8 * q); y3[pt] = __builtin_amdgcn_mfma_f32_16x16x32_bf16(sf, cmf[ks], y3[pt], 0, 0, 0); }
                }
#pragma unroll
                for (int pt = 0; pt < 4; ++pt) {
                    const f32x4 v = y2[pt] + el * y3[pt]; u32x2 o; o.x = pg8::cvt_pk_bf16(v[0], v[1]); o.y = pg8::cvt_pk_bf16(v[2], v[3]);
                    *(u32x2*)(Y + (tok0 + l) * 2048 + hh * 64 + 16 * pt + 4 * q) = o;
                }
                const float etot = __builtin_amdgcn_exp2f(total);
#pragma unroll
                for (int pt = 0; pt < 4; ++pt) st[pt] *= etot;
#pragma unroll
                for (int ks = 0; ks < 4; ++ks) {
#pragma unroll
                    for (int pt = 0; pt < 4; ++pt) { const bf16x8 xf = *(const bf16x8*)(xdwT + (16 * pt + fr) * 136 + 32 * ks + 8 * q); st[pt] = __builtin_amdgcn_mfma_f32_16x16x32_bf16(btf[ks], xf, st[pt], 0, 0, 0); }
                }
            }
            SCAN_LOAD_C(cn);
            SCAN_XRAW_WRITE();
            SCAN_LOAD_A(cnn);
            LDS_BAR();
        }
#undef SCAN_LOAD_A
#undef SCAN_CH
#undef SCAN_XRAW_WRITE
#undef SCAN_LOAD_C
    }
}
__device__ __forceinline__ void ph_gn_scale(const Params& P) {
    bf16_t* proj = (bf16_t*)(P.ws + OFF_R);
    const int lane = threadIdx.x & 63, wid = threadIdx.x >> 6;
    for (int it = blockIdx.x * 8 + wid; it < T_TOK * 4; it += gridDim.x * 8) {
        const int row = it >> 2, grp = it & 3;
        bf16_t* ptr = proj + (size_t)row * LDP + grp * 512 + lane * 8;
        const u32x4 v = *(const u32x4*)ptr; float f[8]; float ss = 0.f;
#pragma unroll
        for (int j = 0; j < 4; ++j) { f[2 * j] = __uint_as_float(v[j] << 16); f[2 * j + 1] = __uint_as_float(v[j] & 0xffff0000u); ss += f[2 * j] * f[2 * j] + f[2 * j + 1] * f[2 * j + 1]; }
        ss = wave_sum(ss);
        const float rstd = rsqrtf(ss * (1.0f / 512.f) + EPS);
        const float* w = P.ssd_norm_w + grp * 512 + lane * 8; u32x4 o;
#pragma unroll
        for (int j = 0; j < 4; ++j) o[j] = pack2(f[2 * j] * rstd * w[2 * j], f[2 * j + 1] * rstd * w[2 * j + 1]);
        *(u32x4*)ptr = o;
    }
}
__device__ __forceinline__ void ph_ffn_conv(const Params& P, int layer, int half) {
    const bf16_t* hup = (const bf16_t*)(P.ws + OFF_R); bf16_t* gout = (bf16_t*)(P.ws + OFF_G);
    const float* cw = P.ffn_conv_w + (size_t)layer * 3 * 5632; const float* cb = P.ffn_conv_b + (size_t)layer * 5632;
    for (int it = blockIdx.x * NT + threadIdx.x; it < (T_TOK / 16) * (FH / 8); it += gridDim.x * NT) {
        const int oc = (it % (FH / 8)) * 8, t0 = (it / (FH / 8)) * 16, lt0 = t0 & (SEQ - 1);
        const int pn = oc >> 7, w = oc & 127, gcol = pn * 256 + w, vcol = gcol + 128;
        const int gch = half * FH + oc, vch = 2816 + gch;
        float wg[3][8], wv[3][8], bg[8], bv[8];
#pragma unroll
        for (int k = 0; k < 3; ++k) {
            const f32x4 a0 = *(const f32x4*)(cw + k * 5632 + gch), a1 = *(const f32x4*)(cw + k * 5632 + gch + 4), c0 = *(const f32x4*)(cw + k * 5632 + vch), c1 = *(const f32x4*)(cw + k * 5632 + vch + 4);
#pragma unroll
            for (int j = 0; j < 4; ++j) { wg[k][j] = a0[j]; wg[k][4 + j] = a1[j]; wv[k][j] = c0[j]; wv[k][4 + j] = c1[j]; }
        }
        { const f32x4 a0 = *(const f32x4*)(cb + gch), a1 = *(const f32x4*)(cb + gch + 4), c0 = *(const f32x4*)(cb + vch), c1 = *(const f32x4*)(cb + vch + 4);
#pragma unroll
          for (int j = 0; j < 4; ++j) { bg[j] = a0[j]; bg[4 + j] = a1[j]; bv[j] = c0[j]; bv[4 + j] = c1[j]; } }
        const bf16_t* base = hup + (size_t)t0 * 2816;
        float gp[8], vp[8], gc[8], vc[8];
        const u32x4 z4 = {0u, 0u, 0u, 0u};
        unpack8(lt0 > 0 ? *(const u32x4*)(base - 2816 + gcol) : z4, gp); unpack8(lt0 > 0 ? *(const u32x4*)(base - 2816 + vcol) : z4, vp);
        unpack8(*(const u32x4*)(base + gcol), gc); unpack8(*(const u32x4*)(base + vcol), vc);
#pragma unroll
        for (int i = 0; i < 16; ++i) {
            float gn[8], vn[8];
            const bool has = (lt0 + i + 1 < SEQ);
            unpack8(has ? *(const u32x4*)(base + (size_t)(i + 1) * 2816 + gcol) : z4, gn); unpack8(has ? *(const u32x4*)(base + (size_t)(i + 1) * 2816 + vcol) : z4, vn);
            u32x4 o;
#pragma unroll
            for (int j = 0; j < 4; ++j) {
                const float g0 = bg[2 * j] + wg[0][2 * j] * gp[2 * j] + wg[1][2 * j] * gc[2 * j] + wg[2][2 * j] * gn[2 * j];
                const float g1 = bg[2 * j + 1] + wg[0][2 * j + 1] * gp[2 * j + 1] + wg[1][2 * j + 1] * gc[2 * j + 1] + wg[2][2 * j + 1] * gn[2 * j + 1];
                const float v0 = bv[2 * j] + wv[0][2 * j] * vp[2 * j] + wv[1][2 * j] * vc[2 * j] + wv[2][2 * j] * vn[2 * j];
                const float v1 = bv[2 * j + 1] + wv[0][2 * j + 1] * vp[2 * j + 1] + wv[1][2 * j + 1] * vc[2 * j + 1] + wv[2][2 * j + 1] * vn[2 * j + 1];
                o[j] = pg8::cvt_pk_bf16(g0 * fsig(g0) * v0, g1 * fsig(g1) * v1);
            }
            *(u32x4*)(gout + (size_t)(t0 + i) * FH + oc) = o;
#pragma unroll
            for (int j = 0; j < 8; ++j) { gp[j] = gc[j]; vp[j] = vc[j]; gc[j] = gn[j]; vc[j] = vn[j]; }
        }
    }
}
__device__ __forceinline__ void ph_s5_naive(const Params& P) {
    const bf16_t* u = (const bf16_t*)(P.ws + OFF_ABUF); float* scr = (float*)(P.ws + OFF_R); bf16_t* gout = (bf16_t*)(P.ws + OFF_G);
    const int lane = threadIdx.x & 63, wid = threadIdx.x >> 6;
    for (int item = blockIdx.x + gridDim.x * wid; item < 256; item += gridDim.x * 8) {
        const int g = item & 63, b = item >> 6;
        for (int d = 0; d < 2; ++d) {
            const float lr = P.s5_a_re[(d * 64 + g) * 64 + lane], li = P.s5_a_im[(d * 64 + g) * 64 + lane];
            const float step = expf(P.s5_log_step[d * 64 + g]);
            const float mag = expf(lr * step), ang = li * step;
            const double angd = (double)ang, two_pi = 6.283185307179586476925;
            const float angr = (float)(angd - two_pi * rint(angd / two_pi));
            const float lbr = mag * cosf(angr), lbi = mag * sinf(angr);
            const float nr = lbr - 1.0f, den = lr * lr + li * li;
            const float qr = (nr * lr + lbi * li) / den, qi = (lbi * lr - nr * li) / den;
            float Br[16], Bi[16], Cr[16], Ci[16];
#pragma unroll
            for (int h = 0; h < 16; ++h) {
                const float br = P.s5_b_re[(g * 64 + lane) * 16 + h], bi = P.s5_b_im[(g * 64 + lane) * 16 + h];
                Br[h] = qr * br - qi * bi; Bi[h] = qr * bi + qi * br;
                Cr[h] = P.s5_c_re[((d * 64 + g) * 16 + h) * 64 + lane]; Ci[h] = P.s5_c_im[((d * 64 + g) * 16 + h) * 64 + lane];
            }
            float hr = 0.f, hi = 0.f;
            for (int s = 0; s < SEQ; ++s) {
                const int lt = d ? SEQ - 1 - s : s; const size_t tok = (size_t)b * SEQ + lt;
                const float uv = bf2f(u[tok * DM + g * 16 + (lane & 15)]);
                float dr = 0.f, di = 0.f;
#pragma unroll
                for (int h = 0; h < 16; ++h) { const float uh = __shfl(uv, h); dr += Br[h] * uh; di += Bi[h] * uh; }
                const float nhr = lbr * hr - lbi * hi + dr, nhi = lbr * hi + lbi * hr + di; hr = nhr; hi = nhi;
                float yv = 0.f;
#pragma unroll
                for (int h = 0; h < 16; ++h) { const float s1 = wave_sum(hr * Cr[h] - hi * Ci[h]); if ((lane & 15) == h) yv = s1; }
                if (lane < 16) {
                    if (d == 0) scr[tok * DM + g * 16 + lane] = yv;
                    else { const float y = scr[tok * DM + g * 16 + lane] + yv + P.s5_d[g * 16 + lane] * uv;
                           const float ge = 0.5f * y * (1.0f + tanhf(0.7978845608028654f * (y + 0.044715f * y * y * y)));
                           gout[tok * DM + g * 16 + lane] = f2bf(ge); }
                }
            }
        }
    }
}

constexpr size_t OFF_S5M = OFF_R + 96 * MiB;
__device__ __forceinline__ void s5_lambda(const Params& P, int d, int g, int p, float& lbr, float& lbi, float& qr, float& qi) {
    const float lr = P.s5_a_re[(d * 64 + g) * 64 + p], li = P.s5_a_im[(d * 64 + g) * 64 + p];
    const float step = expf(P.s5_log_step[d * 64 + g]);
    const float mag = expf(lr * step), ang = li * step;
    const double angd = (double)ang, two_pi = 6.283185307179586476925;
    const float angr = (float)(angd - two_pi * rint(angd / two_pi));
    lbr = mag * cosf(angr); lbi = mag * sinf(angr);
    const float nr = lbr - 1.0f, den = lr * lr + li * li;
    qr = (nr * lr + lbi * li) / den; qi = (lbi * lr - nr * li) / den;
}
__device__ __forceinline__ void ph_s5_setup(const Params& P, unsigned char* ldsraw) {
    float* pw = (float*)ldsraw;
    float* Bb = pw + 2 * 17 * 64 * 2;
    float* Cc = Bb + 2 * 64 * 16 * 2;
    float* Kt = Cc + 2 * 16 * 64 * 2;
    const int tid = threadIdx.x;
    for (int item = blockIdx.x; item < 256; item += gridDim.x) {
        const int g = item >> 2, part = item & 3;
        bf16_t* A1 = (bf16_t*)(P.ws + OFF_S5M) + (size_t)g * (65536 + 131072); bf16_t* A2 = A1 + 65536;
        __syncthreads();
        if (tid < 128) {
            const int d = tid >> 6, p = tid & 63; float lbr, lbi, qr, qi; s5_lambda(P, d, g, p, lbr, lbi, qr, qi);
            float pr = 1.f, pi = 0.f;
            for (int j = 0; j <= 16; ++j) { pw[((d * 17 + j) * 64 + p) * 2] = pr; pw[((d * 17 + j) * 64 + p) * 2 + 1] = pi; const float t = pr * lbr - pi * lbi; pi = pr * lbi + pi * lbr; pr = t; }
            for (int h = 0; h < 16; ++h) {
                const float br = P.s5_b_re[(g * 64 + p) * 16 + h], bi = P.s5_b_im[(g * 64 + p) * 16 + h];
                Bb[((d * 64 + p) * 16 + h) * 2] = qr * br - qi * bi; Bb[((d * 64 + p) * 16 + h) * 2 + 1] = qr * bi + qi * br;
                Cc[((d * 16 + h) * 64 + p) * 2] = P.s5_c_re[((d * 64 + g) * 16 + h) * 64 + p]; Cc[((d * 16 + h) * 64 + p) * 2 + 1] = P.s5_c_im[((d * 64 + g) * 16 + h) * 64 + p];
            }
        }
        __syncthreads();
        for (int i = tid; i < 16384; i += NT) {
            const int k = i & 255, R = 64 * part + (i >> 8), sx = k >> 4, hp = k & 15, d = R >> 7, ri = (R >> 6) & 1, p = R & 63;
            const int e = d ? sx : 15 - sx;
            const float pr = pw[((d * 17 + e) * 64 + p) * 2], pi = pw[((d * 17 + e) * 64 + p) * 2 + 1], br = Bb[((d * 64 + p) * 16 + hp) * 2], bi = Bb[((d * 64 + p) * 16 + hp) * 2 + 1];
            A1[(size_t)R * 256 + k] = f2bf(ri ? (pr * bi + pi * br) : (pr * br - pi * bi));
        }
        for (int i = tid; i < 2048; i += NT) {
            const int hp = i & 15, hl = (i >> 4) & 3, j = (i >> 6) & 15, d = i >> 10, h = 4 * part + hl;
            float acc = 0.f;
            for (int p = 0; p < 64; ++p) {
                const float pr = pw[((d * 17 + j) * 64 + p) * 2], pi = pw[((d * 17 + j) * 64 + p) * 2 + 1], br = Bb[((d * 64 + p) * 16 + hp) * 2], bi = Bb[((d * 64 + p) * 16 + hp) * 2 + 1];
                const float er = pr * br - pi * bi, ei = pr * bi + pi * br;
                acc += Cc[((d * 16 + h) * 64 + p) * 2] * er - Cc[((d * 16 + h) * 64 + p) * 2 + 1] * ei;
            }
            Kt[i] = acc;
        }
        __syncthreads();
        for (int i = tid; i < 16384; i += NT) {
            const int k = i & 255, rr = i >> 8, tau = rr >> 2, hl = rr & 3, h = 4 * part + hl, row = tau * 16 + h, sx = k >> 4, hp = k & 15;
            float v = 0.f;
            if (sx <= tau) v += Kt[(((tau - sx)) * 4 + hl) * 16 + hp];
            if (sx >= tau) v += Kt[((16 + sx - tau) * 4 + hl) * 16 + hp];
            if (sx == tau && hp == h) v += P.s5_d[g * 16 + h];
            A2[(size_t)row * 512 + k] = f2bf(v);
        }
        for (int i = tid; i < 16384; i += NT) {
            const int kk = i & 255, rr = i >> 8, tau = rr >> 2, h = 4 * part + (rr & 3), row = tau * 16 + h, d = kk >> 7, ri = (kk >> 6) & 1, p = kk & 63;
            const int e = d ? 16 - tau : tau + 1;
            const float pr = pw[((d * 17 + e) * 64 + p) * 2], pi = pw[((d * 17 + e) * 64 + p) * 2 + 1], cr = Cc[((d * 16 + h) * 64 + p) * 2], ci = Cc[((d * 16 + h) * 64 + p) * 2 + 1];
            A2[(size_t)row * 512 + 256 + kk] = f2bf(ri ? -(cr * pi + ci * pr) : (cr * pr - ci * pi));
        }
    }
}
__device__ __forceinline__ void ph_s5_main(const Params& P, unsigned char* ldsraw) {
    const bf16_t* u = (const bf16_t*)(P.ws + OFF_ABUF); float* scr = (float*)(P.ws + OFF_R); bf16_t* gout = (bf16_t*)(P.ws + OFF_G);
    bf16_t* Sc = (bf16_t*)ldsraw;
    float* tbuf = (float*)(ldsraw + 256 * 264 * 2);
    bf16_t* atile = (bf16_t*)(ldsraw + 256 * 264 * 2 + 8192);
    const int tid = threadIdx.x, lane = tid & 63, wid = tid >> 6, fr = lane & 15, q = lane >> 4;
    for (int item = blockIdx.x; item < 256; item += gridDim.x) {
        const int g = (item & 7) + 8 * (item >> 5), b = (item >> 3) & 3;
        const bf16_t* A1 = (const bf16_t*)(P.ws + OFF_S5M) + (size_t)g * (65536 + 131072); const bf16_t* A2 = A1 + 65536;
        float* sl = scr + (size_t)item * 65536;
        bf16x8 uf[2][8];
#pragma unroll
        for (int ct = 0; ct < 2; ++ct)
#pragma unroll
            for (int ks = 0; ks < 8; ++ks) {
                const int c = 32 * wid + 16 * ct + fr; const size_t tok = (size_t)b * SEQ + c * 16 + 2 * ks + (q >> 1);
                uf[ct][ks] = *(const bf16x8*)(u + tok * DM + g * 16 + 8 * (q & 1));
            }
        {
            const int srow = tid >> 5, spc = (tid & 31) * 8;
            *(u32x4*)(atile + srow * 264 + spc) = *(const u32x4*)(A1 + (size_t)srow * 256 + spc);
            u32x4 r0, r1 = *(const u32x4*)(A1 + (size_t)(16 + srow) * 256 + spc), r2 = *(const u32x4*)(A1 + (size_t)(32 + srow) * 256 + spc), r3 = *(const u32x4*)(A1 + (size_t)(48 + srow) * 256 + spc);
            __syncthreads();
#define S5A_STEP(Rt, RL, RW) do { \
                RL = *(const u32x4*)(A1 + (size_t)((((Rt) + 4) & 15) * 16 + srow) * 256 + spc); \
                const bf16_t* at = atile + ((Rt) & 1) * (16 * 264) + fr * 264 + 8 * q; \
                f32x4 a0 = {0.f, 0.f, 0.f, 0.f}, a1 = {0.f, 0.f, 0.f, 0.f}; \
                _Pragma("unroll") for (int ks = 0; ks < 8; ++ks) { const bf16x8 af = *(const bf16x8*)(at + ks * 32); \
                    a0 = __builtin_amdgcn_mfma_f32_16x16x32_bf16(af, uf[0][ks], a0, 0, 0, 0); a1 = __builtin_amdgcn_mfma_f32_16x16x32_bf16(af, uf[1][ks], a1, 0, 0, 0); } \
                *(f32x4*)(sl + (size_t)(32 * wid + fr) * 256 + (Rt) * 16 + 4 * q) = a0; \
                *(f32x4*)(sl + (size_t)(32 * wid + 16 + fr) * 256 + (Rt) * 16 + 4 * q) = a1; \
                *(u32x4*)(atile + (((Rt) + 1) & 1) * (16 * 264) + srow * 264 + spc) = RW; \
                LDS_BAR(); } while (0)
            for (int R4 = 0; R4 < 16; R4 += 4) { S5A_STEP(R4, r0, r1); S5A_STEP(R4 + 1, r1, r2); S5A_STEP(R4 + 2, r2, r3); S5A_STEP(R4 + 3, r3, r0); }
#undef S5A_STEP
        }
        asm volatile("s_waitcnt vmcnt(0)" ::: "memory");
        __syncthreads();
        {
            float L0r, L0i, L1r, L1i, qr_, qi_;
            s5_lambda(P, 0, g, lane, L0r, L0i, qr_, qi_); s5_lambda(P, 1, g, lane, L1r, L1i, qr_, qi_);
#pragma unroll
            for (int i = 0; i < 4; ++i) { float t = L0r * L0r - L0i * L0i; L0i = 2.f * L0r * L0i; L0r = t; t = L1r * L1r - L1i * L1i; L1i = 2.f * L1r * L1i; L1r = t; }
            float h0r = 0.f, h0i = 0.f, h1r = 0.f, h1i = 0.f;
            for (int j0 = 0; j0 < 32; j0 += 8) {
                float x0r[8], x0i[8], x1r[8], x1i[8];
#pragma unroll
                for (int i = 0; i < 8; ++i) { const int j = 32 * wid + j0 + i, c0 = j, c1 = 255 - j;
                    x0r[i] = sl[(size_t)c0 * 256 + lane]; x0i[i] = sl[(size_t)c0 * 256 + 64 + lane]; x1r[i] = sl[(size_t)c1 * 256 + 128 + lane]; x1i[i] = sl[(size_t)c1 * 256 + 192 + lane]; }
#pragma unroll
                for (int i = 0; i < 8; ++i) { float t = L0r * h0r - L0i * h0i + x0r[i]; h0i = L0r * h0i + L0i * h0r + x0i[i]; h0r = t; t = L1r * h1r - L1i * h1i + x1r[i]; h1i = L1r * h1i + L1i * h1r + x1i[i]; h1r = t; }
            }
            *(f32x4*)(tbuf + ((wid * 64 + lane) * 4)) = (f32x4){h0r, h0i, h1r, h1i};
            __syncthreads();
            float P0r = L0r, P0i = L0i, P1r = L1r, P1i = L1i;
#pragma unroll
            for (int i = 0; i < 5; ++i) { float t = P0r * P0r - P0i * P0i; P0i = 2.f * P0r * P0i; P0r = t; t = P1r * P1r - P1i * P1i; P1i = 2.f * P1r * P1i; P1r = t; }
            h0r = 0.f; h0i = 0.f; h1r = 0.f; h1i = 0.f;
            for (int w2 = 0; w2 < wid; ++w2) { const f32x4 tv = *(const f32x4*)(tbuf + ((w2 * 64 + lane) * 4));
                float t = P0r * h0r - P0i * h0i + tv[0]; h0i = P0r * h0i + P0i * h0r + tv[1]; h0r = t; t = P1r * h1r - P1i * h1i + tv[2]; h1i = P1r * h1i + P1i * h1r + tv[3]; h1r = t; }
            for (int j0 = 0; j0 < 32; j0 += 8) {
                float x0r[8], x0i[8], x1r[8], x1i[8];
#pragma unroll
                for (int i = 0; i < 8; ++i) { const int j = 32 * wid + j0 + i, c0 = j, c1 = 255 - j;
                    x0r[i] = sl[(size_t)c0 * 256 + lane]; x0i[i] = sl[(size_t)c0 * 256 + 64 + lane]; x1r[i] = sl[(size_t)c1 * 256 + 128 + lane]; x1i[i] = sl[(size_t)c1 * 256 + 192 + lane]; }
#pragma unroll
                for (int i = 0; i < 8; ++i) { const int j = 32 * wid + j0 + i, c0 = j, c1 = 255 - j;
                    Sc[c0 * 264 + lane] = f2bf(h0r); Sc[c0 * 264 + 64 + lane] = f2bf(h0i); Sc[c1 * 264 + 128 + lane] = f2bf(h1r); Sc[c1 * 264 + 192 + lane] = f2bf(h1i);
                    float t = L0r * h0r - L0i * h0i + x0r[i]; h0i = L0r * h0i + L0i * h0r + x0i[i]; h0r = t; t = L1r * h1r - L1i * h1i + x1r[i]; h1i = L1r * h1i + L1i * h1r + x1i[i]; h1r = t; }
            }
        }
        __syncthreads();
        {
            const int srow = tid >> 5, spc = (tid & 31) * 8;
#define S5C_SRC(h) (A2 + (size_t)((((h) & 31) >> 1) * 16 + srow) * 512 + ((h) & 1) * 256 + spc)
            *(u32x4*)(atile + srow * 264 + spc) = *(const u32x4*)S5C_SRC(0);
            u32x4 r0, r1 = *(const u32x4*)S5C_SRC(1), r2 = *(const u32x4*)S5C_SRC(2), r3 = *(const u32x4*)S5C_SRC(3);
            __syncthreads();
            f32x4 a0 = {0.f, 0.f, 0.f, 0.f}, a1 = {0.f, 0.f, 0.f, 0.f};
#define S5C_STEP(hs, RL, RW) do { \
                RL = *(const u32x4*)S5C_SRC((hs) + 4); \
                const bf16_t* at = atile + ((hs) & 1) * (16 * 264) + fr * 264 + 8 * q; \
                if (((hs) & 1) == 0) { \
                    _Pragma("unroll") for (int ks = 0; ks < 8; ++ks) { const bf16x8 af = *(const bf16x8*)(at + ks * 32); \
                        a0 = __builtin_amdgcn_mfma_f32_16x16x32_bf16(af, uf[0][ks], a0, 0, 0, 0); a1 = __builtin_amdgcn_mfma_f32_16x16x32_bf16(af, uf[1][ks], a1, 0, 0, 0); } \
                } else { \
                    _Pragma("unroll") for (int ks = 0; ks < 8; ++ks) { const bf16x8 af = *(const bf16x8*)(at + ks * 32); \
                        const bf16x8 b0 = *(const bf16x8*)(Sc + (32 * wid + fr) * 264 + ks * 32 + 8 * q), b1 = *(const bf16x8*)(Sc + (32 * wid + 16 + fr) * 264 + ks * 32 + 8 * q); \
                        a0 = __builtin_amdgcn_mfma_f32_16x16x32_bf16(af, b0, a0, 0, 0, 0); a1 = __builtin_amdgcn_mfma_f32_16x16x32_bf16(af, b1, a1, 0, 0, 0); } \
                    const int ch = g * 16 + 4 * q, rt = (hs) >> 1; \
                    _Pragma("unroll") for (int ct = 0; ct < 2; ++ct) { \
                        const int c = 32 * wid + 16 * ct + fr; const size_t tok = (size_t)b * SEQ + c * 16 + rt; \
                        const f32x4 av = ct ? a1 : a0; float y[4]; \
                        _Pragma("unroll") for (int r = 0; r < 4; ++r) { const float yy = av[r]; y[r] = yy * fsig(1.5957691216057308f * (yy + 0.044715f * yy * yy * yy)); } \
                        u32x2 o; o.x = pg8::cvt_pk_bf16(y[0], y[1]); o.y = pg8::cvt_pk_bf16(y[2], y[3]); \
                        *(u32x2*)(gout + tok * DM + ch) = o; } \
                    a0 = (f32x4){0.f, 0.f, 0.f, 0.f}; a1 = (f32x4){0.f, 0.f, 0.f, 0.f}; \
                } \
                *(u32x4*)(atile + (((hs) + 1) & 1) * (16 * 264) + srow * 264 + spc) = RW; \
                LDS_BAR(); } while (0)
            for (int h4 = 0; h4 < 32; h4 += 4) { S5C_STEP(h4, r0, r1); S5C_STEP(h4 + 1, r1, r2); S5C_STEP(h4 + 2, r2, r3); S5C_STEP(h4 + 3, r3, r0); }
#undef S5C_STEP
#undef S5C_SRC
        }
        __syncthreads();
    }
}

#define XB_TMO      128
#define XB_XCNT(j)  (256  + 64 * (j))
#define XB_XSUB(j)  (1280 + 64 * (j))
#define XB_XGEN(j)  (2304 + 64 * (j))
#define XB_TOP      3328
#define XB_TOPGEN   3392
#define XCD_BAR_WORDS 3456
#define XB_SPIN_CAP (1u << 18)
constexpr size_t OFF_BAR = 255 * MiB;
constexpr int LDS_ST_OFF = (int)LDS_BYTES - 16;
__device__ __forceinline__ unsigned xb_ld(unsigned* p)              { return __hip_atomic_load(p, __ATOMIC_RELAXED, __HIP_MEMORY_SCOPE_AGENT); }
__device__ __forceinline__ unsigned xb_add(unsigned* p, unsigned v) { return __hip_atomic_fetch_add(p, v, __ATOMIC_RELAXED, __HIP_MEMORY_SCOPE_AGENT); }
__device__ __forceinline__ unsigned xb_xcc_id() { return (unsigned)__builtin_amdgcn_s_getreg((3 << 11) | 20) & 0xFu; }
#define XB_SPIN(cond, bar) do { unsigned _sp = 0; while (cond) { __builtin_amdgcn_s_sleep(1); \
    if ((++_sp & 255u) == 0u) { if (xb_ld(&(bar)[XB_TMO])) break; if (_sp > XB_SPIN_CAP) { atomicAdd(&(bar)[XB_TMO], 1u); break; } } } } while (0)
struct XcdBarrier { unsigned* bar; unsigned x; volatile PG8_LAS unsigned* st; };
__device__ __forceinline__ XcdBarrier xcd_barrier_post(unsigned* bar, volatile PG8_LAS unsigned* st) {
    XcdBarrier b; b.bar = bar; b.x = xb_xcc_id(); b.st = st;
    if (threadIdx.x == 0) (void)xb_add(&bar[XB_XCNT(b.x)], 1u);
    return b;
}
__device__ __forceinline__ void xcd_barrier_complete(unsigned* bar, unsigned x, unsigned& nloc, unsigned& nx) {
    const unsigned G = gridDim.x * gridDim.y * gridDim.z;
    unsigned sum, cnt, mine, sp = 0u;
    for (;;) {
        sum = 0u; cnt = 0u; mine = 0u;
#pragma unroll
        for (unsigned j = 0; j < 16; ++j) { const unsigned c = xb_ld(&bar[XB_XCNT(j)]); sum += c; cnt += (c > 0u) ? 1u : 0u; mine = (j == x) ? c : mine; }
        if (sum == G) break;
        __builtin_amdgcn_s_sleep(1);
        if ((++sp & 255u) == 0u) { if (xb_ld(&bar[XB_TMO])) break; if (sp > XB_SPIN_CAP) { atomicAdd(&bar[XB_TMO], 1u); break; } }
    }
    nloc = mine > 0u ? mine : 1u; nx = cnt > 0u ? cnt : 1u;
}
__device__ __forceinline__ void xcd_barrier(const XcdBarrier& b) {
    asm volatile("s_waitcnt vmcnt(0)" ::: "memory");
    __syncthreads();
    if (threadIdx.x == 0) {
        unsigned* bar = b.bar;
        __builtin_amdgcn_s_waitcnt(0);
        unsigned nloc = b.st[0], nx = b.st[1];
        if (nloc == 0u) { xcd_barrier_complete(bar, b.x, nloc, nx); b.st[0] = nloc; b.st[1] = nx; }
        const unsigned old = xb_add(&bar[XB_XSUB(b.x)], 1u);
        const unsigned gen = old / nloc;
        if (old + 1u == (gen + 1u) * nloc) {
            __builtin_amdgcn_fence(__ATOMIC_RELEASE, "agent");
            asm volatile("s_waitcnt vmcnt(0)" ::: "memory");
            const unsigned og = xb_add(&bar[XB_TOP], 1u);
            const unsigned tg = og / nx;
            if (og + 1u == (tg + 1u) * nx) xb_add(&bar[XB_TOPGEN], 1u);
            else XB_SPIN(xb_ld(&bar[XB_TOPGEN]) == tg, bar);
            __builtin_amdgcn_fence(__ATOMIC_ACQUIRE, "agent");
            xb_add(&bar[XB_XGEN(b.x)], 1u);
            asm volatile("s_waitcnt vmcnt(0)" ::: "memory");
        } else {
            XB_SPIN(xb_ld(&bar[XB_XGEN(b.x)]) == gen, bar);
            __builtin_amdgcn_fence(__ATOMIC_ACQUIRE, "agent");
            asm volatile("s_waitcnt vmcnt(0)" ::: "memory");
        }
    }
    __syncthreads();
}

constexpr int NPH = 32;
#define PH(k, body) if (lo <= (k) && (k) < hi) { { unsigned char* ws = P.ws; bf16_t* abuf = (bf16_t*)(ws + OFF_ABUF); bf16_t* proj = (bf16_t*)(ws + OFF_R); bf16_t* gbuf = (bf16_t*)(ws + OFF_G); bf16_t* hbuf = (bf16_t*)P.out; (void)abuf; (void)proj; (void)gbuf; (void)hbuf; body; } if ((k) + 1 < hi) xcd_barrier(xbar); }
#ifndef USE_NAIVE_GEMM
#define USE_NAIVE_GEMM 0
#endif
#define GEMM(A_, lda_, B_, ldb_, M_, N_, K_, EPI_, ...) { const GemmArgs g_ = mkgemm(A_, lda_, B_, ldb_, M_, N_, K_, EPI_, __VA_ARGS__); if (USE_NAIVE_GEMM) gemm_naive(g_, (float*)lds); else gemm_pg8<EPI_>((PG8_LAS unsigned char*)lds, g_); }
#define W_UPL ((bf16_t*)(ws + (layer ? W_UP1 : W_UP0)))
#define W_DNL ((bf16_t*)(ws + (layer ? W_DN1 : W_DN0)))
#define W_GTL ((bf16_t*)(ws + (layer ? W_GT1 : W_GT0)))
#define W_PPL ((bf16_t*)(ws + (layer ? W_PP1 : W_PP0)))
#define PPBUF ((bf16_t*)(ws + OFF_R))
#define PBF ((bf16_t*)(ws + OFF_R + 64 * MiB))
__device__ __forceinline__ void ffn_section(const Params& P, const int layer, const int base, const int lo, const int hi, const XcdBarrier& xbar, unsigned char* lds) {
    PH(base + 0, { if (layer == 0) ph_s5_setup(P, lds); ph_norm16(hbuf, P.ffn_norm_w + layer * DM, abuf, nullptr); })
    PH(base + 1, GEMM(abuf, DM, W_UPL, DM, T_TOK, 2816, DM, EPI_BF16, proj, 2816))
    PH(base + 2, ph_ffn_conv(P, layer, 0))
    PH(base + 3, GEMM(abuf, DM, W_UPL + (size_t)2816 * DM, DM, T_TOK, 2816, DM, EPI_BF16, proj, 2816))
    PH(base + 4, GEMM(gbuf, FH, W_DNL, 2816, T_TOK, DM, FH, EPI_RES16, hbuf, DM, (const float*)hbuf))
    PH(base + 5, ph_ffn_conv(P, layer, 1))
    PH(base + 6, GEMM(gbuf, FH, W_DNL + FH, 2816, T_TOK, DM, FH, EPI_RES16, hbuf, DM, (const float*)hbuf))
    PH(base + 7, { ph_norm16(hbuf, P.ple_norm_w + layer * DM, abuf, nullptr); ph_cvt_copy(P.p + (size_t)layer * T_TOK * 256, PBF, (size_t)T_TOK * 256); })
    PH(base + 8, { GEMM(PBF, 256, W_PPL, 256, T_TOK, DM, 256, EPI_BF16, PPBUF, DM) GEMM(abuf, DM, W_GTL, DM, T_TOK, DM, DM, EPI_PLE16, (layer ? gbuf : hbuf), DM, (const float*)hbuf, (const float*)PPBUF) })
}

__global__ void __launch_bounds__(NT, 2) mega(Params P) {
    extern __shared__ __attribute__((aligned(16))) unsigned char lds[];
    cg::grid_group grid = cg::this_grid();
    const int lo = P.ph_lo, hi = P.ph_hi;
    if (lo < 0) grid.sync();
    volatile PG8_LAS unsigned* xst = (volatile PG8_LAS unsigned*)((PG8_LAS unsigned char*)lds + LDS_ST_OFF);
    if (threadIdx.x < 4) xst[threadIdx.x] = 0u;
    __syncthreads();
    const XcdBarrier xbar = xcd_barrier_post((unsigned*)(P.ws + OFF_BAR), xst);
    PH(0, { cvt_weights0(P, (float*)lds); ph_norm(P.x, P.mix_norm_w, abuf, nullptr); })
    PH(1, GEMM(abuf, DM, (bf16_t*)(ws + W_IN) + (size_t)2048 * DM, DM, T_TOK, LDP, DM, EPI_BF16, proj, LDP))
    PH(2, ph_ssd_halo(P))
    PH(3, ph_ssd_bcconv(P, lds))
    PH(4, ph_ssd_scan(P, lds))
    PH(5, GEMM(abuf, DM, (bf16_t*)(ws + W_IN), DM, T_TOK, 2048, DM, EPI_ZGATE, proj, LDP, nullptr, nullptr, (const bf16_t*)(ws + OFF_YF), (const bf16_t*)P.out))
    PH(6, { ph_gn_scale(P); cvt_weights1(P, (float*)lds); })
    PH(7, GEMM(proj, LDP, (bf16_t*)(ws + W_OUT), 2048, T_TOK, DM, 2048, EPI_RESX, hbuf, DM, P.x))
    ffn_section(P, 0, 8, lo, hi, xbar, lds);
    PH(18, ph_norm16(hbuf, P.mix_norm_w + DM, abuf, nullptr))
    PH(19, ph_s5_main(P, lds))
    PH(20, GEMM(gbuf, DM, (bf16_t*)(ws + W_GLU), DM, T_TOK, 2048, DM, EPI_GLU16, hbuf, DM, (const float*)hbuf, nullptr, nullptr, nullptr, P.s5_b_glu))
    ffn_section(P, 1, 21, lo, hi, xbar, lds);
    PH(31, ph_norm16(gbuf, P.final_norm_w, nullptr, P.out))
}

extern "C" void kernel_launch(void* const* d_in, const int* in_sizes, int n_in, void* d_out, int out_size, void* d_ws, size_t ws_size, hipStream_t stream) {
    static int grid_blocks = 0;
    if (!grid_blocks) {
        int dev = 0, cus = 0, per_cu = 0;
        hipGetDevice(&dev);
        hipDeviceGetAttribute(&cus, hipDeviceAttributeMultiprocessorCount, dev);
        hipFuncSetAttribute((const void*)mega, hipFuncAttributeMaxDynamicSharedMemorySize, (int)LDS_BYTES);
        hipOccupancyMaxActiveBlocksPerMultiprocessor(&per_cu, (const void*)mega, NT, LDS_BYTES);
        if (per_cu < 1) per_cu = 1;
        grid_blocks = cus * per_cu;
        if (ws_size < 256 * MiB) fprintf(stderr, "workspace too small: %zu\n", ws_size);
    }
    Params P{};
    const float** pp = (const float**)&P;
    for (int i = 0; i < 30; ++i) pp[i] = (const float*)d_in[i];
    P.out = (float*)d_out; P.ws = (unsigned char*)d_ws;
#if COOP
    (void)hipMemsetAsync((unsigned char*)d_ws + OFF_BAR, 0, XCD_BAR_WORDS * 4, stream);
    P.ph_lo = 0; P.ph_hi = NPH;
    void* args[] = {&P};
    hipError_t e = hipLaunchCooperativeKernel((const void*)mega, dim3(grid_blocks), dim3(NT), args, LDS_BYTES, stream);
    if (e != hipSuccess) fprintf(stderr, "cooperative launch failed: %s (grid %d)\n", hipGetErrorString(e), grid_blocks);
#else
    for (int ph = 0; ph < NPH; ++ph) {
        P.ph_lo = ph; P.ph_hi = ph + 1;
        hipLaunchKernelGGL(mega, dim3(grid_blocks), dim3(NT), LDS_BYTES, stream, P);
    }
#endif
}
```

```cpp
#include <hip/hip_runtime.h>
#include <hip/hip_cooperative_groups.h>
#include <cstdio>
namespace cg = cooperative_groups;

#ifndef COOP
#define COOP 1
#endif

typedef unsigned short bf16_t;
typedef float f32x4 __attribute__((ext_vector_type(4)));
typedef unsigned u32x4 __attribute__((ext_vector_type(4)));
typedef unsigned u32x2 __attribute__((ext_vector_type(2)));

constexpr int NT = 512;
constexpr int T_TOK = 16384, DM = 1024, SEQ = 4096, NB = 4;
constexpr int LDP = 3328;
constexpr int FH = 1408;
constexpr float EPS = 1e-6f;
constexpr size_t MiB = 1u << 20;
constexpr size_t OFF_W0 = 0;
constexpr size_t W_IN = OFF_W0, W_OUT = W_IN + (size_t)5376 * 1024 * 2, W_UP0 = W_OUT + 4 * MiB, W_DN0 = W_UP0 + 11 * MiB, W_GT0 = W_DN0 + (size_t)1024 * 2816 * 2, W_PP0 = W_GT0 + 2 * MiB;
constexpr size_t OFF_ABUF = 34 * MiB;
constexpr size_t OFF_R = 66 * MiB;
constexpr size_t OFF_G = 186 * MiB;
constexpr size_t OFF_W1 = 230 * MiB;
constexpr size_t W_GLU = OFF_W1, W_UP1 = W_GLU + 4 * MiB, W_DN1 = W_UP1 + 11 * MiB, W_GT1 = W_DN1 + (size_t)1024 * 2816 * 2, W_PP1 = W_GT1 + 2 * MiB;
constexpr size_t OFF_YF = 186 * MiB;
constexpr size_t OFF_SMALL = 253 * MiB;
constexpr size_t LDS_BYTES = 160 * 1024;

struct Params {
    const float *x, *p, *ssd_w_in, *ssd_conv_w, *ssd_conv_b, *ssd_dt_bias, *ssd_a_log, *ssd_d, *ssd_norm_w, *ssd_w_out;
    const float *s5_a_re, *s5_a_im, *s5_log_step, *s5_b_re, *s5_b_im, *s5_c_re, *s5_c_im, *s5_d, *s5_w_glu, *s5_b_glu;
    const float *mix_norm_w, *ffn_norm_w, *ffn_w_up, *ffn_conv_w, *ffn_conv_b, *ffn_w_down, *ple_norm_w, *ple_w_gate, *ple_w_proj, *final_norm_w;
    float* out; unsigned char* ws;
    int ph_lo, ph_hi;
};

__device__ __forceinline__ int otid() { int t = (int)__builtin_amdgcn_workitem_id_x(); asm volatile("" : "+v"(t)); return t & (NT - 1); }
__device__ __forceinline__ float bf2f(bf16_t b) { return __uint_as_float(((unsigned)b) << 16); }
__device__ __forceinline__ bf16_t f2bf(float f) { unsigned u = __float_as_uint(f); u += 0x7FFFu + ((u >> 16) & 1u); return (bf16_t)(u >> 16); }
__device__ __forceinline__ unsigned pack2(float lo, float hi) { return (unsigned)f2bf(lo) | ((unsigned)f2bf(hi) << 16); }
__device__ __forceinline__ float siluf(float v) { return v / (1.0f + __expf(-v)); }
__device__ __forceinline__ float sigmf(float v) { return 1.0f / (1.0f + __expf(-v)); }
__device__ __forceinline__ float wave_sum(float v) {
#pragma unroll
    for (int o = 32; o >= 1; o >>= 1) v += __shfl_xor(v, o);
    return v;
}

#define PG8_LAS __attribute__((address_space(3)))
typedef short bf16x8 __attribute__((ext_vector_type(8)));
namespace pg8 {
constexpr int BM = 256, BK = 64, HALF = 128, HTB = HALF * BK * 2, STAGE_BYTES = 8 * HTB, NXCD = 8, WGM = 8;
__device__ __forceinline__ int lds_byte(int r, int c) { const int st = (r >> 4) * 2 + (c >> 5), rr = r & 15, cc = c & 31, ob = rr * 64 + cc * 2; return st * 1024 + (ob ^ (((ob >> 9) & 1) << 5)); }
__device__ __forceinline__ void stage_rc(int b, int& R, int& C) { const int st = b / 1024, sb = b % 1024, swz = sb ^ (((sb >> 9) & 1) << 5); R = (st >> 1) * 16 + swz / 64; C = (st & 1) * 32 + (swz % 64) / 2; }
__device__ __forceinline__ int perm32(int rho) { const int n = rho >> 4, i = rho & 15; return 8 * (i >> 2) + 4 * n + (i & 3); }
struct Unit { int pm, pn; };
struct StaticOrder {
    int nM, nN, nwg, G, c;
    __device__ void init(int M, int N, int G_, int c_) { nM = M / BM; nN = N / BM; nwg = nM * nN; G = G_; c = c_; }
    __device__ bool next(int i, Unit& u) const {
        const long L = (long)i * G + c; if (L >= nwg) return false;
        int wgid = (int)L; { const int q = nwg / NXCD, r = nwg % NXCD, xcd = wgid % NXCD, off = wgid / NXCD; wgid = (xcd < r ? xcd * (q + 1) : r * (q + 1) + (xcd - r) * q) + off; }
        const int nig = WGM * nN, gid = wgid / nig, fm = gid * WGM, gsz = (nM - fm) < WGM ? (nM - fm) : WGM;
        u.pm = fm + ((wgid % nig) % gsz); u.pn = (wgid % nig) / gsz; return true;
    }
};
typedef __bf16 bf16x2_t __attribute__((ext_vector_type(2)));
typedef float f32x2_t __attribute__((ext_vector_type(2)));
__device__ __forceinline__ unsigned cvt_pk_bf16(float lo, float hi) { const f32x2_t v = {lo, hi}; union { bf16x2_t b; unsigned u; } r; r.b = __builtin_convertvector(v, bf16x2_t); return r.u; }
}
__device__ __forceinline__ float fsig(float v) { return __builtin_amdgcn_rcpf(1.0f + __expf(-v)); }
__device__ __forceinline__ void unpack8(const u32x4 v, float (&f)[8]) {
#pragma unroll
    for (int j = 0; j < 4; ++j) { f[2 * j] = __uint_as_float(v[j] << 16); f[2 * j + 1] = __uint_as_float(v[j] & 0xffff0000u); }
}
__device__ __forceinline__ f32x4 bf4lo(unsigned a, unsigned b) { return (f32x4){__uint_as_float(a << 16), __uint_as_float(a & 0xffff0000u), __uint_as_float(b << 16), __uint_as_float(b & 0xffff0000u)}; }

struct WDesc { const float* W; bf16_t* Wt; int K, Nsrc, Ndst, mode, H, ntiles; };
__device__ __forceinline__ void cvt_tile(const WDesc& d, int tile, float* lds) {
    const int tid = threadIdx.x, nnt = d.Ndst / 64;
    const int n0 = (tile % nnt) * 64, k0 = (tile / nnt) * 64;
    int src0;
    if (d.mode == 0) src0 = (n0 < d.Nsrc) ? n0 : -1;
    else { const int pn = n0 / 256, w = n0 % 256; src0 = (w < 128) ? pn * 128 + w : d.H + pn * 128 + (w - 128); }
    __syncthreads();
#pragma unroll
    for (int i = 0; i < 2; ++i) {
        const int r = (tid >> 4) + 32 * i, c4 = (tid & 15) * 4;
        f32x4 v = {0.f, 0.f, 0.f, 0.f};
        if (src0 >= 0) v = *(const f32x4*)(d.W + (size_t)(k0 + r) * d.Nsrc + src0 + c4);
#pragma unroll
        for (int j = 0; j < 4; ++j) lds[r * 65 + c4 + j] = v[j];
    }
    __syncthreads();
    {
        const int nr = tid >> 3, kp = (tid & 7) * 8;
        u32x4 o;
#pragma unroll
        for (int j = 0; j < 4; ++j) o[j] = pg8::cvt_pk_bf16(lds[(kp + 2 * j) * 65 + nr], lds[(kp + 2 * j + 1) * 65 + nr]);
        *(u32x4*)(d.Wt + (size_t)(n0 + nr) * d.K + k0 + kp) = o;
    }
}
__device__ __forceinline__ WDesc mkdesc(const float* W, bf16_t* Wt, int K, int Nsrc, int Ndst, int mode, int H) { WDesc d; d.W = W; d.Wt = Wt; d.K = K; d.Nsrc = Nsrc; d.Ndst = Ndst; d.mode = mode; d.H = H; d.ntiles = (K / 64) * (Ndst / 64); return d; }
#define CVT_ONE(W, Wt, K, Ns, Nd, mode, H) { const int n_ = ((K) / 64) * ((Nd) / 64); if (tt >= 0 && tt < n_) { const WDesc d_ = mkdesc(W, Wt, K, Ns, Nd, mode, H); cvt_tile(d_, tt, lds); } tt -= n_; }
__device__ __forceinline__ void cvt_weights0(const Params& P, float* lds) {
    unsigned char* ws = P.ws;
    for (int t = blockIdx.x; t < 1344 + 512 + 1408 + 704 + 256 + 64; t += gridDim.x) {
        int tt = t;
        CVT_ONE(P.ssd_w_in, (bf16_t*)(ws + W_IN), 1024, 5184, 5376, 0, 0)
        CVT_ONE(P.ssd_w_out, (bf16_t*)(ws + W_OUT), 2048, 1024, 1024, 0, 0)
        CVT_ONE(P.ffn_w_up, (bf16_t*)(ws + W_UP0), 1024, 5632, 5632, 1, 2816)
        CVT_ONE(P.ffn_w_down, (bf16_t*)(ws + W_DN0), 2816, 1024, 1024, 0, 0)
        CVT_ONE(P.ple_w_gate, (bf16_t*)(ws + W_GT0), 1024, 1024, 1024, 0, 0)
        CVT_ONE(P.ple_w_proj, (bf16_t*)(ws + W_PP0), 256, 1024, 1024, 0, 0)
    }
}
__device__ __forceinline__ void cvt_weights1(const Params& P, float* lds) {
    unsigned char* ws = P.ws;
    for (int t = blockIdx.x; t < 512 + 1408 + 704 + 256 + 64; t += gridDim.x) {
        int tt = t;
        CVT_ONE(P.s5_w_glu, (bf16_t*)(ws + W_GLU), 1024, 2048, 2048, 1, 1024)
        CVT_ONE(P.ffn_w_up + (size_t)1024 * 5632, (bf16_t*)(ws + W_UP1), 1024, 5632, 5632, 1, 2816)
        CVT_ONE(P.ffn_w_down + (size_t)2816 * 1024, (bf16_t*)(ws + W_DN1), 2816, 1024, 1024, 0, 0)
        CVT_ONE(P.ple_w_gate + (size_t)1024 * 1024, (bf16_t*)(ws + W_GT1), 1024, 1024, 1024, 0, 0)
        CVT_ONE(P.ple_w_proj + (size_t)256 * 1024, (bf16_t*)(ws + W_PP1), 256, 1024, 1024, 0, 0)
    }
}
__device__ __forceinline__ void ph_norm(const float* src, const float* w, bf16_t* dstb, float* dstf) {
    const int lane = threadIdx.x & 63, wid = threadIdx.x >> 6;
    for (int row = blockIdx.x * 8 + wid; row < T_TOK; row += gridDim.x * 8) {
        const float* s = src + (size_t)row * DM;
        f32x4 v[4]; float ss = 0.f;
#pragma unroll
        for (int i = 0; i < 4; ++i) { v[i] = *(const f32x4*)(s + lane * 4 + 256 * i); ss += v[i][0] * v[i][0] + v[i][1] * v[i][1] + v[i][2] * v[i][2] + v[i][3] * v[i][3]; }
        ss = wave_sum(ss);
        const float rstd = rsqrtf(ss * (1.0f / DM) + EPS);
#pragma unroll
        for (int i = 0; i < 4; ++i) {
            const f32x4 wv = *(const f32x4*)(w + lane * 4 + 256 * i);
            const f32x4 o = v[i] * rstd * wv;
            if (dstb) { u32x2 pk; pk.x = pack2(o[0], o[1]); pk.y = pack2(o[2], o[3]); *(u32x2*)(dstb + (size_t)row * DM + lane * 4 + 256 * i) = pk; }
            else *(f32x4*)(dstf + (size_t)row * DM + lane * 4 + 256 * i) = o;
        }
    }
}
__device__ __forceinline__ void ph_norm16(const bf16_t* src, const float* w, bf16_t* dstb, float* dstf) {
    const int lane = threadIdx.x & 63, wid = threadIdx.x >> 6;
    for (int row = blockIdx.x * 8 + wid; row < T_TOK; row += gridDim.x * 8) {
        const bf16_t* sp = src + (size_t)row * DM;
        float v[2][8]; float ss = 0.f;
#pragma unroll
        for (int i = 0; i < 2; ++i) { unpack8(*(const u32x4*)(sp + lane * 8 + 512 * i), v[i]);
#pragma unroll
            for (int j = 0; j < 8; ++j) ss += v[i][j] * v[i][j]; }
        ss = wave_sum(ss);
        const float rstd = rsqrtf(ss * (1.0f / DM) + EPS);
#pragma unroll
        for (int i = 0; i < 2; ++i) {
            const f32x4 w0 = *(const f32x4*)(w + lane * 8 + 512 * i), w1 = *(const f32x4*)(w + lane * 8 + 512 * i + 4);
            float o[8];
#pragma unroll
            for (int j = 0; j < 4; ++j) { o[j] = v[i][j] * rstd * w0[j]; o[4 + j] = v[i][4 + j] * rstd * w1[j]; }
            if (dstb) { u32x4 pk; pk.x = pg8::cvt_pk_bf16(o[0], o[1]); pk.y = pg8::cvt_pk_bf16(o[2], o[3]); pk.z = pg8::cvt_pk_bf16(o[4], o[5]); pk.w = pg8::cvt_pk_bf16(o[6], o[7]); *(u32x4*)(dstb + (size_t)row * DM + lane * 8 + 512 * i) = pk; }
            else { *(f32x4*)(dstf + (size_t)row * DM + lane * 8 + 512 * i) = (f32x4){o[0], o[1], o[2], o[3]}; *(f32x4*)(dstf + (size_t)row * DM + lane * 8 + 512 * i + 4) = (f32x4){o[4], o[5], o[6], o[7]}; }
        }
    }
}
__device__ __forceinline__ void ph_cvt_copy(const float* src, bf16_t* dst, size_t n) {
    for (size_t i = ((size_t)blockIdx.x * NT + threadIdx.x) * 4; i < n; i += (size_t)gridDim.x * NT * 4) {
        const f32x4 v = *(const f32x4*)(src + i); u32x2 pk; pk.x = pack2(v[0], v[1]); pk.y = pack2(v[2], v[3]); *(u32x2*)(dst + i) = pk;
    }
}

enum { EPI_BF16 = 0, EPI_RES = 1, EPI_F32 = 2, EPI_PLE = 3, EPI_GLU = 4, EPI_ZGATE = 5, EPI_RESX = 6, EPI_RES16 = 7, EPI_PLE16 = 8, EPI_GLU16 = 9 };
struct GemmArgs {
    const bf16_t* A; int lda; const bf16_t* Bt; int ldb; int M, N, K; int epi;
    void* out; int ldc; const float* res; const float* aux; const bf16_t* y1; const bf16_t* y2; const float* bias;
};
__device__ __forceinline__ void epi_store(const GemmArgs& g, int row, int pn, int tc, float acc, float accp) {
    const int col = pn * 256 + tc;
    switch (g.epi) {
        case EPI_BF16: ((bf16_t*)g.out)[(size_t)row * g.ldc + col] = f2bf(acc); break;
        case EPI_RES: { const size_t o = (size_t)row * g.ldc + col; ((float*)g.out)[o] = g.res[o] + acc; } break;
        case EPI_F32: ((float*)g.out)[(size_t)row * g.ldc + col] = acc; break;
        case EPI_PLE: { const size_t o = (size_t)row * g.ldc + col; ((float*)g.out)[o] = g.res[o] + g.aux[o] * sigmf(acc); } break;
        case EPI_GLU: { const int oc = pn * 128 + tc; const size_t o = (size_t)row * g.ldc + oc; ((float*)g.out)[o] = g.res[o] + (acc + g.bias[oc]) * sigmf(accp + g.bias[1024 + oc]); } break;
        case EPI_ZGATE: { const size_t yo = (size_t)row * 2048 + col; ((bf16_t*)g.out)[(size_t)row * g.ldc + col] = f2bf((bf2f(g.y1[yo]) + bf2f(g.y2[yo])) * siluf(acc)); } break;
    }
}
__device__ __forceinline__ void gemm_naive(const GemmArgs& g, float* lds) {
    float* As = lds;
    float* Bs = lds + 32 * 132;
    const int tid = threadIdx.x, ty = tid >> 4, tx = tid & 15;
    const int nM = g.M / 128, nN = g.N / 256;
    for (int tile = blockIdx.x; tile < nM * nN; tile += gridDim.x) {
        const int pm = tile % nM, pn = tile / nM;
        float acc[4][16];
#pragma unroll
        for (int i = 0; i < 4; ++i)
#pragma unroll
            for (int j = 0; j < 16; ++j) acc[i][j] = 0.f;
        for (int k0 = 0; k0 < g.K; k0 += 32) {
            __syncthreads();
            { const int r = tid >> 2, kk = (tid & 3) * 8;
              const u32x4 v = *(const u32x4*)(g.A + (size_t)(pm * 128 + r) * g.lda + k0 + kk);
#pragma unroll
              for (int j = 0; j < 4; ++j) { As[(kk + 2 * j) * 132 + r] = __uint_as_float(v[j] << 16); As[(kk + 2 * j + 1) * 132 + r] = __uint_as_float(v[j] & 0xffff0000u); } }
#pragma unroll
            for (int h = 0; h < 2; ++h) { const int r = (tid >> 2) + 128 * h, kk = (tid & 3) * 8;
              const u32x4 v = *(const u32x4*)(g.Bt + (size_t)(pn * 256 + r) * g.ldb + k0 + kk);
#pragma unroll
              for (int j = 0; j < 4; ++j) { Bs[(kk + 2 * j) * 260 + r] = __uint_as_float(v[j] << 16); Bs[(kk + 2 * j + 1) * 260 + r] = __uint_as_float(v[j] & 0xffff0000u); } }
            __syncthreads();
#pragma unroll 4
            for (int kk = 0; kk < 32; ++kk) {
                const f32x4 a = *(const f32x4*)(As + kk * 132 + ty * 4);
                const f32x4 b0 = *(const f32x4*)(Bs + kk * 260 + tx * 8), b1 = *(const f32x4*)(Bs + kk * 260 + tx * 8 + 4);
                const f32x4 b2 = *(const f32x4*)(Bs + kk * 260 + 128 + tx * 8), b3 = *(const f32x4*)(Bs + kk * 260 + 128 + tx * 8 + 4);
#pragma unroll
                for (int i = 0; i < 4; ++i)
#pragma unroll
                    for (int j = 0; j < 4; ++j) { acc[i][j] += a[i] * b0[j]; acc[i][4 + j] += a[i] * b1[j]; acc[i][8 + j] += a[i] * b2[j]; acc[i][12 + j] += a[i] * b3[j]; }
            }
        }
#pragma unroll
        for (int i = 0; i < 4; ++i) {
            const int row = pm * 128 + ty * 4 + i;
#pragma unroll
            for (int j = 0; j < 8; ++j) {
                if (g.epi == EPI_GLU) epi_store(g, row, pn, tx * 8 + j, acc[i][j], acc[i][8 + j]);
                else { epi_store(g, row, pn, tx * 8 + j, acc[i][j], 0.f); epi_store(g, row, pn, 128 + tx * 8 + j, acc[i][8 + j], 0.f); }
            }
        }
    }
}
__device__ __forceinline__ GemmArgs mkgemm(const bf16_t* A, int lda, const bf16_t* Bt, int ldb, int M, int N, int K, int epi, void* out, int ldc,
                                           const float* res = nullptr, const float* aux = nullptr, const bf16_t* y1 = nullptr, const bf16_t* y2 = nullptr, const float* bias = nullptr) {
    GemmArgs g; g.A = A; g.lda = lda; g.Bt = Bt; g.ldb = ldb; g.M = M; g.N = N; g.K = K; g.epi = epi; g.out = out; g.ldc = ldc; g.res = res; g.aux = aux; g.y1 = y1; g.y2 = y2; g.bias = bias; return g;
}

template <int EPI>
__device__ __forceinline__ void epi_tile(const GemmArgs& g, const f32x4 (&acc)[2][2][4][2], const pg8::Unit& u, int wr, int wc, int fr, int fq) {
    const int row0 = u.pm * 256 + wr * 64 + fr;
    if constexpr (EPI == EPI_RESX || EPI == EPI_RES16 || EPI == EPI_PLE16 || EPI == EPI_GLU16) {
        constexpr int NBJ = (EPI == EPI_GLU16) ? 1 : 2;
        const int col0 = (EPI == EPI_GLU16 ? u.pn * 128 : u.pn * 256) + wc * 32 + 8 * fq;
        f32x4 bv[2] = {{0.f, 0.f, 0.f, 0.f}, {0.f, 0.f, 0.f, 0.f}}, bg[2] = {{0.f, 0.f, 0.f, 0.f}, {0.f, 0.f, 0.f, 0.f}};
        if constexpr (EPI == EPI_GLU16) {
#pragma unroll
            for (int n = 0; n < 2; ++n) { bv[n] = *(const f32x4*)(g.bias + col0 + 4 * n); bg[n] = *(const f32x4*)(g.bias + 1024 + col0 + 4 * n); }
        }
#pragma unroll
        for (int ai = 0; ai < 2; ++ai)
#pragma unroll
            for (int m = 0; m < 4; ++m) {
                const int row = row0 + ai * 128 + m * 16;
#pragma unroll
                for (int bj = 0; bj < NBJ; ++bj) {
                    const size_t o = (size_t)row * g.ldc + col0 + bj * 128;
                    f32x4 r0, r1;
                    if constexpr (EPI == EPI_RESX) { r0 = *(const f32x4*)(g.res + o); r1 = *(const f32x4*)(g.res + o + 4); }
                    else { const u32x4 rr = *(const u32x4*)((const bf16_t*)g.res + o); r0 = bf4lo(rr[0], rr[1]); r1 = bf4lo(rr[2], rr[3]); }
                    f32x4 v0 = acc[ai][bj][m][0], v1 = acc[ai][bj][m][1];
                    if constexpr (EPI == EPI_PLE16) {
                        const u32x4 aa = *(const u32x4*)((const bf16_t*)g.aux + o); const f32x4 a0 = bf4lo(aa[0], aa[1]), a1 = bf4lo(aa[2], aa[3]);
#pragma unroll
                        for (int j = 0; j < 4; ++j) { v0[j] = a0[j] * fsig(v0[j]); v1[j] = a1[j] * fsig(v1[j]); }
                    }
                    if constexpr (EPI == EPI_GLU16) {
                        const f32x4 g0 = acc[ai][1][m][0] + bg[0], g1 = acc[ai][1][m][1] + bg[1];
                        v0 += bv[0]; v1 += bv[1];
#pragma unroll
                        for (int j = 0; j < 4; ++j) { v0[j] *= fsig(g0[j]); v1[j] *= fsig(g1[j]); }
                    }
                    v0 += r0; v1 += r1;
                    u32x4 w; w.x = pg8::cvt_pk_bf16(v0[0], v0[1]); w.y = pg8::cvt_pk_bf16(v0[2], v0[3]); w.z = pg8::cvt_pk_bf16(v1[0], v1[1]); w.w = pg8::cvt_pk_bf16(v1[2], v1[3]);
                    *(u32x4*)((bf16_t*)g.out + o) = w;
                }
                asm volatile("" ::: "memory");
            }
    } else if constexpr (EPI == EPI_BF16 || EPI == EPI_ZGATE) {
        const int col0 = u.pn * 256 + wc * 32 + 8 * fq;
#pragma unroll
        for (int ai = 0; ai < 2; ++ai)
#pragma unroll
            for (int m = 0; m < 4; ++m) {
                const int row = row0 + ai * 128 + m * 16;
#pragma unroll
                for (int bj = 0; bj < 2; ++bj) {
                    f32x4 v0 = acc[ai][bj][m][0], v1 = acc[ai][bj][m][1];
                    const int col = col0 + bj * 128;
                    if constexpr (EPI == EPI_ZGATE) {
                        const u32x4 a = *(const u32x4*)(g.y1 + (size_t)row * 2048 + col), b = *(const u32x4*)(g.y2 + (size_t)row * 2048 + col);
                        const f32x4 y0 = bf4lo(a[0], a[1]) + bf4lo(b[0], b[1]), y1v = bf4lo(a[2], a[3]) + bf4lo(b[2], b[3]);
#pragma unroll
                        for (int j = 0; j < 4; ++j) { v0[j] = y0[j] * v0[j] * fsig(v0[j]); v1[j] = y1v[j] * v1[j] * fsig(v1[j]); }
                    }
                    u32x4 w; w.x = pg8::cvt_pk_bf16(v0[0], v0[1]); w.y = pg8::cvt_pk_bf16(v0[2], v0[3]); w.z = pg8::cvt_pk_bf16(v1[0], v1[1]); w.w = pg8::cvt_pk_bf16(v1[2], v1[3]);
                    *(u32x4*)((bf16_t*)g.out + (size_t)row * g.ldc + col) = w;
                }
                if constexpr (EPI == EPI_ZGATE) asm volatile("" ::: "memory");
            }
    } else if constexpr (EPI == EPI_GLU) {
        const int col0 = u.pn * 128 + wc * 32 + 4 * fq;
        f32x4 bv[2], bg[2];
#pragma unroll
        for (int n = 0; n < 2; ++n) { bv[n] = *(const f32x4*)(g.bias + col0 + 16 * n); bg[n] = *(const f32x4*)(g.bias + 1024 + col0 + 16 * n); }
#pragma unroll
        for (int ai = 0; ai < 2; ++ai)
#pragma unroll
            for (int m = 0; m < 4; ++m) {
                const int row = row0 + ai * 128 + m * 16;
#pragma unroll
                for (int n = 0; n < 2; ++n) {
                    const size_t o = (size_t)row * g.ldc + col0 + 16 * n;
                    const f32x4 r = *(const f32x4*)(g.res + o), v = acc[ai][0][m][n] + bv[n], gt = acc[ai][1][m][n] + bg[n];
                    f32x4 ov;
#pragma unroll
                    for (int j = 0; j < 4; ++j) ov[j] = r[j] + v[j] * fsig(gt[j]);
                    *(f32x4*)((float*)g.out + o) = ov;
                }
                asm volatile("" ::: "memory");
            }
    } else {
        const int col0 = u.pn * 256 + wc * 32 + 4 * fq;
#pragma unroll
        for (int ai = 0; ai < 2; ++ai)
#pragma unroll
            for (int m = 0; m < 4; ++m) {
                const int row = row0 + ai * 128 + m * 16;
#pragma unroll
                for (int bj = 0; bj < 2; ++bj)
#pragma unroll
                    for (int n = 0; n < 2; ++n) {
                        const size_t o = (size_t)row * g.ldc + col0 + bj * 128 + n * 16;
                        f32x4 ov = acc[ai][bj][m][n];
                        if constexpr (EPI == EPI_RES) ov += *(const f32x4*)(g.res + o);
                        if constexpr (EPI == EPI_PLE) { const f32x4 r = *(const f32x4*)(g.res + o), a = *(const f32x4*)(g.aux + o);
#pragma unroll
                            for (int j = 0; j < 4; ++j) ov[j] = r[j] + a[j] * fsig(ov[j]); }
                        *(f32x4*)((float*)g.out + o) = ov;
                    }
                if constexpr (EPI != EPI_F32) asm volatile("" ::: "memory");
            }
    }
}

template <int EPI>
__device__ __forceinline__ void gemm_pg8(PG8_LAS unsigned char* lds, const GemmArgs g) {
    using namespace pg8;
    constexpr bool PERM = (EPI == EPI_BF16 || EPI == EPI_ZGATE || EPI == EPI_RESX || EPI == EPI_RES16 || EPI == EPI_PLE16 || EPI == EPI_GLU16);
    const int tid = otid(), wid = __builtin_amdgcn_readfirstlane(tid >> 6), lane = tid & 63, wr = wid >> 2, wc = wid & 3, fr = lane & 15, fq = lane >> 4;
    const int K = g.K, nt = K / BK;
    StaticOrder S; S.init(g.M, g.N, (int)gridDim.x, (int)blockIdx.x);
    unsigned voffA[2], voffB[2];
#pragma unroll
    for (int i = 0; i < 2; ++i) { int R, C; stage_rc(tid * 16 + i * 8192, R, C); const int Rb = PERM ? ((R & ~31) + perm32(R & 31)) : R;
        voffA[i] = (unsigned)(R * g.lda + C) * 2u; voffB[i] = (unsigned)(Rb * g.ldb + C) * 2u; }
    const size_t kstep = (size_t)(BK * 2);
    const size_t hstepA = (size_t)HALF * g.lda * 2, hstepB = (size_t)HALF * g.ldb * 2;
    const size_t tstepA = 2 * hstepA, tstepB = 2 * hstepB;
    const unsigned ldsw = (unsigned)wid * 1024u;
    const int aoff = lds_byte(wr * 64 + fr, fq * 8), boff = lds_byte(wc * 32 + fr, fq * 8);
#define PG8_SA(b, h) (((b) * 2 + (h)) * HTB)
#define PG8_SB(b, h) ((4 + (b) * 2 + (h)) * HTB)
#define PG8_STAGE(bufoff, gbase, voff) do { _Pragma("unroll") for (int _i = 0; _i < 2; ++_i) \
        __builtin_amdgcn_global_load_lds((const unsigned*)((const char*)(gbase) + (voff)[_i]), (PG8_LAS unsigned*)(lds + (bufoff) + ldsw + _i * 8192), 16, 0, 0); } while (0)
#define PG8_LDA(dst, b, h) do { _Pragma("unroll") for (int m = 0; m < 4; ++m) _Pragma("unroll") for (int k = 0; k < 2; ++k) dst[m][k] = *(const PG8_LAS bf16x8*)(lds + PG8_SA(b, h) + aoff + m * 2048 + k * 1024); } while (0)
#define PG8_LDB(dst, b, h) do { _Pragma("unroll") for (int n = 0; n < 2; ++n) _Pragma("unroll") for (int k = 0; k < 2; ++k) dst[n][k] = *(const PG8_LAS bf16x8*)(lds + PG8_SB(b, h) + boff + n * 2048 + k * 1024); } while (0)
#define PG8_MMA(ai, bj, At, Bt) do { __builtin_amdgcn_s_setprio(1); _Pragma("unroll") for (int m = 0; m < 4; ++m) _Pragma("unroll") for (int n = 0; n < 2; ++n) _Pragma("unroll") for (int k = 0; k < 2; ++k) \
        acc[ai][bj][m][n] = __builtin_amdgcn_mfma_f32_16x16x32_bf16(Bt[n][k], At[m][k], acc[ai][bj][m][n], 0, 0, 0); __builtin_amdgcn_s_setprio(0); } while (0)
#define PG8_WAIT_V(n) asm volatile("s_waitcnt vmcnt(" #n ")" ::: "memory")
#define PG8_WAIT_L(n) asm volatile("s_waitcnt lgkmcnt(" #n ")" ::: "memory")
#define PG8_BAR __builtin_amdgcn_s_barrier()
#define PG8_SCHED __builtin_amdgcn_sched_barrier(0)
    Unit cur, nxt; int ui = 0;
    if (!S.next(0, cur)) return;
    f32x4 acc[2][2][4][2];
#pragma unroll
    for (int a = 0; a < 2; ++a)
#pragma unroll
        for (int b = 0; b < 2; ++b)
#pragma unroll
            for (int m = 0; m < 4; ++m)
#pragma unroll
                for (int n = 0; n < 2; ++n) acc[a][b][m][n] = (f32x4){0.f, 0.f, 0.f, 0.f};
    bf16x8 At[4][2], B0[2][2], B1[2][2];
    const char* cA = (const char*)g.A + (size_t)cur.pm * tstepA; const char* cB = (const char*)g.Bt + (size_t)cur.pn * tstepB;
    PG8_STAGE(PG8_SB(0, 0), cB, voffB); PG8_STAGE(PG8_SA(0, 0), cA, voffA); PG8_STAGE(PG8_SB(0, 1), cB + hstepB, voffB); PG8_STAGE(PG8_SA(0, 1), cA + hstepA, voffA);
    if (wr == 1) PG8_BAR;
    PG8_WAIT_V(4); PG8_BAR;
    PG8_STAGE(PG8_SB(1, 0), cB + kstep, voffB); PG8_STAGE(PG8_SA(1, 0), cA + kstep, voffA); PG8_STAGE(PG8_SB(1, 1), cB + hstepB + kstep, voffB);
    PG8_WAIT_V(6); PG8_BAR;
    for (;;) {
        const bool has_next = S.next(ui + 1, nxt);
        const char* nA = has_next ? (const char*)g.A + (size_t)nxt.pm * tstepA : cA; const char* nB = has_next ? (const char*)g.Bt + (size_t)nxt.pn * tstepB : cB;
        for (int t = 0; t < nt; t += 2) {
            const bool last = (t == nt - 2);
            const char* a1 = cA + (size_t)(t + 1) * kstep;
            const char* a2 = last ? nA : cA + (size_t)(t + 2) * kstep; const char* b2 = last ? nB : cB + (size_t)(t + 2) * kstep;
            const char* a3 = a2 + kstep; const char* b3 = b2 + kstep;
            PG8_LDB(B0, 0, 0); PG8_SCHED; PG8_LDA(At, 0, 0); PG8_STAGE(PG8_SA(1, 1), a1 + hstepA, voffA);
            PG8_WAIT_L(8); PG8_BAR; PG8_WAIT_L(0); PG8_MMA(0, 0, At, B0); PG8_BAR; PG8_SCHED;
            PG8_LDB(B1, 0, 1); PG8_STAGE(PG8_SB(0, 0), b2, voffB);
            PG8_BAR; PG8_WAIT_L(0); PG8_MMA(0, 1, At, B1); PG8_BAR;
            PG8_LDA(At, 0, 1); PG8_STAGE(PG8_SA(0, 0), a2, voffA);
            PG8_BAR; PG8_WAIT_L(0); PG8_MMA(1, 0, At, B0); PG8_BAR; PG8_SCHED;
            PG8_STAGE(PG8_SB(0, 1), b2 + hstepB, voffB);
            PG8_WAIT_V(6); PG8_BAR; PG8_MMA(1, 1, At, B1); PG8_BAR;
            PG8_LDB(B0, 1, 0); PG8_SCHED; PG8_LDA(At, 1, 0); PG8_STAGE(PG8_SA(0, 1), a2 + hstepA, voffA);
            PG8_WAIT_L(8); PG8_BAR; PG8_WAIT_L(0); PG8_MMA(0, 0, At, B0); PG8_BAR; PG8_SCHED;
            PG8_LDB(B1, 1, 1); PG8_STAGE(PG8_SB(1, 0), b3, voffB);
            PG8_BAR; PG8_WAIT_L(0); PG8_MMA(0, 1, At, B1); PG8_BAR;
            PG8_LDA(At, 1, 1); PG8_STAGE(PG8_SA(1, 0), a3, voffA);
            PG8_BAR; PG8_WAIT_L(0); PG8_MMA(1, 0, At, B0); PG8_BAR; PG8_SCHED;
            PG8_STAGE(PG8_SB(1, 1), b3 + hstepB, voffB);
            PG8_WAIT_V(6); PG8_BAR; PG8_MMA(1, 1, At, B1); PG8_BAR;
        }
        epi_tile<EPI>(g, acc, cur, wr, wc, fr, fq);
        if (!has_next) break;
#pragma unroll
        for (int a = 0; a < 2; ++a)
#pragma unroll
            for (int b = 0; b < 2; ++b)
#pragma unroll
                for (int m = 0; m < 4; ++m)
#pragma unroll
                    for (int n = 0; n < 2; ++n) acc[a][b][m][n] = (f32x4){0.f, 0.f, 0.f, 0.f};
        cur = nxt; cA = nA; cB = nB; ++ui;
    }
    PG8_WAIT_V(0);
    if (wr == 0) PG8_BAR;
    PG8_BAR;
#undef PG8_SA
#undef PG8_SB
#undef PG8_STAGE
#undef PG8_LDA
#undef PG8_LDB
#undef PG8_MMA
#undef PG8_WAIT_V
#undef PG8_WAIT_L
#undef PG8_BAR
#undef PG8_SCHED
}

__device__ __forceinline__ void ph_ssd_halo(const Params& P) {
    bf16_t* proj = (bf16_t*)(P.ws + OFF_R); bf16_t* halo = (bf16_t*)(P.ws + OFF_SMALL);
    const int gt = blockIdx.x * NT + threadIdx.x, gs = gridDim.x * NT;
    for (int i = gt; i < 512 * 4 * 256; i += gs) {
        const int ch = i & 255, hr = (i >> 8) & 3, item = i >> 10;
        const int g = item & 3, c = (item >> 2) & 31, b = item >> 7;
        const int lt = c * 128 + (hr < 2 ? hr - 2 : 126 + hr);
        const int col = 2048 + (ch >> 7) * 512 + g * 128 + (ch & 127);
        bf16_t v = 0;
        if (lt >= 0 && lt < SEQ) v = proj[(size_t)(b * SEQ + lt) * LDP + col];
        halo[i] = v;
    }
    for (int i = gt; i < T_TOK * 64; i += gs) {
        const int j = i & 63, t = i >> 6;
        const float xr = bf2f(proj[(size_t)t * LDP + 3072 + j]) + P.ssd_dt_bias[j];
        const float sp = fmaxf(xr, 0.f) + log1pf(__expf(-fabsf(xr)));
        ((float*)(proj + (size_t)t * LDP + 3136))[j] = sp;
    }
}
constexpr size_t OFF_CB = OFF_R + 104 * MiB;
__device__ __forceinline__ void ph_ssd_bcconv(const Params& P, unsigned char* ldsraw) {
    bf16_t* proj = (bf16_t*)(P.ws + OFF_R); const bf16_t* halo = (const bf16_t*)(P.ws + OFF_SMALL); bf16_t* CBg = (bf16_t*)(P.ws + OFF_CB);
    bf16_t* tile = (bf16_t*)ldsraw;
    bf16_t* cv = tile + 132 * 256;
    const int tid = threadIdx.x, lane = tid & 63, wid = tid >> 6, fr = lane & 15, q = lane >> 4;
    for (int item = blockIdx.x; item < 512; item += gridDim.x) {
        const int g = item & 3, c = (item >> 2) & 31, b = item >> 7;
        const size_t r0 = (size_t)b * SEQ + c * 128;
        __syncthreads();
        for (int i = tid; i < 132 * 32; i += NT) {
            const int co = i & 31, r = i >> 5, ch = co * 8;
            const int col = 2048 + (ch >> 7) * 512 + g * 128 + (ch & 127);
            u32x4 v;
            if (r < 2) v = *(const u32x4*)(halo + (size_t)item * 1024 + r * 256 + ch);
            else if (r >= 130) v = *(const u32x4*)(halo + (size_t)item * 1024 + (r - 128) * 256 + ch);
            else v = *(const u32x4*)(proj + (r0 + r - 2) * LDP + col);
            *(u32x4*)(tile + r * 256 + ch) = v;
        }
        __syncthreads();
        for (int i = tid; i < 128 * 32; i += NT) {
            const int co = i & 31, r = i >> 5, ch = co * 8;
            const int col = 2048 + (ch >> 7) * 512 + g * 128 + (ch & 127);
            float acc[8];
            { const f32x4 b0 = *(const f32x4*)(P.ssd_conv_b + col), b1 = *(const f32x4*)(P.ssd_conv_b + col + 4);
#pragma unroll
              for (int j = 0; j < 4; ++j) { acc[j] = b0[j]; acc[4 + j] = b1[j]; } }
#pragma unroll
            for (int k = 0; k < 5; ++k) {
                float xv[8]; unpack8(*(const u32x4*)(tile + (r + k) * 256 + ch), xv);
                const f32x4 w0 = *(const f32x4*)(P.ssd_conv_w + k * 3072 + col), w1 = *(const f32x4*)(P.ssd_conv_w + k * 3072 + col + 4);
#pragma unroll
                for (int j = 0; j < 4; ++j) { acc[j] += xv[j] * w0[j]; acc[4 + j] += xv[4 + j] * w1[j]; }
            }
            u32x4 o;
#pragma unroll
            for (int j = 0; j < 4; ++j) o[j] = pg8::cvt_pk_bf16(acc[2 * j] * fsig(acc[2 * j]), acc[2 * j + 1] * fsig(acc[2 * j + 1]));
            *(u32x4*)(cv + r * 264 + ch) = o;
            if (ch >= 128) *(u32x4*)(proj + (r0 + r) * LDP + col) = o;
        }
        __syncthreads();
        for (int i = tid; i < 2048; i += NT) {
            const int n = i >> 4, to = (i & 15) * 8; u32x4 o;
#pragma unroll
            for (int j = 0; j < 4; ++j) o[j] = (unsigned)cv[(to + 2 * j) * 264 + n] | ((unsigned)cv[(to + 2 * j + 1) * 264 + n] << 16);
            *(u32x4*)(proj + (r0 + n) * LDP + 2048 + g * 128 + to) = o;
        }
        bf16x8 af[4];
#pragma unroll
        for (int ks = 0; ks < 4; ++ks) af[ks] = *(const bf16x8*)(cv + (16 * wid + fr) * 264 + 32 * ks + 8 * q);
        bf16_t* cbo = CBg + (size_t)item * 16384;
#pragma unroll
        for (int lt = 0; lt < 8; ++lt) {
            f32x4 acc = {0.f, 0.f, 0.f, 0.f};
#pragma unroll
            for (int ks = 0; ks < 4; ++ks) { const bf16x8 bfr = *(const bf16x8*)(cv + (16 * lt + fr) * 264 + 128 + 32 * ks + 8 * q); acc = __builtin_amdgcn_mfma_f32_16x16x32_bf16(af[ks], bfr, acc, 0, 0, 0); }
            u32x2 o; o.x = pg8::cvt_pk_bf16(acc[0], acc[1]); o.y = pg8::cvt_pk_bf16(acc[2], acc[3]);
            *(u32x2*)(cbo + (16 * lt + fr) * 128 + 16 * wid + 4 * q) = o;
        }
    }
}
__device__ __forceinline__ void ph_ssd_scan_naive(const Params& P, unsigned char* ldsraw) {
    const bf16_t* proj = (const bf16_t*)(P.ws + OFF_R);
    bf16_t* Bs = (bf16_t*)ldsraw;
    bf16_t* Cs = Bs + 64 * 128;
    float* xs = (float*)(Cs + 64 * 128);
    float* dts = xs + 64 * 64;
    const int tid = threadIdx.x, p = tid >> 3, ng = tid & 7;
    for (int item = blockIdx.x; item < 256; item += gridDim.x) {
        const int d = item & 1, hh = (item >> 1) & 31, b = item >> 6, g = hh >> 3;
        const float a = -__expf(P.ssd_a_log[d * 32 + hh]), dsk = P.ssd_d[hh];
        bf16_t* Y = d ? (bf16_t*)P.out : (bf16_t*)(P.ws + OFF_YF);
        float h[16];
#pragma unroll
        for (int j = 0; j < 16; ++j) h[j] = 0.f;
        for (int blk = 0; blk < SEQ / 64; ++blk) {
            __syncthreads();
            for (int i = tid; i < 64 * 128; i += NT) {
                const int n = i & 127, r = i >> 7; const int lt = d ? SEQ - 1 - (blk * 64 + r) : blk * 64 + r;
                const size_t ro = (size_t)(b * SEQ + lt) * LDP;
                Bs[i] = proj[(size_t)(b * SEQ + (lt & ~127) + n) * LDP + 2048 + g * 128 + (lt & 127)]; Cs[i] = proj[ro + 2560 + g * 128 + n];
            }
            for (int i = tid; i < 64 * 64; i += NT) {
                const int pp = i & 63, r = i >> 6; const int lt = d ? SEQ - 1 - (blk * 64 + r) : blk * 64 + r;
                const int col = hh * 64 + pp;
                float acc = P.ssd_conv_b[col];
#pragma unroll
                for (int k = 0; k < 5; ++k) { const int l2 = lt + k - 2; if (l2 >= 0 && l2 < SEQ) acc += bf2f(proj[(size_t)(b * SEQ + l2) * LDP + col]) * P.ssd_conv_w[k * 3072 + col]; }
                xs[i] = siluf(acc);
            }
            if (tid < 64) { const int lt = d ? SEQ - 1 - (blk * 64 + tid) : blk * 64 + tid; dts[tid] = ((const float*)(proj + (size_t)(b * SEQ + lt) * LDP + 3136))[d * 32 + hh]; }
            __syncthreads();
            for (int r = 0; r < 64; ++r) {
                const float dt = dts[r], xv = xs[r * 64 + p], dA = __expf(dt * a), dx = dt * xv;
                float part = 0.f;
#pragma unroll
                for (int j = 0; j < 16; ++j) { h[j] = h[j] * dA + dx * bf2f(Bs[r * 128 + ng * 16 + j]); part += bf2f(Cs[r * 128 + ng * 16 + j]) * h[j]; }
                part += __shfl_xor(part, 1); part += __shfl_xor(part, 2); part += __shfl_xor(part, 4);
                if (ng == 0) { const int lt = d ? SEQ - 1 - (blk * 64 + r) : blk * 64 + r; Y[(size_t)(b * SEQ + lt) * 2048 + hh * 64 + p] = f2bf(part + (d == 0 ? dsk * xv : 0.f)); }
            }
        }
    }
}
#define LDS_BAR() do { asm volatile("s_waitcnt lgkmcnt(0)" ::: "memory"); __builtin_amdgcn_s_barrier(); asm volatile("" ::: "memory"); } while (0)
__device__ __forceinline__ void ph_ssd_scan(const Params& P, unsigned char* ldsraw) {
    const bf16_t* proj = (const bf16_t*)(P.ws + OFF_R); const bf16_t* CBg = (const bf16_t*)(P.ws + OFF_CB);
    bf16_t* xdT = (bf16_t*)ldsraw;
    bf16_t* xdwT = xdT + 64 * 136;
    bf16_t* stb = xdwT + 64 * 136;
    bf16_t* xraw = stb + 64 * 136;
    float* cs = (float*)(xraw + 132 * 72);
    float* dts = cs + 128;
    float* tot = dts + 128;
    float* cwl = tot + 4;
    float* csA = cwl + 384;
    float* dtsA = csA + 32 * 128;
    float* totA = dtsA + 32 * 128;
    const int tid = threadIdx.x, lane = tid & 63, wid = tid >> 6, fr = lane & 15, q = lane >> 4;
    const int ltile = (wid < 4) ? wid : 11 - wid;
    for (int item = blockIdx.x; item < 256; item += gridDim.x) {
        const int d = item & 1, hh = (item >> 1) & 31, b = item >> 6, g = hh >> 3;
        const float a = -__expf(P.ssd_a_log[d * 32 + hh]), dsk = P.ssd_d[hh];
        bf16_t* Y = d ? (bf16_t*)P.out : (bf16_t*)(P.ws + OFF_YF);
        __syncthreads();
        for (int i = tid; i < 384; i += NT) cwl[i] = (i < 320) ? P.ssd_conv_w[(i >> 6) * 3072 + hh * 64 + (i & 63)] : P.ssd_conv_b[hh * 64 + i - 320];
        for (int k4 = 0; k4 < 4; ++k4) {
            const int cc = wid + 8 * k4; const size_t t0_ = (size_t)b * SEQ + cc * 128;
            const float dta = ((const float*)(proj + (t0_ + 2 * lane) * LDP + 3136))[d * 32 + hh], dtb = ((const float*)(proj + (t0_ + 2 * lane + 1) * LDP + 3136))[d * 32 + hh];
            const float ad0 = dta * a * 1.4426950408889634f, ad1 = dtb * a * 1.4426950408889634f, v = ad0 + ad1; float inc = v;
#pragma unroll
            for (int o = 1; o < 64; o <<= 1) { const float t = __shfl_up(inc, o); if (lane >= o) inc += t; }
            const float excl = inc - v, totl = __shfl(inc, 63);
            if (d == 0) { csA[cc * 128 + 2 * lane] = excl + ad0; csA[cc * 128 + 2 * lane + 1] = inc; } else { csA[cc * 128 + 2 * lane] = totl - excl; csA[cc * 128 + 2 * lane + 1] = totl - excl - ad0; }
            dtsA[cc * 128 + 2 * lane] = dta; dtsA[cc * 128 + 2 * lane + 1] = dtb; if (lane == 0) totA[cc] = totl;
        }
        f32x4 st[4];
#pragma unroll
        for (int pt = 0; pt < 4; ++pt) st[pt] = (f32x4){0.f, 0.f, 0.f, 0.f};
        u32x4 xp[3]; u32x4 cbv[4]; bf16x8 cmf[4], btf[4];
#define SCAN_LOAD_A(cc) do { const size_t t0_ = (size_t)b * SEQ + (cc) * 128; \
            _Pragma("unroll") for (int e_ = 0; e_ < 3; ++e_) { const int i_ = tid + e_ * NT; const int r_ = i_ >> 3, pc_ = (i_ & 7) * 8; const int lt_ = (cc) * 128 + r_ - 2; \
                xp[e_] = (u32x4){0u, 0u, 0u, 0u}; if (i_ < 132 * 8 && lt_ >= 0 && lt_ < SEQ) xp[e_] = *(const u32x4*)(proj + ((size_t)b * SEQ + lt_) * LDP + hh * 64 + pc_); } } while (0)
#define SCAN_LOAD_C(cc) do { const size_t t0_ = (size_t)b * SEQ + (cc) * 128; const int l_ = 16 * ltile + fr, n_ = 16 * wid + fr; \
            const bf16_t* cbrow_ = CBg + (size_t)((b * 32 + (cc)) * 4 + g) * 16384 + l_ * 128 + 8 * q; const bf16_t* cmrow_ = proj + (t0_ + l_) * LDP + 2560 + g * 128 + 8 * q; \
            const bf16_t* btrow_ = proj + (t0_ + n_) * LDP + 2048 + g * 128 + 8 * q; \
            _Pragma("unroll") for (int ks_ = 0; ks_ < 4; ++ks_) { cbv[ks_] = *(const u32x4*)(cbrow_ + 32 * ks_); cmf[ks_] = *(const bf16x8*)(cmrow_ + 32 * ks_); btf[ks_] = *(const bf16x8*)(btrow_ + 32 * ks_); } } while (0)
#define SCAN_CH(i_) (d ? 31 - ((i_) < 31 ? (i_) : 31) : ((i_) < 31 ? (i_) : 31))
#define SCAN_XRAW_WRITE() do { _Pragma("unroll") for (int e = 0; e < 3; ++e) { const int i = tid + e * NT; if (i < 132 * 8) *(u32x4*)(xraw + (i >> 3) * 72 + (i & 7) * 8) = xp[e]; } } while (0)
        { const int c0_ = SCAN_CH(0), c1_ = SCAN_CH(1); SCAN_LOAD_A(c0_); SCAN_LOAD_C(c0_); SCAN_XRAW_WRITE(); SCAN_LOAD_A(c1_); }
        __syncthreads();
        for (int ci = 0; ci < 32; ++ci) {
            const int c = d ? 31 - ci : ci; const size_t tok0 = (size_t)b * SEQ + c * 128;
            const int cn = SCAN_CH(ci + 1), cnn = SCAN_CH(ci + 2);
            const float* cs = csA + c * 128; const float* dts = dtsA + c * 128;
#pragma unroll
            for (int pt = 0; pt < 4; ++pt) { u32x2 o; o.x = pg8::cvt_pk_bf16(st[pt][0], st[pt][1]); o.y = pg8::cvt_pk_bf16(st[pt][2], st[pt][3]); *(u32x2*)(stb + (16 * pt + fr) * 136 + 16 * wid + 4 * q) = o; }
            const float total = totA[c];
            {
                const int tp = tid & 63, oc = (tid >> 6) * 8;
                float w5[5][8], accA[8], accB[8];
#pragma unroll
                for (int k = 0; k < 5; ++k) { const f32x4 w0 = *(const f32x4*)(cwl + k * 64 + oc), w1 = *(const f32x4*)(cwl + k * 64 + oc + 4);
#pragma unroll
                    for (int j = 0; j < 4; ++j) { w5[k][j] = w0[j]; w5[k][4 + j] = w1[j]; } }
                { const f32x4 b0 = *(const f32x4*)(cwl + 320 + oc), b1 = *(const f32x4*)(cwl + 320 + oc + 4);
#pragma unroll
                  for (int j = 0; j < 4; ++j) { accA[j] = b0[j]; accA[4 + j] = b1[j]; accB[j] = b0[j]; accB[4 + j] = b1[j]; } }
#pragma unroll
                for (int k = 0; k < 6; ++k) {
                    float xr[8]; unpack8(*(const u32x4*)(xraw + (2 * tp + k) * 72 + oc), xr);
#pragma unroll
                    for (int j = 0; j < 8; ++j) { if (k < 5) accA[j] += xr[j] * w5[k < 5 ? k : 0][j]; if (k > 0) accB[j] += xr[j] * w5[k > 0 ? k - 1 : 0][j]; }
                }
                const float dtA = dts[2 * tp], dtB = dts[2 * tp + 1], wA = __builtin_amdgcn_exp2f(total - cs[2 * tp]), wB = __builtin_amdgcn_exp2f(total - cs[2 * tp + 1]);
#pragma unroll
                for (int j = 0; j < 8; ++j) {
                    const float xa = accA[j] * fsig(accA[j]) * dtA, xb_ = accB[j] * fsig(accB[j]) * dtB;
                    ((unsigned*)(xdT + (oc + j) * 136))[tp] = pg8::cvt_pk_bf16(xa, xb_);
                    ((unsigned*)(xdwT + (oc + j) * 136))[tp] = pg8::cvt_pk_bf16(xa * wA, xb_ * wB);
                }
            }
            LDS_BAR();
            {
                int l = 16 * ltile + fr; asm volatile("" : "+v"(l));
                const float csl = cs[l], el = __builtin_amdgcn_exp2f(csl), ddt = dsk * __builtin_amdgcn_rcpf(dts[l]);
                f32x4 y2[4], y3[4];
#pragma unroll
                for (int pt = 0; pt < 4; ++pt) { y2[pt] = (f32x4){0.f, 0.f, 0.f, 0.f}; y3[pt] = (f32x4){0.f, 0.f, 0.f, 0.f}; }
                const int whalf = __builtin_amdgcn_readfirstlane(ltile) >> 1;
#pragma unroll
                for (int ks = 0; ks < 4; ++ks) {
                  if (d ? (ks >= whalf) : (ks <= whalf)) {
                    const f32x4 c0 = *(const f32x4*)(cs + 32 * ks + 8 * q), c1 = *(const f32x4*)(cs + 32 * ks + 8 * q + 4);
                    float gv[8];
#pragma unroll
                    for (int j = 0; j < 8; ++j) {
                        const int sx = 32 * ks + 8 * q + j; const float cb = (j & 1) ? __uint_as_float(cbv[ks][j >> 1] & 0xffff0000u) : __uint_as_float(cbv[ks][j >> 1] << 16);
                        const float css = (j < 4) ? c0[j & 3] : c1[j & 3];
                        float val = cb * __builtin_amdgcn_exp2f(csl - css);
                        if (ks == whalf) {
                            const bool keep = d ? (sx >= l) : (sx <= l);
                            val = keep ? val : 0.f;
                            if (d == 0 && sx == l) val += ddt;
                        }
                        gv[j] = val;
                    }
                    union { u32x4 u; bf16x8 h; } gf; gf.u = (u32x4){pg8::cvt_pk_bf16(gv[0], gv[1]), pg8::cvt_pk_bf16(gv[2], gv[3]), pg8::cvt_pk_bf16(gv[4], gv[5]), pg8::cvt_pk_bf16(gv[6], gv[7])};
#pragma unroll
                    for (int pt = 0; pt < 4; ++pt) { const bf16x8 xf = *(const bf16x8*)(xdT + (16 * pt + fr) * 136 + 32 * ks + 8 * q); y2[pt] = __builtin_amdgcn_mfma_f32_16x16x32_bf16(xf, gf.h, y2[pt], 0, 0, 0); }
                  }
#pragma unroll
                    for (int pt = 0; pt < 4; ++pt) { const bf16x8 sf = *(const bf16x8*)(stb + (16 * pt + fr) * 136 + 32 * ks + 8 * q); y3[pt] = __builtin_amdgcn_mfma_f32_16x16x32_bf16(sf, cmf[ks], y3[pt], 0, 0, 0); }
                }
#pragma unroll
                for (int pt = 0; pt < 4; ++pt) {
                    const f32x4 v = y2[pt] + el * y3[pt]; u32x2 o; o.x = pg8::cvt_pk_bf16(v[0], v[1]); o.y = pg8::cvt_pk_bf16(v[2], v[3]);
                    *(u32x2*)(Y + (tok0 + l) * 2048 + hh * 64 + 16 * pt + 4 * q) = o;
                }
                const float etot = __builtin_amdgcn_exp2f(total);
#pragma unroll
                for (int pt = 0; pt < 4; ++pt) st[pt] *= etot;
#pragma unroll
                for (int ks = 0; ks < 4; ++ks) {
#pragma unroll
                    for (int pt = 0; pt < 4; ++pt) { const bf16x8 xf = *(const bf16x8*)(xdwT + (16 * pt + fr) * 136 + 32 * ks + 8 * q); st[pt] = __builtin_amdgcn_mfma_f32_16x16x32_bf16(btf[ks], xf, st[pt], 0, 0, 0); }
                }
            }
            SCAN_LOAD_C(cn);
            SCAN_XRAW_WRITE();
            SCAN_LOAD_A(cnn);
            LDS_BAR();
        }
#undef SCAN_LOAD_A
#undef SCAN_CH
#undef SCAN_XRAW_WRITE
#undef SCAN_LOAD_C
    }
}
__device__ __forceinline__ void ph_gn_scale(const Params& P) {
    bf16_t* proj = (bf16_t*)(P.ws + OFF_R);
    const int lane = threadIdx.x & 63, wid = threadIdx.x >> 6;
    for (int it = blockIdx.x * 8 + wid; it < T_TOK * 4; it += gridDim.x * 8) {
        const int row = it >> 2, grp = it & 3;
        bf16_t* ptr = proj + (size_t)row * LDP + grp * 512 + lane * 8;
        const u32x4 v = *(const u32x4*)ptr; float f[8]; float ss = 0.f;
#pragma unroll
        for (int j = 0; j < 4; ++j) { f[2 * j] = __uint_as_float(v[j] << 16); f[2 * j + 1] = __uint_as_float(v[j] & 0xffff0000u); ss += f[2 * j] * f[2 * j] + f[2 * j + 1] * f[2 * j + 1]; }
        ss = wave_sum(ss);
        const float rstd = rsqrtf(ss * (1.0f / 512.f) + EPS);
        const float* w = P.ssd_norm_w + grp * 512 + lane * 8; u32x4 o;
#pragma unroll
        for (int j = 0; j < 4; ++j) o[j] = pack2(f[2 * j] * rstd * w[2 * j], f[2 * j + 1] * rstd * w[2 * j + 1]);
        *(u32x4*)ptr = o;
    }
}
__device__ __forceinline__ void ph_ffn_conv(const Params& P, int layer, int half) {
    const bf16_t* hup = (const bf16_t*)(P.ws + OFF_R); bf16_t* gout = (bf16_t*)(P.ws + OFF_G);
    const float* cw = P.ffn_conv_w + (size_t)layer * 3 * 5632; const float* cb = P.ffn_conv_b + (size_t)layer * 5632;
    for (int it = blockIdx.x * NT + threadIdx.x; it < (T_TOK / 16) * (FH / 8); it += gridDim.x * NT) {
        const int oc = (it % (FH / 8)) * 8, t0 = (it / (FH / 8)) * 16, lt0 = t0 & (SEQ - 1);
        const int pn = oc >> 7, w = oc & 127, gcol = pn * 256 + w, vcol = gcol + 128;
        const int gch = half * FH + oc, vch = 2816 + gch;
        float wg[3][8], wv[3][8], bg[8], bv[8];
#pragma unroll
        for (int k = 0; k < 3; ++k) {
            const f32x4 a0 = *(const f32x4*)(cw + k * 5632 + gch), a1 = *(const f32x4*)(cw + k * 5632 + gch + 4), c0 = *(const f32x4*)(cw + k * 5632 + vch), c1 = *(const f32x4*)(cw + k * 5632 + vch + 4);
#pragma unroll
            for (int j = 0; j < 4; ++j) { wg[k][j] = a0[j]; wg[k][4 + j] = a1[j]; wv[k][j] = c0[j]; wv[k][4 + j] = c1[j]; }
        }
        { const f32x4 a0 = *(const f32x4*)(cb + gch), a1 = *(const f32x4*)(cb + gch + 4), c0 = *(const f32x4*)(cb + vch), c1 = *(const f32x4*)(cb + vch + 4);
#pragma unroll
          for (int j = 0; j < 4; ++j) { bg[j] = a0[j]; bg[4 + j] = a1[j]; bv[j] = c0[j]; bv[4 + j] = c1[j]; } }
        const bf16_t* base = hup + (size_t)t0 * 2816;
        float gp[8], vp[8], gc[8], vc[8];
        const u32x4 z4 = {0u, 0u, 0u, 0u};
        unpack8(lt0 > 0 ? *(const u32x4*)(base - 2816 + gcol) : z4, gp); unpack8(lt0 > 0 ? *(const u32x4*)(base - 2816 + vcol) : z4, vp);
        unpack8(*(const u32x4*)(base + gcol), gc); unpack8(*(const u32x4*)(base + vcol), vc);
#pragma unroll
        for (int i = 0; i < 16; ++i) {
            float gn[8], vn[8];
            const bool has = (lt0 + i + 1 < SEQ);
            unpack8(has ? *(const u32x4*)(base + (size_t)(i + 1) * 2816 + gcol) : z4, gn); unpack8(has ? *(const u32x4*)(base + (size_t)(i + 1) * 2816 + vcol) : z4, vn);
            u32x4 o;
#pragma unroll
            for (int j = 0; j < 4; ++j) {
                const float g0 = bg[2 * j] + wg[0][2 * j] * gp[2 * j] + wg[1][2 * j] * gc[2 * j] + wg[2][2 * j] * gn[2 * j];
                const float g1 = bg[2 * j + 1] + wg[0][2 * j + 1] * gp[2 * j + 1] + wg[1][2 * j + 1] * gc[2 * j + 1] + wg[2][2 * j + 1] * gn[2 * j + 1];
                const float v0 = bv[2 * j] + wv[0][2 * j] * vp[2 * j] + wv[1][2 * j] * vc[2 * j] + wv[2][2 * j] * vn[2 * j];
                const float v1 = bv[2 * j + 1] + wv[0][2 * j + 1] * vp[2 * j + 1] + wv[1][2 * j + 1] * vc[2 * j + 1] + wv[2][2 * j + 1] * vn[2 * j + 1];
                o[j] = pg8::cvt_pk_bf16(g0 * fsig(g0) * v0, g1 * fsig(g1) * v1);
            }
            *(u32x4*)(gout + (size_t)(t0 + i) * FH + oc) = o;
#pragma unroll
            for (int j = 0; j < 8; ++j) { gp[j] = gc[j]; vp[j] = vc[j]; gc[j] = gn[j]; vc[j] = vn[j]; }
        }
    }
}
__device__ __forceinline__ void ph_s5_naive(const Params& P) {
    const bf16_t* u = (const bf16_t*)(P.ws + OFF_ABUF); float* scr = (float*)(P.ws + OFF_R); bf16_t* gout = (bf16_t*)(P.ws + OFF_G);
    const int lane = threadIdx.x & 63, wid = threadIdx.x >> 6;
    for (int item = blockIdx.x + gridDim.x * wid; item < 256; item += gridDim.x * 8) {
        const int g = item & 63, b = item >> 6;
        for (int d = 0; d < 2; ++d) {
            const float lr = P.s5_a_re[(d * 64 + g) * 64 + lane], li = P.s5_a_im[(d * 64 + g) * 64 + lane];
            const float step = expf(P.s5_log_step[d * 64 + g]);
            const float mag = expf(lr * step), ang = li * step;
            const double angd = (double)ang, two_pi = 6.283185307179586476925;
            const float angr = (float)(angd - two_pi * rint(angd / two_pi));
            const float lbr = mag * cosf(angr), lbi = mag * sinf(angr);
            const float nr = lbr - 1.0f, den = lr * lr + li * li;
            const float qr = (nr * lr + lbi * li) / den, qi = (lbi * lr - nr * li) / den;
            float Br[16], Bi[16], Cr[16], Ci[16];
#pragma unroll
            for (int h = 0; h < 16; ++h) {
                const float br = P.s5_b_re[(g * 64 + lane) * 16 + h], bi = P.s5_b_im[(g * 64 + lane) * 16 + h];
                Br[h] = qr * br - qi * bi; Bi[h] = qr * bi + qi * br;
                Cr[h] = P.s5_c_re[((d * 64 + g) * 16 + h) * 64 + lane]; Ci[h] = P.s5_c_im[((d * 64 + g) * 16 + h) * 64 + lane];
            }
            float hr = 0.f, hi = 0.f;
            for (int s = 0; s < SEQ; ++s) {
                const int lt = d ? SEQ - 1 - s : s; const size_t tok = (size_t)b * SEQ + lt;
                const float uv = bf2f(u[tok * DM + g * 16 + (lane & 15)]);
                float dr = 0.f, di = 0.f;
#pragma unroll
                for (int h = 0; h < 16; ++h) { const float uh = __shfl(uv, h); dr += Br[h] * uh; di += Bi[h] * uh; }
                const float nhr = lbr * hr - lbi * hi + dr, nhi = lbr * hi + lbi * hr + di; hr = nhr; hi = nhi;
                float yv = 0.f;
#pragma unroll
                for (int h = 0; h < 16; ++h) { const float s1 = wave_sum(hr * Cr[h] - hi * Ci[h]); if ((lane & 15) == h) yv = s1; }
                if (lane < 16) {
                    if (d == 0) scr[tok * DM + g * 16 + lane] = yv;
                    else { const float y = scr[tok * DM + g * 16 + lane] + yv + P.s5_d[g * 16 + lane] * uv;
                           const float ge = 0.5f * y * (1.0f + tanhf(0.7978845608028654f * (y + 0.044715f * y * y * y)));
                           gout[tok * DM + g * 16 + lane] = f2bf(ge); }
                }
            }
        }
    }
}

constexpr size_t OFF_S5M = OFF_R + 96 * MiB;
__device__ __forceinline__ void s5_lambda(const Params& P, int d, int g, int p, float& lbr, float& lbi, float& qr, float& qi) {
    const float lr = P.s5_a_re[(d * 64 + g) * 64 + p], li = P.s5_a_im[(d * 64 + g) * 64 + p];
    const float step = expf(P.s5_log_step[d * 64 + g]);
    const float mag = expf(lr * step), ang = li * step;
    const double angd = (double)ang, two_pi = 6.283185307179586476925;
    const float angr = (float)(angd - two_pi * rint(angd / two_pi));
    lbr = mag * cosf(angr); lbi = mag * sinf(angr);
    const float nr = lbr - 1.0f, den = lr * lr + li * li;
    qr = (nr * lr + lbi * li) / den; qi = (lbi * lr - nr * li) / den;
}
__device__ __forceinline__ void ph_s5_setup(const Params& P, unsigned char* ldsraw) {
    float* pw = (float*)ldsraw;
    float* Bb = pw + 2 * 17 * 64 * 2;
    float* Cc = Bb + 2 * 64 * 16 * 2;
    float* Kt = Cc + 2 * 16 * 64 * 2;
    const int tid = threadIdx.x;
    for (int item = blockIdx.x; item < 256; item += gridDim.x) {
        const int g = item >> 2, part = item & 3;
        bf16_t* A1 = (bf16_t*)(P.ws + OFF_S5M) + (size_t)g * (65536 + 131072); bf16_t* A2 = A1 + 65536;
        __syncthreads();
        if (tid < 128) {
            const int d = tid >> 6, p = tid & 63; float lbr, lbi, qr, qi; s5_lambda(P, d, g, p, lbr, lbi, qr, qi);
            float pr = 1.f, pi = 0.f;
            for (int j = 0; j <= 16; ++j) { pw[((d * 17 + j) * 64 + p) * 2] = pr; pw[((d * 17 + j) * 64 + p) * 2 + 1] = pi; const float t = pr * lbr - pi * lbi; pi = pr * lbi + pi * lbr; pr = t; }
            for (int h = 0; h < 16; ++h) {
                const float br = P.s5_b_re[(g * 64 + p) * 16 + h], bi = P.s5_b_im[(g * 64 + p) * 16 + h];
                Bb[((d * 64 + p) * 16 + h) * 2] = qr * br - qi * bi; Bb[((d * 64 + p) * 16 + h) * 2 + 1] = qr * bi + qi * br;
                Cc[((d * 16 + h) * 64 + p) * 2] = P.s5_c_re[((d * 64 + g) * 16 + h) * 64 + p]; Cc[((d * 16 + h) * 64 + p) * 2 + 1] = P.s5_c_im[((d * 64 + g) * 16 + h) * 64 + p];
            }
        }
        __syncthreads();
        for (int i = tid; i < 16384; i += NT) {
            const int k = i & 255, R = 64 * part + (i >> 8), sx = k >> 4, hp = k & 15, d = R >> 7, ri = (R >> 6) & 1, p = R & 63;
            const int e = d ? sx : 15 - sx;
            const float pr = pw[((d * 17 + e) * 64 + p) * 2], pi = pw[((d * 17 + e) * 64 + p) * 2 + 1], br = Bb[((d * 64 + p) * 16 + hp) * 2], bi = Bb[((d * 64 + p) * 16 + hp) * 2 + 1];
            A1[(size_t)R * 256 + k] = f2bf(ri ? (pr * bi + pi * br) : (pr * br - pi * bi));
        }
        for (int i = tid; i < 2048; i += NT) {
            const int hp = i & 15, hl = (i >> 4) & 3, j = (i >> 6) & 15, d = i >> 10, h = 4 * part + hl;
            float acc = 0.f;
            for (int p = 0; p < 64; ++p) {
                const float pr = pw[((d * 17 + j) * 64 + p) * 2], pi = pw[((d * 17 + j) * 64 + p) * 2 + 1], br = Bb[((d * 64 + p) * 16 + hp) * 2], bi = Bb[((d * 64 + p) * 16 + hp) * 2 + 1];
                const float er = pr * br - pi * bi, ei = pr * bi + pi * br;
                acc += Cc[((d * 16 + h) * 64 + p) * 2] * er - Cc[((d * 16 + h) * 64 + p) * 2 + 1] * ei;
            }
            Kt[i] = acc;
        }
        __syncthreads();
        for (int i = tid; i < 16384; i += NT) {
            const int k = i & 255, rr = i >> 8, tau = rr >> 2, hl = rr & 3, h = 4 * part + hl, row = tau * 16 + h, sx = k >> 4, hp = k & 15;
            float v = 0.f;
            if (sx <= tau) v += Kt[(((tau - sx)) * 4 + hl) * 16 + hp];
            if (sx >= tau) v += Kt[((16 + sx - tau) * 4 + hl) * 16 + hp];
            if (sx == tau && hp == h) v += P.s5_d[g * 16 + h];
            A2[(size_t)row * 512 + k] = f2bf(v);
        }
        for (int i = tid; i < 16384; i += NT) {
            const int kk = i & 255, rr = i >> 8, tau = rr >> 2, h = 4 * part + (rr & 3), row = tau * 16 + h, d = kk >> 7, ri = (kk >> 6) & 1, p = kk & 63;
            const int e = d ? 16 - tau : tau + 1;
            const float pr = pw[((d * 17 + e) * 64 + p) * 2], pi = pw[((d * 17 + e) * 64 + p) * 2 + 1], cr = Cc[((d * 16 + h) * 64 + p) * 2], ci = Cc[((d * 16 + h) * 64 + p) * 2 + 1];
            A2[(size_t)row * 512 + 256 + kk] = f2bf(ri ? -(cr * pi + ci * pr) : (cr * pr - ci * pi));
        }
    }
}
__device__ __forceinline__ void ph_s5_main(const Params& P, unsigned char* ldsraw) {
    const bf16_t* u = (const bf16_t*)(P.ws + OFF_ABUF); float* scr = (float*)(P.ws + OFF_R); bf16_t* gout = (bf16_t*)(P.ws + OFF_G);
    bf16_t* Sc = (bf16_t*)ldsraw;
    float* tbuf = (float*)(ldsraw + 256 * 264 * 2);
    bf16_t* atile = (bf16_t*)(ldsraw + 256 * 264 * 2 + 8192);
    const int tid = threadIdx.x, lane = tid & 63, wid = tid >> 6, fr = lane & 15, q = lane >> 4;
    for (int item = blockIdx.x; item < 256; item += gridDim.x) {
        const int g = (item & 7) + 8 * (item >> 5), b = (item >> 3) & 3;
        const bf16_t* A1 = (const bf16_t*)(P.ws + OFF_S5M) + (size_t)g * (65536 + 131072); const bf16_t* A2 = A1 + 65536;
        float* sl = scr + (size_t)item * 65536;
        bf16x8 uf[2][8];
#pragma unroll
        for (int ct = 0; ct < 2; ++ct)
#pragma unroll
            for (int ks = 0; ks < 8; ++ks) {
                const int c = 32 * wid + 16 * ct + fr; const size_t tok = (size_t)b * SEQ + c * 16 + 2 * ks + (q >> 1);
                uf[ct][ks] = *(const bf16x8*)(u + tok * DM + g * 16 + 8 * (q & 1));
            }
        {
            const int srow = tid >> 5, spc = (tid & 31) * 8;
            *(u32x4*)(atile + srow * 264 + spc) = *(const u32x4*)(A1 + (size_t)srow * 256 + spc);
            u32x4 r0, r1 = *(const u32x4*)(A1 + (size_t)(16 + srow) * 256 + spc), r2 = *(const u32x4*)(A1 + (size_t)(32 + srow) * 256 + spc), r3 = *(const u32x4*)(A1 + (size_t)(48 + srow) * 256 + spc);
            __syncthreads();
#define S5A_STEP(Rt, RL, RW) do { \
                RL = *(const u32x4*)(A1 + (size_t)((((Rt) + 4) & 15) * 16 + srow) * 256 + spc); \
                const bf16_t* at = atile + ((Rt) & 1) * (16 * 264) + fr * 264 + 8 * q; \
                f32x4 a0 = {0.f, 0.f, 0.f, 0.f}, a1 = {0.f, 0.f, 0.f, 0.f}; \
                _Pragma("unroll") for (int ks = 0; ks < 8; ++ks) { const bf16x8 af = *(const bf16x8*)(at + ks * 32); \
                    a0 = __builtin_amdgcn_mfma_f32_16x16x32_bf16(af, uf[0][ks], a0, 0, 0, 0); a1 = __builtin_amdgcn_mfma_f32_16x16x32_bf16(af, uf[1][ks], a1, 0, 0, 0); } \
                *(f32x4*)(sl + (size_t)(32 * wid + fr) * 256 + (Rt) * 16 + 4 * q) = a0; \
                *(f32x4*)(sl + (size_t)(32 * wid + 16 + fr) * 256 + (Rt) * 16 + 4 * q) = a1; \
                *(u32x4*)(atile + (((Rt) + 1) & 1) * (16 * 264) + srow * 264 + spc) = RW; \
                LDS_BAR(); } while (0)
            for (int R4 = 0; R4 < 16; R4 += 4) { S5A_STEP(R4, r0, r1); S5A_STEP(R4 + 1, r1, r2); S5A_STEP(R4 + 2, r2, r3); S5A_STEP(R4 + 3, r3, r0); }
#undef S5A_STEP
        }
        asm volatile("s_waitcnt vmcnt(0)" ::: "memory");
        __syncthreads();
        {
            float L0r, L0i, L1r, L1i, qr_, qi_;
            s5_lambda(P, 0, g, lane, L0r, L0i, qr_, qi_); s5_lambda(P, 1, g, lane, L1r, L1i, qr_, qi_);
#pragma unroll
            for (int i = 0; i < 4; ++i) { float t = L0r * L0r - L0i * L0i; L0i = 2.f * L0r * L0i; L0r = t; t = L1r * L1r - L1i * L1i; L1i = 2.f * L1r * L1i; L1r = t; }
            float h0r = 0.f, h0i = 0.f, h1r = 0.f, h1i = 0.f;
            for (int j0 = 0; j0 < 32; j0 += 8) {
                float x0r[8], x0i[8], x1r[8], x1i[8];
#pragma unroll
                for (int i = 0; i < 8; ++i) { const int j = 32 * wid + j0 + i, c0 = j, c1 = 255 - j;
                    x0r[i] = sl[(size_t)c0 * 256 + lane]; x0i[i] = sl[(size_t)c0 * 256 + 64 + lane]; x1r[i] = sl[(size_t)c1 * 256 + 128 + lane]; x1i[i] = sl[(size_t)c1 * 256 + 192 + lane]; }
#pragma unroll
                for (int i = 0; i < 8; ++i) { float t = L0r * h0r - L0i * h0i + x0r[i]; h0i = L0r * h0i + L0i * h0r + x0i[i]; h0r = t; t = L1r * h1r - L1i * h1i + x1r[i]; h1i = L1r * h1i + L1i * h1r + x1i[i]; h1r = t; }
            }
            *(f32x4*)(tbuf + ((wid * 64 + lane) * 4)) = (f32x4){h0r, h0i, h1r, h1i};
            __syncthreads();
            float P0r = L0r, P0i = L0i, P1r = L1r, P1i = L1i;
#pragma unroll
            for (int i = 0; i < 5; ++i) { float t = P0r * P0r - P0i * P0i; P0i = 2.f * P0r * P0i; P0r = t; t = P1r * P1r - P1i * P1i; P1i = 2.f * P1r * P1i; P1r = t; }
            h0r = 0.f; h0i = 0.f; h1r = 0.f; h1i = 0.f;
            for (int w2 = 0; w2 < wid; ++w2) { const f32x4 tv = *(const f32x4*)(tbuf + ((w2 * 64 + lane) * 4));
                float t = P0r * h0r - P0i * h0i + tv[0]; h0i = P0r * h0i + P0i * h0r + tv[1]; h0r = t; t = P1r * h1r - P1i * h1i + tv[2]; h1i = P1r * h1i + P1i * h1r + tv[3]; h1r = t; }
            for (int j0 = 0; j0 < 32; j0 += 8) {
                float x0r[8], x0i[8], x1r[8], x1i[8];
#pragma unroll
                for (int i = 0; i < 8; ++i) { const int j = 32 * wid + j0 + i, c0 = j, c1 = 255 - j;
                    x0r[i] = sl[(size_t)c0 * 256 + lane]; x0i[i] = sl[(size_t)c0 * 256 + 64 + lane]; x1r[i] = sl[(size_t)c1 * 256 + 128 + lane]; x1i[i] = sl[(size_t)c1 * 256 + 192 + lane]; }
#pragma unroll
                for (int i = 0; i < 8; ++i) { const int j = 32 * wid + j0 + i, c0 = j, c1 = 255 - j;
                    Sc[c0 * 264 + lane] = f2bf(h0r); Sc[c0 * 264 + 64 + lane] = f2bf(h0i); Sc[c1 * 264 + 128 + lane] = f2bf(h1r); Sc[c1 * 264 + 192 + lane] = f2bf(h1i);
                    float t = L0r * h0r - L0i * h0i + x0r[i]; h0i = L0r * h0i + L0i * h0r + x0i[i]; h0r = t; t = L1r * h1r - L1i * h1i + x1r[i]; h1i = L1r * h1i + L1i * h1r + x1i[i]; h1r = t; }
            }
        }
        __syncthreads();
        {
            const int srow = tid >> 5, spc = (tid & 31) * 8;
#define S5C_SRC(h) (A2 + (size_t)((((h) & 31) >> 1) * 16 + srow) * 512 + ((h) & 1) * 256 + spc)
            *(u32x4*)(atile + srow * 264 + spc) = *(const u32x4*)S5C_SRC(0);
            u32x4 r0, r1 = *(const u32x4*)S5C_SRC(1), r2 = *(const u32x4*)S5C_SRC(2), r3 = *(const u32x4*)S5C_SRC(3);
            __syncthreads();
            f32x4 a0 = {0.f, 0.f, 0.f, 0.f}, a1 = {0.f, 0.f, 0.f, 0.f};
#define S5C_STEP(hs, RL, RW) do { \
                RL = *(const u32x4*)S5C_SRC((hs) + 4); \
                const bf16_t* at = atile + ((hs) & 1) * (16 * 264) + fr * 264 + 8 * q; \
                if (((hs) & 1) == 0) { \
                    _Pragma("unroll") for (int ks = 0; ks < 8; ++ks) { const bf16x8 af = *(const bf16x8*)(at + ks * 32); \
                        a0 = __builtin_amdgcn_mfma_f32_16x16x32_bf16(af, uf[0][ks], a0, 0, 0, 0); a1 = __builtin_amdgcn_mfma_f32_16x16x32_bf16(af, uf[1][ks], a1, 0, 0, 0); } \
                } else { \
                    _Pragma("unroll") for (int ks = 0; ks < 8; ++ks) { const bf16x8 af = *(const bf16x8*)(at + ks * 32); \
                        const bf16x8 b0 = *(const bf16x8*)(Sc + (32 * wid + fr) * 264 + ks * 32 + 8 * q), b1 = *(const bf16x8*)(Sc + (32 * wid + 16 + fr) * 264 + ks * 32 + 8 * q); \
                        a0 = __builtin_amdgcn_mfma_f32_16x16x32_bf16(af, b0, a0, 0, 0, 0); a1 = __builtin_amdgcn_mfma_f32_16x16x32_bf16(af, b1, a1, 0, 0, 0); } \
                    const int ch = g * 16 + 4 * q, rt = (hs) >> 1; \
                    _Pragma("unroll") for (int ct = 0; ct < 2; ++ct) { \
                        const int c = 32 * wid + 16 * ct + fr; const size_t tok = (size_t)b * SEQ + c * 16 + rt; \
                        const f32x4 av = ct ? a1 : a0; float y[4]; \
                        _Pragma("unroll") for (int r = 0; r < 4; ++r) { const float yy = av[r]; y[r] = yy * fsig(1.5957691216057308f * (yy + 0.044715f * yy * yy * yy)); } \
                        u32x2 o; o.x = pg8::cvt_pk_bf16(y[0], y[1]); o.y = pg8::cvt_pk_bf16(y[2], y[3]); \
                        *(u32x2*)(gout + tok * DM + ch) = o; } \
                    a0 = (f32x4){0.f, 0.f, 0.f, 0.f}; a1 = (f32x4){0.f, 0.f, 0.f, 0.f}; \
                } \
                *(u32x4*)(atile + (((hs) + 1) & 1) * (16 * 264) + srow * 264 + spc) = RW; \
                LDS_BAR(); } while (0)
            for (int h4 = 0; h4 < 32; h4 += 4) { S5C_STEP(h4, r0, r1); S5C_STEP(h4 + 1, r1, r2); S5C_STEP(h4 + 2, r2, r3); S5C_STEP(h4 + 3, r3, r0); }
#undef S5C_STEP
#undef S5C_SRC
        }
        __syncthreads();
    }
}

#define XB_TMO      128
#define XB_XCNT(j)  (256  + 64 * (j))
#define XB_XSUB(j)  (1280 + 64 * (j))
#define XB_XGEN(j)  (2304 + 64 * (j))
#define XB_TOP      3328
#define XB_TOPGEN   3392
#define XCD_BAR_WORDS 3456
#define XB_SPIN_CAP (1u << 18)
constexpr size_t OFF_BAR = 255 * MiB;
constexpr int LDS_ST_OFF = (int)LDS_BYTES - 16;
__device__ __forceinline__ unsigned xb_ld(unsigned* p)              { return __hip_atomic_load(p, __ATOMIC_RELAXED, __HIP_MEMORY_SCOPE_AGENT); }
__device__ __forceinline__ unsigned xb_add(unsigned* p, unsigned v) { return __hip_atomic_fetch_add(p, v, __ATOMIC_RELAXED, __HIP_MEMORY_SCOPE_AGENT); }
__device__ __forceinline__ unsigned xb_xcc_id() { return (unsigned)__builtin_amdgcn_s_getreg((3 << 11) | 20) & 0xFu; }
#define XB_SPIN(cond, bar) do { unsigned _sp = 0; while (cond) { __builtin_amdgcn_s_sleep(1); \
    if ((++_sp & 255u) == 0u) { if (xb_ld(&(bar)[XB_TMO])) break; if (_sp > XB_SPIN_CAP) { atomicAdd(&(bar)[XB_TMO], 1u); break; } } } } while (0)
struct XcdBarrier { unsigned* bar; unsigned x; volatile PG8_LAS unsigned* st; };
__device__ __forceinline__ XcdBarrier xcd_barrier_post(unsigned* bar, volatile PG8_LAS unsigned* st) {
    XcdBarrier b; b.bar = bar; b.x = xb_xcc_id(); b.st = st;
    if (threadIdx.x == 0) (void)xb_add(&bar[XB_XCNT(b.x)], 1u);
    return b;
}
__device__ __forceinline__ void xcd_barrier_complete(unsigned* bar, unsigned x, unsigned& nloc, unsigned& nx) {
    const unsigned G = gridDim.x * gridDim.y * gridDim.z;
    unsigned sum, cnt, mine, sp = 0u;
    for (;;) {
        sum = 0u; cnt = 0u; mine = 0u;
#pragma unroll
        for (unsigned j = 0; j < 16; ++j) { const unsigned c = xb_ld(&bar[XB_XCNT(j)]); sum += c; cnt += (c > 0u) ? 1u : 0u; mine = (j == x) ? c : mine; }
        if (sum == G) break;
        __builtin_amdgcn_s_sleep(1);
        if ((++sp & 255u) == 0u) { if (xb_ld(&bar[XB_TMO])) break; if (sp > XB_SPIN_CAP) { atomicAdd(&bar[XB_TMO], 1u); break; } }
    }
    nloc = mine > 0u ? mine : 1u; nx = cnt > 0u ? cnt : 1u;
}
__device__ __forceinline__ void xcd_barrier(const XcdBarrier& b) {
    asm volatile("s_waitcnt vmcnt(0)" ::: "memory");
    __syncthreads();
    if (threadIdx.x == 0) {
        unsigned* bar = b.bar;
        __builtin_amdgcn_s_waitcnt(0);
        unsigned nloc = b.st[0], nx = b.st[1];
        if (nloc == 0u) { xcd_barrier_complete(bar, b.x, nloc, nx); b.st[0] = nloc; b.st[1] = nx; }
        const unsigned old = xb_add(&bar[XB_XSUB(b.x)], 1u);
        const unsigned gen = old / nloc;
        if (old + 1u == (gen + 1u) * nloc) {
            __builtin_amdgcn_fence(__ATOMIC_RELEASE, "agent");
            asm volatile("s_waitcnt vmcnt(0)" ::: "memory");
            const unsigned og = xb_add(&bar[XB_TOP], 1u);
            const unsigned tg = og / nx;
            if (og + 1u == (tg + 1u) * nx) xb_add(&bar[XB_TOPGEN], 1u);
            else XB_SPIN(xb_ld(&bar[XB_TOPGEN]) == tg, bar);
            __builtin_amdgcn_fence(__ATOMIC_ACQUIRE, "agent");
            xb_add(&bar[XB_XGEN(b.x)], 1u);
            asm volatile("s_waitcnt vmcnt(0)" ::: "memory");
        } else {
            XB_SPIN(xb_ld(&bar[XB_XGEN(b.x)]) == gen, bar);
            __builtin_amdgcn_fence(__ATOMIC_ACQUIRE, "agent");
            asm volatile("s_waitcnt vmcnt(0)" ::: "memory");
        }
    }
    __syncthreads();
}

constexpr int NPH = 32;
#define PH(k, body) if (lo <= (k) && (k) < hi) { { unsigned char* ws = P.ws; bf16_t* abuf = (bf16_t*)(ws + OFF_ABUF); bf16_t* proj = (bf16_t*)(ws + OFF_R); bf16_t* gbuf = (bf16_t*)(ws + OFF_G); bf16_t* hbuf = (bf16_t*)P.out; (void)abuf; (void)proj; (void)gbuf; (void)hbuf; body; } if ((k) + 1 < hi) xcd_barrier(xbar); }
#ifndef USE_NAIVE_GEMM
#define USE_NAIVE_GEMM 0
#endif
#define GEMM(A_, lda_, B_, ldb_, M_, N_, K_, EPI_, ...) { const GemmArgs g_ = mkgemm(A_, lda_, B_, ldb_, M_, N_, K_, EPI_, __VA_ARGS__); if (USE_NAIVE_GEMM) gemm_naive(g_, (float*)lds); else gemm_pg8<EPI_>((PG8_LAS unsigned char*)lds, g_); }
#define W_UPL ((bf16_t*)(ws + (layer ? W_UP1 : W_UP0)))
#define W_DNL ((bf16_t*)(ws + (layer ? W_DN1 : W_DN0)))
#define W_GTL ((bf16_t*)(ws + (layer ? W_GT1 : W_GT0)))
#define W_PPL ((bf16_t*)(ws + (layer ? W_PP1 : W_PP0)))
#define PPBUF ((bf16_t*)(ws + OFF_R))
#define PBF ((bf16_t*)(ws + OFF_R + 64 * MiB))
__device__ __forceinline__ void ffn_section(const Params& P, const int layer, const int base, const int lo, const int hi, const XcdBarrier& xbar, unsigned char* lds) {
    PH(base + 0, { if (layer == 0) ph_s5_setup(P, lds); ph_norm16(hbuf, P.ffn_norm_w + layer * DM, abuf, nullptr); })
    PH(base + 1, GEMM(abuf, DM, W_UPL, DM, T_TOK, 2816, DM, EPI_BF16, proj, 2816))
    PH(base + 2, ph_ffn_conv(P, layer, 0))
    PH(base + 3, GEMM(abuf, DM, W_UPL + (size_t)2816 * DM, DM, T_TOK, 2816, DM, EPI_BF16, proj, 2816))
    PH(base + 4, GEMM(gbuf, FH, W_DNL, 2816, T_TOK, DM, FH, EPI_RES16, hbuf, DM, (const float*)hbuf))
    PH(base + 5, ph_ffn_conv(P, layer, 1))
    PH(base + 6, GEMM(gbuf, FH, W_DNL + FH, 2816, T_TOK, DM, FH, EPI_RES16, hbuf, DM, (const float*)hbuf))
    PH(base + 7, { ph_norm16(hbuf, P.ple_norm_w + layer * DM, abuf, nullptr); ph_cvt_copy(P.p + (size_t)layer * T_TOK * 256, PBF, (size_t)T_TOK * 256); })
    PH(base + 8, { GEMM(PBF, 256, W_PPL, 256, T_TOK, DM, 256, EPI_BF16, PPBUF, DM) GEMM(abuf, DM, W_GTL, DM, T_TOK, DM, DM, EPI_PLE16, (layer ? gbuf : hbuf), DM, (const float*)hbuf, (const float*)PPBUF) })
}

__global__ void __launch_bounds__(NT, 2) mega(Params P) {
    extern __shared__ __attribute__((aligned(16))) unsigned char lds[];
    cg::grid_group grid = cg::this_grid();
    const int lo = P.ph_lo, hi = P.ph_hi;
    if (lo < 0) grid.sync();
    volatile PG8_LAS unsigned* xst = (volatile PG8_LAS unsigned*)((PG8_LAS unsigned char*)lds + LDS_ST_OFF);
    if (threadIdx.x < 4) xst[threadIdx.x] = 0u;
    __syncthreads();
    const XcdBarrier xbar = xcd_barrier_post((unsigned*)(P.ws + OFF_BAR), xst);
    PH(0, { cvt_weights0(P, (float*)lds); ph_norm(P.x, P.mix_norm_w, abuf, nullptr); })
    PH(1, GEMM(abuf, DM, (bf16_t*)(ws + W_IN) + (size_t)2048 * DM, DM, T_TOK, LDP, DM, EPI_BF16, proj, LDP))
    PH(2, ph_ssd_halo(P))
    PH(3, ph_ssd_bcconv(P, lds))
    PH(4, ph_ssd_scan(P, lds))
    PH(5, GEMM(abuf, DM, (bf16_t*)(ws + W_IN), DM, T_TOK, 2048, DM, EPI_ZGATE, proj, LDP, nullptr, nullptr, (const bf16_t*)(ws + OFF_YF), (const bf16_t*)P.out))
    PH(6, { ph_gn_scale(P); cvt_weights1(P, (float*)lds); })
    PH(7, GEMM(proj, LDP, (bf16_t*)(ws + W_OUT), 2048, T_TOK, DM, 2048, EPI_RESX, hbuf, DM, P.x))
    ffn_section(P, 0, 8, lo, hi, xbar, lds);
    PH(18, ph_norm16(hbuf, P.mix_norm_w + DM, abuf, nullptr))
    PH(19, ph_s5_main(P, lds))
    PH(20, GEMM(gbuf, DM, (bf16_t*)(ws + W_GLU), DM, T_TOK, 2048, DM, EPI_GLU16, hbuf, DM, (const float*)hbuf, nullptr, nullptr, nullptr, P.s5_b_glu))
    ffn_section(P, 1, 21, lo, hi, xbar, lds);
    PH(31, ph_norm16(gbuf, P.final_norm_w, nullptr, P.out))
}

extern "C" void kernel_launch(void* const* d_in, const int* in_sizes, int n_in, void* d_out, int out_size, void* d_ws, size_t ws_size, hipStream_t stream) {
    static int grid_blocks = 0;
    if (!grid_blocks) {
        int dev = 0, cus = 0, per_cu = 0;
        hipGetDevice(&dev);
        hipDeviceGetAttribute(&cus, hipDeviceAttributeMultiprocessorCount, dev);
        hipFuncSetAttribute((const void*)mega, hipFuncAttributeMaxDynamicSharedMemorySize, (int)LDS_BYTES);
        hipOccupancyMaxActiveBlocksPerMultiprocessor(&per_cu, (const void*)mega, NT, LDS_BYTES);
        if (per_cu < 1) per_cu = 1;
        grid_blocks = cus * per_cu;
        if (ws_size < 256 * MiB) fprintf(stderr, "workspace too small: %zu\n", ws_size);
    }
    Params P{};
    const float** pp = (const float**)&P;
    for (int i = 0; i < 30; ++i) pp[i] = (const float*)d_in[i];
    P.out = (float*)d_out; P.ws = (unsigned char*)d_ws;
#if COOP
    (void)hipMemsetAsync((unsigned char*)d_ws + OFF_BAR, 0, XCD_BAR_WORDS * 4, stream);
    P.ph_lo = 0; P.ph_hi = NPH;
    void* args[] = {&P};
    hipError_t e = hipLaunchCooperativeKernel((const void*)mega, dim3(grid_blocks), dim3(NT), args, LDS_BYTES, stream);
    if (e != hipSuccess) fprintf(stderr, "cooperative launch failed: %s (grid %d)\n", hipGetErrorString(e), grid_blocks);
#else
    for (int ph = 0; ph < NPH; ++ph) {
        P.ph_lo = ph; P.ph_hi = ph + 1;
        hipLaunchKernelGGL(mega, dim3(grid_blocks), dim3(NT), LDS_BYTES, stream, P);
    }
#endif
}
```

```cpp
#include <hip/hip_runtime.h>
#include <hip/hip_cooperative_groups.h>
#include <cstdio>
namespace cg = cooperative_groups;

#ifndef COOP
#define COOP 1
#endif

typedef unsigned short bf16_t;
typedef float f32x4 __attribute__((ext_vector_type(4)));
typedef unsigned u32x4 __attribute__((ext_vector_type(4)));
typedef unsigned u32x2 __attribute__((ext_vector_type(2)));

constexpr int NT = 512;
constexpr int T_TOK = 16384, DM = 1024, SEQ = 4096, NB = 4;
constexpr int LDP = 3328;
constexpr int FH = 1408;
constexpr float EPS = 1e-6f;
constexpr size_t MiB = 1u << 20;
constexpr size_t OFF_W0 = 0;
constexpr size_t W_IN = OFF_W0, W_OUT = W_IN + (size_t)5376 * 1024 * 2, W_UP0 = W_OUT + 4 * MiB, W_DN0 = W_UP0 + 11 * MiB, W_GT0 = W_DN0 + (size_t)1024 * 2816 * 2, W_PP0 = W_GT0 + 2 * MiB;
constexpr size_t OFF_ABUF = 34 * MiB;
constexpr size_t OFF_R = 66 * MiB;
constexpr size_t OFF_G = 186 * MiB;
constexpr size_t OFF_W1 = 230 * MiB;
constexpr size_t W_GLU = OFF_W1, W_UP1 = W_GLU + 4 * MiB, W_DN1 = W_UP1 + 11 * MiB, W_GT1 = W_DN1 + (size_t)1024 * 2816 * 2, W_PP1 = W_GT1 + 2 * MiB;
constexpr size_t OFF_YF = 186 * MiB;
constexpr size_t OFF_SMALL = 253 * MiB;
constexpr size_t LDS_BYTES = 160 * 1024;

struct Params {
    const float *x, *p, *ssd_w_in, *ssd_conv_w, *ssd_conv_b, *ssd_dt_bias, *ssd_a_log, *ssd_d, *ssd_norm_w, *ssd_w_out;
    const float *s5_a_re, *s5_a_im, *s5_log_step, *s5_b_re, *s5_b_im, *s5_c_re, *s5_c_im, *s5_d, *s5_w_glu, *s5_b_glu;
    const float *mix_norm_w, *ffn_norm_w, *ffn_w_up, *ffn_conv_w, *ffn_conv_b, *ffn_w_down, *ple_norm_w, *ple_w_gate, *ple_w_proj, *final_norm_w;
    float* out; unsigned char* ws;
    int ph_lo, ph_hi;
};

__device__ __forceinline__ int otid() { int t = (int)__builtin_amdgcn_workitem_id_x(); asm volatile("" : "+v"(t)); return t & (NT - 1); }
__device__ __forceinline__ float bf2f(bf16_t b) { return __uint_as_float(((unsigned)b) << 16); }
__device__ __forceinline__ bf16_t f2bf(float f) { unsigned u = __float_as_uint(f); u += 0x7FFFu + ((u >> 16) & 1u); return (bf16_t)(u >> 16); }
__device__ __forceinline__ unsigned pack2(float lo, float hi) { return (unsigned)f2bf(lo) | ((unsigned)f2bf(hi) << 16); }
__device__ __forceinline__ float siluf(float v) { return v / (1.0f + __expf(-v)); }
__device__ __forceinline__ float sigmf(float v) { return 1.0f / (1.0f + __expf(-v)); }
__device__ __forceinline__ float wave_sum(float v) {
#pragma unroll
    for (int o = 32; o >= 1; o >>= 1) v += __shfl_xor(v, o);
    return v;
}

#define PG8_LAS __attribute__((address_space(3)))
typedef short bf16x8 __attribute__((ext_vector_type(8)));
namespace pg8 {
constexpr int BM = 256, BK = 64, HALF = 128, HTB = HALF * BK * 2, STAGE_BYTES = 8 * HTB, NXCD = 8, WGM = 8;
__device__ __forceinline__ int lds_byte(int r, int c) { const int st = (r >> 4) * 2 + (c >> 5), rr = r & 15, cc = c & 31, ob = rr * 64 + cc * 2; return st * 1024 + (ob ^ (((ob >> 9) & 1) << 5)); }
__device__ __forceinline__ void stage_rc(int b, int& R, int& C) { const int st = b / 1024, sb = b % 1024, swz = sb ^ (((sb >> 9) & 1) << 5); R = (st >> 1) * 16 + swz / 64; C = (st & 1) * 32 + (swz % 64) / 2; }
__device__ __forceinline__ int perm32(int rho) { const int n = rho >> 4, i = rho & 15; return 8 * (i >> 2) + 4 * n + (i & 3); }
struct Unit { int pm, pn; };
struct StaticOrder {
    int nM, nN, nwg, G, c;
    __device__ void init(int M, int N, int G_, int c_) { nM = M / BM; nN = N / BM; nwg = nM * nN; G = G_; c = c_; }
    __device__ bool next(int i, Unit& u) const {
        const long L = (long)i * G + c; if (L >= nwg) return false;
        int wgid = (int)L; { const int q = nwg / NXCD, r = nwg % NXCD, xcd = wgid % NXCD, off = wgid / NXCD; wgid = (xcd < r ? xcd * (q + 1) : r * (q + 1) + (xcd - r) * q) + off; }
        const int nig = WGM * nN, gid = wgid / nig, fm = gid * WGM, gsz = (nM - fm) < WGM ? (nM - fm) : WGM;
        u.pm = fm + ((wgid % nig) % gsz); u.pn = (wgid % nig) / gsz; return true;
    }
};
typedef __bf16 bf16x2_t __attribute__((ext_vector_type(2)));
typedef float f32x2_t __attribute__((ext_vector_type(2)));
__device__ __forceinline__ unsigned cvt_pk_bf16(float lo, float hi) { const f32x2_t v = {lo, hi}; union { bf16x2_t b; unsigned u; } r; r.b = __builtin_convertvector(v, bf16x2_t); return r.u; }
}
__device__ __forceinline__ float fsig(float v) { return __builtin_amdgcn_rcpf(1.0f + __expf(-v)); }
__device__ __forceinline__ void unpack8(const u32x4 v, float (&f)[8]) {
#pragma unroll
    for (int j = 0; j < 4; ++j) { f[2 * j] = __uint_as_float(v[j] << 16); f[2 * j + 1] = __uint_as_float(v[j] & 0xffff0000u); }
}
__device__ __forceinline__ f32x4 bf4lo(unsigned a, unsigned b) { return (f32x4){__uint_as_float(a << 16), __uint_as_float(a & 0xffff0000u), __uint_as_float(b << 16), __uint_as_float(b & 0xffff0000u)}; }

struct WDesc { const float* W; bf16_t* Wt; int K, Nsrc, Ndst, mode, H, ntiles; };
__device__ __forceinline__ void cvt_tile(const WDesc& d, int tile, float* lds) {
    const int tid = threadIdx.x, nnt = d.Ndst / 64;
    const int n0 = (tile % nnt) * 64, k0 = (tile / nnt) * 64;
    int src0;
    if (d.mode == 0) src0 = (n0 < d.Nsrc) ? n0 : -1;
    else { const int pn = n0 / 256, w = n0 % 256; src0 = (w < 128) ? pn * 128 + w : d.H + pn * 128 + (w - 128); }
    __syncthreads();
#pragma unroll
    for (int i = 0; i < 2; ++i) {
        const int r = (tid >> 4) + 32 * i, c4 = (tid & 15) * 4;
        f32x4 v = {0.f, 0.f, 0.f, 0.f};
        if (src0 >= 0) v = *(const f32x4*)(d.W + (size_t)(k0 + r) * d.Nsrc + src0 + c4);
#pragma unroll
        for (int j = 0; j < 4; ++j) lds[r * 65 + c4 + j] = v[j];
    }
    __syncthreads();
    {
        const int nr = tid >> 3, kp = (tid & 7) * 8;
        u32x4 o;
#pragma unroll
        for (int j = 0; j < 4; ++j) o[j] = pg8::cvt_pk_bf16(lds[(kp + 2 * j) * 65 + nr], lds[(kp + 2 * j + 1) * 65 + nr]);
        *(u32x4*)(d.Wt + (size_t)(n0 + nr) * d.K + k0 + kp) = o;
    }
}
__device__ __forceinline__ WDesc mkdesc(const float* W, bf16_t* Wt, int K, int Nsrc, int Ndst, int mode, int H) { WDesc d; d.W = W; d.Wt = Wt; d.K = K; d.Nsrc = Nsrc; d.Ndst = Ndst; d.mode = mode; d.H = H; d.ntiles = (K / 64) * (Ndst / 64); return d; }
#define CVT_ONE(W, Wt, K, Ns, Nd, mode, H) { const int n_ = ((K) / 64) * ((Nd) / 64); if (tt >= 0 && tt < n_) { const WDesc d_ = mkdesc(W, Wt, K, Ns, Nd, mode, H); cvt_tile(d_, tt, lds); } tt -= n_; }
__device__ __forceinline__ void cvt_weights0(const Params& P, float* lds) {
    unsigned char* ws = P.ws;
    for (int t = blockIdx.x; t < 1344 + 512 + 1408 + 704 + 256 + 64; t += gridDim.x) {
        int tt = t;
        CVT_ONE(P.ssd_w_in, (bf16_t*)(ws + W_IN), 1024, 5184, 5376, 0, 0)
        CVT_ONE(P.ssd_w_out, (bf16_t*)(ws + W_OUT), 2048, 1024, 1024, 0, 0)
        CVT_ONE(P.ffn_w_up, (bf16_t*)(ws + W_UP0), 1024, 5632, 5632, 1, 2816)
        CVT_ONE(P.ffn_w_down, (bf16_t*)(ws + W_DN0), 2816, 1024, 1024, 0, 0)
        CVT_ONE(P.ple_w_gate, (bf16_t*)(ws + W_GT0), 1024, 1024, 1024, 0, 0)
        CVT_ONE(P.ple_w_proj, (bf16_t*)(ws + W_PP0), 256, 1024, 1024, 0, 0)
    }
}
__device__ __forceinline__ void cvt_weights1(const Params& P, float* lds) {
    unsigned char* ws = P.ws;
    for (int t = blockIdx.x; t < 512 + 1408 + 704 + 256 + 64; t += gridDim.x) {
        int tt = t;
        CVT_ONE(P.s5_w_glu, (bf16_t*)(ws + W_GLU), 1024, 2048, 2048, 1, 1024)
        CVT_ONE(P.ffn_w_up + (size_t)1024 * 5632, (bf16_t*)(ws + W_UP1), 1024, 5632, 5632, 1, 2816)
        CVT_ONE(P.ffn_w_down + (size_t)2816 * 1024, (bf16_t*)(ws + W_DN1), 2816, 1024, 1024, 0, 0)
        CVT_ONE(P.ple_w_gate + (size_t)1024 * 1024, (bf16_t*)(ws + W_GT1), 1024, 1024, 1024, 0, 0)
        CVT_ONE(P.ple_w_proj + (size_t)256 * 1024, (bf16_t*)(ws + W_PP1), 256, 1024, 1024, 0, 0)
    }
}
__device__ __forceinline__ void ph_norm(const float* src, const float* w, bf16_t* dstb, float* dstf) {
    const int lane = threadIdx.x & 63, wid = threadIdx.x >> 6;
    for (int row = blockIdx.x * 8 + wid; row < T_TOK; row += gridDim.x * 8) {
        const float* s = src + (size_t)row * DM;
        f32x4 v[4]; float ss = 0.f;
#pragma unroll
        for (int i = 0; i < 4; ++i) { v[i] = *(const f32x4*)(s + lane * 4 + 256 * i); ss += v[i][0] * v[i][0] + v[i][1] * v[i][1] + v[i][2] * v[i][2] + v[i][3] * v[i][3]; }
        ss = wave_sum(ss);
        const float rstd = rsqrtf(ss * (1.0f / DM) + EPS);
#pragma unroll
        for (int i = 0; i < 4; ++i) {
            const f32x4 wv = *(const f32x4*)(w + lane * 4 + 256 * i);
            const f32x4 o = v[i] * rstd * wv;
            if (dstb) { u32x2 pk; pk.x = pack2(o[0], o[1]); pk.y = pack2(o[2], o[3]); *(u32x2*)(dstb + (size_t)row * DM + lane * 4 + 256 * i) = pk; }
            else *(f32x4*)(dstf + (size_t)row * DM + lane * 4 + 256 * i) = o;
        }
    }
}
__device__ __forceinline__ void ph_norm16(const bf16_t* src, const float* w, bf16_t* dstb, float* dstf) {
    const int lane = threadIdx.x & 63, wid = threadIdx.x >> 6;
    for (int row = blockIdx.x * 8 + wid; row < T_TOK; row += gridDim.x * 8) {
        const bf16_t* sp = src + (size_t)row * DM;
        float v[2][8]; float ss = 0.f;
#pragma unroll
        for (int i = 0; i < 2; ++i) { unpack8(*(const u32x4*)(sp + lane * 8 + 512 * i), v[i]);
#pragma unroll
            for (int j = 0; j < 8; ++j) ss += v[i][j] * v[i][j]; }
        ss = wave_sum(ss);
        const float rstd = rsqrtf(ss * (1.0f / DM) + EPS);
#pragma unroll
        for (int i = 0; i < 2; ++i) {
            const f32x4 w0 = *(const f32x4*)(w + lane * 8 + 512 * i), w1 = *(const f32x4*)(w + lane * 8 + 512 * i + 4);
            float o[8];
#pragma unroll
            for (int j = 0; j < 4; ++j) { o[j] = v[i][j] * rstd * w0[j]; o[4 + j] = v[i][4 + j] * rstd * w1[j]; }
            if (dstb) { u32x4 pk; pk.x = pg8::cvt_pk_bf16(o[0], o[1]); pk.y = pg8::cvt_pk_bf16(o[2], o[3]); pk.z = pg8::cvt_pk_bf16(o[4], o[5]); pk.w = pg8::cvt_pk_bf16(o[6], o[7]); *(u32x4*)(dstb + (size_t)row * DM + lane * 8 + 512 * i) = pk; }
            else { *(f32x4*)(dstf + (size_t)row * DM + lane * 8 + 512 * i) = (f32x4){o[0], o[1], o[2], o[3]}; *(f32x4*)(dstf + (size_t)row * DM + lane * 8 + 512 * i + 4) = (f32x4){o[4], o[5], o[6], o[7]}; }
        }
    }
}
__device__ __forceinline__ void ph_cvt_copy(const float* src, bf16_t* dst, size_t n) {
    for (size_t i = ((size_t)blockIdx.x * NT + threadIdx.x) * 4; i < n; i += (size_t)gridDim.x * NT * 4) {
        const f32x4 v = *(const f32x4*)(src + i); u32x2 pk; pk.x = pack2(v[0], v[1]); pk.y = pack2(v[2], v[3]); *(u32x2*)(dst + i) = pk;
    }
}

enum { EPI_BF16 = 0, EPI_RES = 1, EPI_F32 = 2, EPI_PLE = 3, EPI_GLU = 4, EPI_ZGATE = 5, EPI_RESX = 6, EPI_RES16 = 7, EPI_PLE16 = 8, EPI_GLU16 = 9 };
struct GemmArgs {
    const bf16_t* A; int lda; const bf16_t* Bt; int ldb; int M, N, K; int epi;
    void* out; int ldc; const float* res; const float* aux; const bf16_t* y1; const bf16_t* y2; const float* bias;
};
__device__ __forceinline__ void epi_store(const GemmArgs& g, int row, int pn, int tc, float acc, float accp) {
    const int col = pn * 256 + tc;
    switch (g.epi) {
        case EPI_BF16: ((bf16_t*)g.out)[(size_t)row * g.ldc + col] = f2bf(acc); break;
        case EPI_RES: { const size_t o = (size_t)row * g.ldc + col; ((float*)g.out)[o] = g.res[o] + acc; } break;
        case EPI_F32: ((float*)g.out)[(size_t)row * g.ldc + col] = acc; break;
        case EPI_PLE: { const size_t o = (size_t)row * g.ldc + col; ((float*)g.out)[o] = g.res[o] + g.aux[o] * sigmf(acc); } break;
        case EPI_GLU: { const int oc = pn * 128 + tc; const size_t o = (size_t)row * g.ldc + oc; ((float*)g.out)[o] = g.res[o] + (acc + g.bias[oc]) * sigmf(accp + g.bias[1024 + oc]); } break;
        case EPI_ZGATE: { const size_t yo = (size_t)row * 2048 + col; ((bf16_t*)g.out)[(size_t)row * g.ldc + col] = f2bf((bf2f(g.y1[yo]) + bf2f(g.y2[yo])) * siluf(acc)); } break;
    }
}
__device__ __forceinline__ void gemm_naive(const GemmArgs& g, float* lds) {
    float* As = lds;
    float* Bs = lds + 32 * 132;
    const int tid = threadIdx.x, ty = tid >> 4, tx = tid & 15;
    const int nM = g.M / 128, nN = g.N / 256;
    for (int tile = blockIdx.x; tile < nM * nN; tile += gridDim.x) {
        const int pm = tile % nM, pn = tile / nM;
        float acc[4][16];
#pragma unroll
        for (int i = 0; i < 4; ++i)
#pragma unroll
            for (int j = 0; j < 16; ++j) acc[i][j] = 0.f;
        for (int k0 = 0; k0 < g.K; k0 += 32) {
            __syncthreads();
            { const int r = tid >> 2, kk = (tid & 3) * 8;
              const u32x4 v = *(const u32x4*)(g.A + (size_t)(pm * 128 + r) * g.lda + k0 + kk);
#pragma unroll
              for (int j = 0; j < 4; ++j) { As[(kk + 2 * j) * 132 + r] = __uint_as_float(v[j] << 16); As[(kk + 2 * j + 1) * 132 + r] = __uint_as_float(v[j] & 0xffff0000u); } }
#pragma unroll
            for (int h = 0; h < 2; ++h) { const int r = (tid >> 2) + 128 * h, kk = (tid & 3) * 8;
              const u32x4 v = *(const u32x4*)(g.Bt + (size_t)(pn * 256 + r) * g.ldb + k0 + kk);
#pragma unroll
              for (int j = 0; j < 4; ++j) { Bs[(kk + 2 * j) * 260 + r] = __uint_as_float(v[j] << 16); Bs[(kk + 2 * j + 1) * 260 + r] = __uint_as_float(v[j] & 0xffff0000u); } }
            __syncthreads();
#pragma unroll 4
            for (int kk = 0; kk < 32; ++kk) {
                const f32x4 a = *(const f32x4*)(As + kk * 132 + ty * 4);
                const f32x4 b0 = *(const f32x4*)(Bs + kk * 260 + tx * 8), b1 = *(const f32x4*)(Bs + kk * 260 + tx * 8 + 4);
                const f32x4 b2 = *(const f32x4*)(Bs + kk * 260 + 128 + tx * 8), b3 = *(const f32x4*)(Bs + kk * 260 + 128 + tx * 8 + 4);
#pragma unroll
                for (int i = 0; i < 4; ++i)
#pragma unroll
                    for (int j = 0; j < 4; ++j) { acc[i][j] += a[i] * b0[j]; acc[i][4 + j] += a[i] * b1[j]; acc[i][8 + j] += a[i] * b2[j]; acc[i][12 + j] += a[i] * b3[j]; }
            }
        }
#pragma unroll
        for (int i = 0; i < 4; ++i) {
            const int row = pm * 128 + ty * 4 + i;
#pragma unroll
            for (int j = 0; j < 8; ++j) {
                if (g.epi == EPI_GLU) epi_store(g, row, pn, tx * 8 + j, acc[i][j], acc[i][8 + j]);
                else { epi_store(g, row, pn, tx * 8 + j, acc[i][j], 0.f); epi_store(g, row, pn, 128 + tx * 8 + j, acc[i][8 + j], 0.f); }
            }
        }
    }
}
__device__ __forceinline__ GemmArgs mkgemm(const bf16_t* A, int lda, const bf16_t* Bt, int ldb, int M, int N, int K, int epi, void* out, int ldc,
                                           const float* res = nullptr, const float* aux = nullptr, const bf16_t* y1 = nullptr, const bf16_t* y2 = nullptr, const float* bias = nullptr) {
    GemmArgs g; g.A = A; g.lda = lda; g.Bt = Bt; g.ldb = ldb; g.M = M; g.N = N; g.K = K; g.epi = epi; g.out = out; g.ldc = ldc; g.res = res; g.aux = aux; g.y1 = y1; g.y2 = y2; g.bias = bias; return g;
}

template <int EPI>
__device__ __forceinline__ void epi_tile(const GemmArgs& g, const f32x4 (&acc)[2][2][4][2], const pg8::Unit& u, int wr, int wc, int fr, int fq) {
    const int row0 = u.pm * 256 + wr * 64 + fr;
    if constexpr (EPI == EPI_RESX || EPI == EPI_RES16 || EPI == EPI_PLE16 || EPI == EPI_GLU16) {
        constexpr int NBJ = (EPI == EPI_GLU16) ? 1 : 2;
        const int col0 = (EPI == EPI_GLU16 ? u.pn * 128 : u.pn * 256) + wc * 32 + 8 * fq;
        f32x4 bv[2] = {{0.f, 0.f, 0.f, 0.f}, {0.f, 0.f, 0.f, 0.f}}, bg[2] = {{0.f, 0.f, 0.f, 0.f}, {0.f, 0.f, 0.f, 0.f}};
        if constexpr (EPI == EPI_GLU16) {
#pragma unroll
            for (int n = 0; n < 2; ++n) { bv[n] = *(const f32x4*)(g.bias + col0 + 4 * n); bg[n] = *(const f32x4*)(g.bias + 1024 + col0 + 4 * n); }
        }
#pragma unroll
        for (int ai = 0; ai < 2; ++ai)
#pragma unroll
            for (int m = 0; m < 4; ++m) {
                const int row = row0 + ai * 128 + m * 16;
#pragma unroll
                for (int bj = 0; bj < NBJ; ++bj) {
                    const size_t o = (size_t)row * g.ldc + col0 + bj * 128;
                    f32x4 r0, r1;
                    if constexpr (EPI == EPI_RESX) { r0 = *(const f32x4*)(g.res + o); r1 = *(const f32x4*)(g.res + o + 4); }
                    else { const u32x4 rr = *(const u32x4*)((const bf16_t*)g.res + o); r0 = bf4lo(rr[0], rr[1]); r1 = bf4lo(rr[2], rr[3]); }
                    f32x4 v0 = acc[ai][bj][m][0], v1 = acc[ai][bj][m][1];
                    if constexpr (EPI == EPI_PLE16) {
                        const u32x4 aa = *(const u32x4*)((const bf16_t*)g.aux + o); const f32x4 a0 = bf4lo(aa[0], aa[1]), a1 = bf4lo(aa[2], aa[3]);
#pragma unroll
                        for (int j = 0; j < 4; ++j) { v0[j] = a0[j] * fsig(v0[j]); v1[j] = a1[j] * fsig(v1[j]); }
                    }
                    if constexpr (EPI == EPI_GLU16) {
                        const f32x4 g0 = acc[ai][1][m][0] + bg[0], g1 = acc[ai][1][m][1] + bg[1];
                        v0 += bv[0]; v1 += bv[1];
#pragma unroll
                        for (int j = 0; j < 4; ++j) { v0[j] *= fsig(g0[j]); v1[j] *= fsig(g1[j]); }
                    }
                    v0 += r0; v1 += r1;
                    u32x4 w; w.x = pg8::cvt_pk_bf16(v0[0], v0[1]); w.y = pg8::cvt_pk_bf16(v0[2], v0[3]); w.z = pg8::cvt_pk_bf16(v1[0], v1[1]); w.w = pg8::cvt_pk_bf16(v1[2], v1[3]);
                    *(u32x4*)((bf16_t*)g.out + o) = w;
                }
                asm volatile("" ::: "memory");
            }
    } else if constexpr (EPI == EPI_BF16 || EPI == EPI_ZGATE) {
        const int col0 = u.pn * 256 + wc * 32 + 8 * fq;
#pragma unroll
        for (int ai = 0; ai < 2; ++ai)
#pragma unroll
            for (int m = 0; m < 4; ++m) {
                const int row = row0 + ai * 128 + m * 16;
#pragma unroll
                for (int bj = 0; bj < 2; ++bj) {
                    f32x4 v0 = acc[ai][bj][m][0], v1 = acc[ai][bj][m][1];
                    const int col = col0 + bj * 128;
                    if constexpr (EPI == EPI_ZGATE) {
                        const u32x4 a = *(const u32x4*)(g.y1 + (size_t)row * 2048 + col), b = *(const u32x4*)(g.y2 + (size_t)row * 2048 + col);
                        const f32x4 y0 = bf4lo(a[0], a[1]) + bf4lo(b[0], b[1]), y1v = bf4lo(a[2], a[3]) + bf4lo(b[2], b[3]);
#pragma unroll
                        for (int j = 0; j < 4; ++j) { v0[j] = y0[j] * v0[j] * fsig(v0[j]); v1[j] = y1v[j] * v1[j] * fsig(v1[j]); }
                    }
                    u32x4 w; w.x = pg8::cvt_pk_bf16(v0[0], v0[1]); w.y = pg8::cvt_pk_bf16(v0[2], v0[3]); w.z = pg8::cvt_pk_bf16(v1[0], v1[1]); w.w = pg8::cvt_pk_bf16(v1[2], v1[3]);
                    *(u32x4*)((bf16_t*)g.out + (size_t)row * g.ldc + col) = w;
                }
                if constexpr (EPI == EPI_ZGATE) asm volatile("" ::: "memory");
            }
    } else if constexpr (EPI == EPI_GLU) {
        const int col0 = u.pn * 128 + wc * 32 + 4 * fq;
        f32x4 bv[2], bg[2];
#pragma unroll
        for (int n = 0; n < 2; ++n) { bv[n] = *(const f32x4*)(g.bias + col0 + 16 * n); bg[n] = *(const f32x4*)(g.bias + 1024 + col0 + 16 * n); }
#pragma unroll
        for (int ai = 0; ai < 2; ++ai)
#pragma unroll
            for (int m = 0; m < 4; ++m) {
                const int row = row0 + ai * 128 + m * 16;
#pragma unroll
                for (int n = 0; n < 2; ++n) {
                    const size_t o = (size_t)row * g.ldc + col0 + 16 * n;
                    const f32x4 r = *(const f32x4*)(g.res + o), v = acc[ai][0][m][n] + bv[n], gt = acc[ai][1][m][n] + bg[n];
                    f32x4 ov;
#pragma unroll
                    for (int j = 0; j < 4; ++j) ov[j] = r[j] + v[j] * fsig(gt[j]);
                    *(f32x4*)((float*)g.out + o) = ov;
                }
                asm volatile("" ::: "memory");
            }
    } else {
        const int col0 = u.pn * 256 + wc * 32 + 4 * fq;
#pragma unroll
        for (int ai = 0; ai < 2; ++ai)
#pragma unroll
            for (int m = 0; m < 4; ++m) {
                const int row = row0 + ai * 128 + m * 16;
#pragma unroll
                for (int bj = 0; bj < 2; ++bj)
#pragma unroll
                    for (int n = 0; n < 2; ++n) {
                        const size_t o = (size_t)row * g.ldc + col0 + bj * 128 + n * 16;
                        f32x4 ov = acc[ai][bj][m][n];
                        if constexpr (EPI == EPI_RES) ov += *(const f32x4*)(g.res + o);
                        if constexpr (EPI == EPI_PLE) { const f32x4 r = *(const f32x4*)(g.res + o), a = *(const f32x4*)(g.aux + o);
#pragma unroll
                            for (int j = 0; j < 4; ++j) ov[j] = r[j] + a[j] * fsig(ov[j]); }
                        *(f32x4*)((float*)g.out + o) = ov;
                    }
                if constexpr (EPI != EPI_F32) asm volatile("" ::: "memory");
            }
    }
}

template <int EPI>
__device__ __forceinline__ void gemm_pg8(PG8_LAS unsigned char* lds, const GemmArgs g) {
    using namespace pg8;
    constexpr bool PERM = (EPI == EPI_BF16 || EPI == EPI_ZGATE || EPI == EPI_RESX || EPI == EPI_RES16 || EPI == EPI_PLE16 || EPI == EPI_GLU16);
    const int tid = otid(), wid = __builtin_amdgcn_readfirstlane(tid >> 6), lane = tid & 63, wr = wid >> 2, wc = wid & 3, fr = lane & 15, fq = lane >> 4;
    const int K = g.K, nt = K / BK;
    StaticOrder S; S.init(g.M, g.N, (int)gridDim.x, (int)blockIdx.x);
    unsigned voffA[2], voffB[2];
#pragma unroll
    for (int i = 0; i < 2; ++i) { int R, C; stage_rc(tid * 16 + i * 8192, R, C); const int Rb = PERM ? ((R & ~31) + perm32(R & 31)) : R;
        voffA[i] = (unsigned)(R * g.lda + C) * 2u; voffB[i] = (unsigned)(Rb * g.ldb + C) * 2u; }
    const size_t kstep = (size_t)(BK * 2);
    const size_t hstepA = (size_t)HALF * g.lda * 2, hstepB = (size_t)HALF * g.ldb * 2;
    const size_t tstepA = 2 * hstepA, tstepB = 2 * hstepB;
    const unsigned ldsw = (unsigned)wid * 1024u;
    const int aoff = lds_byte(wr * 64 + fr, fq * 8), boff = lds_byte(wc * 32 + fr, fq * 8);
#define PG8_SA(b, h) (((b) * 2 + (h)) * HTB)
#define PG8_SB(b, h) ((4 + (b) * 2 + (h)) * HTB)
#define PG8_STAGE(bufoff, gbase, voff) do { _Pragma("unroll") for (int _i = 0; _i < 2; ++_i) \
        __builtin_amdgcn_global_load_lds((const unsigned*)((const char*)(gbase) + (voff)[_i]), (PG8_LAS unsigned*)(lds + (bufoff) + ldsw + _i * 8192), 16, 0, 0); } while (0)
#define PG8_LDA(dst, b, h) do { _Pragma("unroll") for (int m = 0; m < 4; ++m) _Pragma("unroll") for (int k = 0; k < 2; ++k) dst[m][k] = *(const PG8_LAS bf16x8*)(lds + PG8_SA(b, h) + aoff + m * 2048 + k * 1024); } while (0)
#define PG8_LDB(dst, b, h) do { _Pragma("unroll") for (int n = 0; n < 2; ++n) _Pragma("unroll") for (int k = 0; k < 2; ++k) dst[n][k] = *(const PG8_LAS bf16x8*)(lds + PG8_SB(b, h) + boff + n * 2048 + k * 1024); } while (0)
#define PG8_MMA(ai, bj, At, Bt) do { __builtin_amdgcn_s_setprio(1); _Pragma("unroll") for (int m = 0; m < 4; ++m) _Pragma("unroll") for (int n = 0; n < 2; ++n) _Pragma("unroll") for (int k = 0; k < 2; ++k) \
        acc[ai][bj][m][n] = __builtin_amdgcn_mfma_f32_16x16x32_bf16(Bt[n][k], At[m][k], acc[ai][bj][m][n], 0, 0, 0); __builtin_amdgcn_s_setprio(0); } while (0)
#define PG8_WAIT_V(n) asm volatile("s_waitcnt vmcnt(" #n ")" ::: "memory")
#define PG8_WAIT_L(n) asm volatile("s_waitcnt lgkmcnt(" #n ")" ::: "memory")
#define PG8_BAR __builtin_amdgcn_s_barrier()
#define PG8_SCHED __builtin_amdgcn_sched_barrier(0)
    Unit cur, nxt; int ui = 0;
    if (!S.next(0, cur)) return;
    f32x4 acc[2][2][4][2];
#pragma unroll
    for (int a = 0; a < 2; ++a)
#pragma unroll
        for (int b = 0; b < 2; ++b)
#pragma unroll
            for (int m = 0; m < 4; ++m)
#pragma unroll
                for (int n = 0; n < 2; ++n) acc[a][b][m][n] = (f32x4){0.f, 0.f, 0.f, 0.f};
    bf16x8 At[4][2], B0[2][2], B1[2][2];
    const char* cA = (const char*)g.A + (size_t)cur.pm * tstepA; const char* cB = (const char*)g.Bt + (size_t)cur.pn * tstepB;
    PG8_STAGE(PG8_SB(0, 0), cB, voffB); PG8_STAGE(PG8_SA(0, 0), cA, voffA); PG8_STAGE(PG8_SB(0, 1), cB + hstepB, voffB); PG8_STAGE(PG8_SA(0, 1), cA + hstepA, voffA);
    if (wr == 1) PG8_BAR;
    PG8_WAIT_V(4); PG8_BAR;
    PG8_STAGE(PG8_SB(1, 0), cB + kstep, voffB); PG8_STAGE(PG8_SA(1, 0), cA + kstep, voffA); PG8_STAGE(PG8_SB(1, 1), cB + hstepB + kstep, voffB);
    PG8_WAIT_V(6); PG8_BAR;
    for (;;) {
        const bool has_next = S.next(ui + 1, nxt);
        const char* nA = has_next ? (const char*)g.A + (size_t)nxt.pm * tstepA : cA; const char* nB = has_next ? (const char*)g.Bt + (size_t)nxt.pn * tstepB : cB;
        for (int t = 0; t < nt; t += 2) {
            const bool last = (t == nt - 2);
            const char* a1 = cA + (size_t)(t + 1) * kstep;
            const char* a2 = last ? nA : cA + (size_t)(t + 2) * kstep; const char* b2 = last ? nB : cB + (size_t)(t + 2) * kstep;
            const char* a3 = a2 + kstep; const char* b3 = b2 + kstep;
            PG8_LDB(B0, 0, 0); PG8_SCHED; PG8_LDA(At, 0, 0); PG8_STAGE(PG8_SA(1, 1), a1 + hstepA, voffA);
            PG8_WAIT_L(8); PG8_BAR; PG8_WAIT_L(0); PG8_MMA(0, 0, At, B0); PG8_BAR; PG8_SCHED;
            PG8_LDB(B1, 0, 1); PG8_STAGE(PG8_SB(0, 0), b2, voffB);
            PG8_BAR; PG8_WAIT_L(0); PG8_MMA(0, 1, At, B1); PG8_BAR;
            PG8_LDA(At, 0, 1); PG8_STAGE(PG8_SA(0, 0), a2, voffA);
            PG8_BAR; PG8_WAIT_L(0); PG8_MMA(1, 0, At, B0); PG8_BAR; PG8_SCHED;
            PG8_STAGE(PG8_SB(0, 1), b2 + hstepB, voffB);
            PG8_WAIT_V(6); PG8_BAR; PG8_MMA(1, 1, At, B1); PG8_BAR;
            PG8_LDB(B0, 1, 0); PG8_SCHED; PG8_LDA(At, 1, 0); PG8_STAGE(PG8_SA(0, 1), a2 + hstepA, voffA);
            PG8_WAIT_L(8); PG8_BAR; PG8_WAIT_L(0); PG8_MMA(0, 0, At, B0); PG8_BAR; PG8_SCHED;
            PG8_LDB(B1, 1, 1); PG8_STAGE(PG8_SB(1, 0), b3, voffB);
            PG8_BAR; PG8_WAIT_L(0); PG8_MMA(0, 1, At, B1); PG8_BAR;
            PG8_LDA(At, 1, 1); PG8_STAGE(PG8_SA(1, 0), a3, voffA);
            PG8_BAR; PG8_WAIT_L(0); PG8_MMA(1, 0, At, B0); PG8_BAR; PG8_SCHED;
            PG8_STAGE(PG8_SB(1, 1), b3 + hstepB, voffB);
            PG8_WAIT_V(6); PG8_BAR; PG8_MMA(1, 1, At, B1); PG8_BAR;
        }
        epi_tile<EPI>(g, acc, cur, wr, wc, fr, fq);
        if (!has_next) break;
#pragma unroll
        for (int a = 0; a < 2; ++a)
#pragma unroll
            for (int b = 0; b < 2; ++b)
#pragma unroll
                for (int m = 0; m < 4; ++m)
#pragma unroll
                    for (int n = 0; n < 2; ++n) acc[a][b][m][n] = (f32x4){0.f, 0.f, 0.f, 0.f};
        cur = nxt; cA = nA; cB = nB; ++ui;
    }
    PG8_WAIT_V(0);
    if (wr == 0) PG8_BAR;
    PG8_BAR;
#undef PG8_SA
#undef PG8_SB
#undef PG8_STAGE
#undef PG8_LDA
#undef PG8_LDB
#undef PG8_MMA
#undef PG8_WAIT_V
#undef PG8_WAIT_L
#undef PG8_BAR
#undef PG8_SCHED
}

__device__ __forceinline__ void ph_ssd_halo(const Params& P) {
    bf16_t* proj = (bf16_t*)(P.ws + OFF_R); bf16_t* halo = (bf16_t*)(P.ws + OFF_SMALL);
    const int gt = blockIdx.x * NT + threadIdx.x, gs = gridDim.x * NT;
    for (int i = gt; i < 512 * 4 * 256; i += gs) {
        const int ch = i & 255, hr = (i >> 8) & 3, item = i >> 10;
        const int g = item & 3, c = (item >> 2) & 31, b = item >> 7;
        const int lt = c * 128 + (hr < 2 ? hr - 2 : 126 + hr);
        const int col = 2048 + (ch >> 7) * 512 + g * 128 + (ch & 127);
        bf16_t v = 0;
        if (lt >= 0 && lt < SEQ) v = proj[(size_t)(b * SEQ + lt) * LDP + col];
        halo[i] = v;
    }
    for (int i = gt; i < T_TOK * 64; i += gs) {
        const int j = i & 63, t = i >> 6;
        const float xr = bf2f(proj[(size_t)t * LDP + 3072 + j]) + P.ssd_dt_bias[j];
        const float sp = fmaxf(xr, 0.f) + log1pf(__expf(-fabsf(xr)));
        ((float*)(proj + (size_t)t * LDP + 3136))[j] = sp;
    }
}
constexpr size_t OFF_CB = OFF_R + 104 * MiB;
__device__ __forceinline__ void ph_ssd_bcconv(const Params& P, unsigned char* ldsraw) {
    bf16_t* proj = (bf16_t*)(P.ws + OFF_R); const bf16_t* halo = (const bf16_t*)(P.ws + OFF_SMALL); bf16_t* CBg = (bf16_t*)(P.ws + OFF_CB);
    bf16_t* tile = (bf16_t*)ldsraw;
    bf16_t* cv = tile + 132 * 256;
    const int tid = threadIdx.x, lane = tid & 63, wid = tid >> 6, fr = lane & 15, q = lane >> 4;
    for (int item = blockIdx.x; item < 512; item += gridDim.x) {
        const int g = item & 3, c = (item >> 2) & 31, b = item >> 7;
        const size_t r0 = (size_t)b * SEQ + c * 128;
        __syncthreads();
        for (int i = tid; i < 132 * 32; i += NT) {
            const int co = i & 31, r = i >> 5, ch = co * 8;
            const int col = 2048 + (ch >> 7) * 512 + g * 128 + (ch & 127);
            u32x4 v;
            if (r < 2) v = *(const u32x4*)(halo + (size_t)item * 1024 + r * 256 + ch);
            else if (r >= 130) v = *(const u32x4*)(halo + (size_t)item * 1024 + (r - 128) * 256 + ch);
            else v = *(const u32x4*)(proj + (r0 + r - 2) * LDP + col);
            *(u32x4*)(tile + r * 256 + ch) = v;
        }
        __syncthreads();
        for (int i = tid; i < 128 * 32; i += NT) {
            const int co = i & 31, r = i >> 5, ch = co * 8;
            const int col = 2048 + (ch >> 7) * 512 + g * 128 + (ch & 127);
            float acc[8];
            { const f32x4 b0 = *(const f32x4*)(P.ssd_conv_b + col), b1 = *(const f32x4*)(P.ssd_conv_b + col + 4);
#pragma unroll
              for (int j = 0; j < 4; ++j) { acc[j] = b0[j]; acc[4 + j] = b1[j]; } }
#pragma unroll
            for (int k = 0; k < 5; ++k) {
                float xv[8]; unpack8(*(const u32x4*)(tile + (r + k) * 256 + ch), xv);
                const f32x4 w0 = *(const f32x4*)(P.ssd_conv_w + k * 3072 + col), w1 = *(const f32x4*)(P.ssd_conv_w + k * 3072 + col + 4);
#pragma unroll
                for (int j = 0; j < 4; ++j) { acc[j] += xv[j] * w0[j]; acc[4 + j] += xv[4 + j] * w1[j]; }
            }
            u32x4 o;
#pragma unroll
            for (int j = 0; j < 4; ++j) o[j] = pg8::cvt_pk_bf16(acc[2 * j] * fsig(acc[2 * j]), acc[2 * j + 1] * fsig(acc[2 * j + 1]));
            *(u32x4*)(cv + r * 264 + ch) = o;
            if (ch >= 128) *(u32x4*)(proj + (r0 + r) * LDP + col) = o;
        }
        __syncthreads();
        for (int i = tid; i < 2048; i += NT) {
            const int n = i >> 4, to = (i & 15) * 8; u32x4 o;
#pragma unroll
            for (int j = 0; j < 4; ++j) o[j] = (unsigned)cv[(to + 2 * j) * 264 + n] | ((unsigned)cv[(to + 2 * j + 1) * 264 + n] << 16);
            *(u32x4*)(proj + (r0 + n) * LDP + 2048 + g * 128 + to) = o;
        }
        bf16x8 af[4];
#pragma unroll
        for (int ks = 0; ks < 4; ++ks) af[ks] = *(const bf16x8*)(cv + (16 * wid + fr) * 264 + 32 * ks + 8 * q);
        bf16_t* cbo = CBg + (size_t)item * 16384;
#pragma unroll
        for (int lt = 0; lt < 8; ++lt) {
            f32x4 acc = {0.f, 0.f, 0.f, 0.f};
#pragma unroll
            for (int ks = 0; ks < 4; ++ks) { const bf16x8 bfr = *(const bf16x8*)(cv + (16 * lt + fr) * 264 + 128 + 32 * ks + 8 * q); acc = __builtin_amdgcn_mfma_f32_16x16x32_bf16(af[ks], bfr, acc, 0, 0, 0); }
            u32x2 o; o.x = pg8::cvt_pk_bf16(acc[0], acc[1]); o.y = pg8::cvt_pk_bf16(acc[2], acc[3]);
            *(u32x2*)(cbo + (16 * lt + fr) * 128 + 16 * wid + 4 * q) = o;
        }
    }
}
__device__ __forceinline__ void ph_ssd_scan_naive(const Params& P, unsigned char* ldsraw) {
    const bf16_t* proj = (const bf16_t*)(P.ws + OFF_R);
    bf16_t* Bs = (bf16_t*)ldsraw;
    bf16_t* Cs = Bs + 64 * 128;
    float* xs = (float*)(Cs + 64 * 128);
    float* dts = xs + 64 * 64;
    const int tid = threadIdx.x, p = tid >> 3, ng = tid & 7;
    for (int item = blockIdx.x; item < 256; item += gridDim.x) {
        const int d = item & 1, hh = (item >> 1) & 31, b = item >> 6, g = hh >> 3;
        const float a = -__expf(P.ssd_a_log[d * 32 + hh]), dsk = P.ssd_d[hh];
        bf16_t* Y = d ? (bf16_t*)P.out : (bf16_t*)(P.ws + OFF_YF);
        float h[16];
#pragma unroll
        for (int j = 0; j < 16; ++j) h[j] = 0.f;
        for (int blk = 0; blk < SEQ / 64; ++blk) {
            __syncthreads();
            for (int i = tid; i < 64 * 128; i += NT) {
                const int n = i & 127, r = i >> 7; const int lt = d ? SEQ - 1 - (blk * 64 + r) : blk * 64 + r;
                const size_t ro = (size_t)(b * SEQ + lt) * LDP;
                Bs[i] = proj[(size_t)(b * SEQ + (lt & ~127) + n) * LDP + 2048 + g * 128 + (lt & 127)]; Cs[i] = proj[ro + 2560 + g * 128 + n];
            }
            for (int i = tid; i < 64 * 64; i += NT) {
                const int pp = i & 63, r = i >> 6; const int lt = d ? SEQ - 1 - (blk * 64 + r) : blk * 64 + r;
                const int col = hh * 64 + pp;
                float acc = P.ssd_conv_b[col];
#pragma unroll
                for (int k = 0; k < 5; ++k) { const int l2 = lt + k - 2; if (l2 >= 0 && l2 < SEQ) acc += bf2f(proj[(size_t)(b * SEQ + l2) * LDP + col]) * P.ssd_conv_w[k * 3072 + col]; }
                xs[i] = siluf(acc);
            }
            if (tid < 64) { const int lt = d ? SEQ - 1 - (blk * 64 + tid) : blk * 64 + tid; dts[tid] = ((const float*)(proj + (size_t)(b * SEQ + lt) * LDP + 3136))[d * 32 + hh]; }
            __syncthreads();
            for (int r = 0; r < 64; ++r) {
                const float dt = dts[r], xv = xs[r * 64 + p], dA = __expf(dt * a), dx = dt * xv;
                float part = 0.f;
#pragma unroll
                for (int j = 0; j < 16; ++j) { h[j] = h[j] * dA + dx * bf2f(Bs[r * 128 + ng * 16 + j]); part += bf2f(Cs[r * 128 + ng * 16 + j]) * h[j]; }
                part += __shfl_xor(part, 1); part += __shfl_xor(part, 2); part += __shfl_xor(part, 4);
                if (ng == 0) { const int lt = d ? SEQ - 1 - (blk * 64 + r) : blk * 64 + r; Y[(size_t)(b * SEQ + lt) * 2048 + hh * 64 + p] = f2bf(part + (d == 0 ? dsk * xv : 0.f)); }
            }
        }
    }
}
#define LDS_BAR() do { asm volatile("s_waitcnt lgkmcnt(0)" ::: "memory"); __builtin_amdgcn_s_barrier(); asm volatile("" ::: "memory"); } while (0)
__device__ __forceinline__ void ph_ssd_scan(const Params& P, unsigned char* ldsraw) {
    const bf16_t* proj = (const bf16_t*)(P.ws + OFF_R); const bf16_t* CBg = (const bf16_t*)(P.ws + OFF_CB);
    bf16_t* xdT = (bf16_t*)ldsraw;
    bf16_t* xdwT = xdT + 64 * 136;
    bf16_t* stb = xdwT + 64 * 136;
    bf16_t* xraw = stb + 64 * 136;
    float* cs = (float*)(xraw + 132 * 72);
    float* dts = cs + 128;
    float* tot = dts + 128;
    float* cwl = tot + 4;
    float* csA = cwl + 384;
    float* dtsA = csA + 32 * 128;
    float* totA = dtsA + 32 * 128;
    const int tid = threadIdx.x, lane = tid & 63, wid = tid >> 6, fr = lane & 15, q = lane >> 4;
    const int ltile = (wid < 4) ? wid : 11 - wid;
    for (int item = blockIdx.x; item < 256; item += gridDim.x) {
        const int d = item & 1, hh = (item >> 1) & 31, b = item >> 6, g = hh >> 3;
        const float a = -__expf(P.ssd_a_log[d * 32 + hh]), dsk = P.ssd_d[hh];
        bf16_t* Y = d ? (bf16_t*)P.out : (bf16_t*)(P.ws + OFF_YF);
        __syncthreads();
        for (int i = tid; i < 384; i += NT) cwl[i] = (i < 320) ? P.ssd_conv_w[(i >> 6) * 3072 + hh * 64 + (i & 63)] : P.ssd_conv_b[hh * 64 + i - 320];
        for (int k4 = 0; k4 < 4; ++k4) {
            const int cc = wid + 8 * k4; const size_t t0_ = (size_t)b * SEQ + cc * 128;
            const float dta = ((const float*)(proj + (t0_ + 2 * lane) * LDP + 3136))[d * 32 + hh], dtb = ((const float*)(proj + (t0_ + 2 * lane + 1) * LDP + 3136))[d * 32 + hh];
            const float ad0 = dta * a * 1.4426950408889634f, ad1 = dtb * a * 1.4426950408889634f, v = ad0 + ad1; float inc = v;
#pragma unroll
            for (int o = 1; o < 64; o <<= 1) { const float t = __shfl_up(inc, o); if (lane >= o) inc += t; }
            const float excl = inc - v, totl = __shfl(inc, 63);
            if (d == 0) { csA[cc * 128 + 2 * lane] = excl + ad0; csA[cc * 128 + 2 * lane + 1] = inc; } else { csA[cc * 128 + 2 * lane] = totl - excl; csA[cc * 128 + 2 * lane + 1] = totl - excl - ad0; }
            dtsA[cc * 128 + 2 * lane] = dta; dtsA[cc * 128 + 2 * lane + 1] = dtb; if (lane == 0) totA[cc] = totl;
        }
        f32x4 st[4];
#pragma unroll
        for (int pt = 0; pt < 4; ++pt) st[pt] = (f32x4){0.f, 0.f, 0.f, 0.f};
        u32x4 xp[3]; u32x4 cbv[4]; bf16x8 cmf[4], btf[4];
        const int whs = __builtin_amdgcn_readfirstlane(ltile) >> 1;
#pragma unroll
        for (int k0_ = 0; k0_ < 4; ++k0_) cbv[k0_] = (u32x4){0u, 0u, 0u, 0u};
#define SCAN_LOAD_A(cc) do { const size_t t0_ = (size_t)b * SEQ + (cc) * 128; \
            _Pragma("unroll") for (int e_ = 0; e_ < 3; ++e_) { const int i_ = tid + e_ * NT; const int r_ = i_ >> 3, pc_ = (i_ & 7) * 8; const int lt_ = (cc) * 128 + r_ - 2; \
                xp[e_] = (u32x4){0u, 0u, 0u, 0u}; if (i_ < 132 * 8 && lt_ >= 0 && lt_ < SEQ) xp[e_] = *(const u32x4*)(proj + ((size_t)b * SEQ + lt_) * LDP + hh * 64 + pc_); } } while (0)
#define SCAN_LOAD_C(cc) do { const size_t t0_ = (size_t)b * SEQ + (cc) * 128; const int l_ = 16 * ltile + fr, n_ = 16 * wid + fr; \
            const bf16_t* cbrow_ = CBg + (size_t)((b * 32 + (cc)) * 4 + g) * 16384 + l_ * 128 + 8 * q; const bf16_t* cmrow_ = proj + (t0_ + l_) * LDP + 2560 + g * 128 + 8 * q; \
            const bf16_t* btrow_ = proj + (t0_ + n_) * LDP + 2048 + g * 128 + 8 * q; \
            _Pragma("unroll") for (int ks_ = 0; ks_ < 4; ++ks_) { if (d ? (ks_ >= whs) : (ks_ <= whs)) cbv[ks_] = *(const u32x4*)(cbrow_ + 32 * ks_); cmf[ks_] = *(const bf16x8*)(cmrow_ + 32 * ks_); btf[ks_] = *(const bf16x8*)(btrow_ + 32 * ks_); } } while (0)
#define SCAN_CH(i_) (d ? 31 - ((i_) < 31 ? (i_) : 31) : ((i_) < 31 ? (i_) : 31))
#define SCAN_XRAW_WRITE() do { _Pragma("unroll") for (int e = 0; e < 3; ++e) { const int i = tid + e * NT; if (i < 132 * 8) *(u32x4*)(xraw + (i >> 3) * 72 + (i & 7) * 8) = xp[e]; } } while (0)
        { const int c0_ = SCAN_CH(0), c1_ = SCAN_CH(1); SCAN_LOAD_A(c0_); SCAN_LOAD_C(c0_); SCAN_XRAW_WRITE(); SCAN_LOAD_A(c1_); }
        __syncthreads();
        for (int ci = 0; ci < 32; ++ci) {
            const int c = d ? 31 - ci : ci; const size_t tok0 = (size_t)b * SEQ + c * 128;
            const int cn = SCAN_CH(ci + 1), cnn = SCAN_CH(ci + 2);
            const float* cs = csA + c * 128; const float* dts = dtsA + c * 128;
#pragma unroll
            for (int pt = 0; pt < 4; ++pt) { u32x2 o; o.x = pg8::cvt_pk_bf16(st[pt][0], st[pt][1]); o.y = pg8::cvt_pk_bf16(st[pt][2], st[pt][3]); *(u32x2*)(stb + (16 * pt + fr) * 136 + 16 * wid + 4 * q) = o; }
            const float total = totA[c];
            {
                const int tp = tid & 63, oc = (tid >> 6) * 8;
                float w5[5][8], accA[8], accB[8];
#pragma unroll
                for (int k = 0; k < 5; ++k) { const f32x4 w0 = *(const f32x4*)(cwl + k * 64 + oc), w1 = *(const f32x4*)(cwl + k * 64 + oc + 4);
#pragma unroll
                    for (int j = 0; j < 4; ++j) { w5[k][j] = w0[j]; w5[k][4 + j] = w1[j]; } }
                { const f32x4 b0 = *(const f32x4*)(cwl + 320 + oc), b1 = *(const f32x4*)(cwl + 320 + oc + 4);
#pragma unroll
                  for (int j = 0; j < 4; ++j) { accA[j] = b0[j]; accA[4 + j] = b1[j]; accB[j] = b0[j]; accB[4 + j] = b1[j]; } }
#pragma unroll
                for (int k = 0; k < 6; ++k) {
                    float xr[8]; unpack8(*(const u32x4*)(xraw + (2 * tp + k) * 72 + oc), xr);
#pragma unroll
                    for (int j = 0; j < 8; ++j) { if (k < 5) accA[j] += xr[j] * w5[k < 5 ? k : 0][j]; if (k > 0) accB[j] += xr[j] * w5[k > 0 ? k - 1 : 0][j]; }
                }
                const float dtA = dts[2 * tp], dtB = dts[2 * tp + 1], wA = __builtin_amdgcn_exp2f(total - cs[2 * tp]), wB = __builtin_amdgcn_exp2f(total - cs[2 * tp + 1]);
#pragma unroll
                for (int j = 0; j < 8; ++j) {
                    const float xa = accA[j] * fsig(accA[j]) * dtA, xb_ = accB[j] * fsig(accB[j]) * dtB;
                    ((unsigned*)(xdT + (oc + j) * 136))[tp] = pg8::cvt_pk_bf16(xa, xb_);
                    ((unsigned*)(xdwT + (oc + j) * 136))[tp] = pg8::cvt_pk_bf16(xa * wA, xb_ * wB);
                }
            }
            LDS_BAR();
            {
                int l = 16 * ltile + fr; asm volatile("" : "+v"(l));
                const float csl = cs[l], el = __builtin_amdgcn_exp2f(csl), ddt = dsk * __builtin_amdgcn_rcpf(dts[l]);
                f32x4 y2[4], y3[4];
#pragma unroll
                for (int pt = 0; pt < 4; ++pt) { y2[pt] = (f32x4){0.f, 0.f, 0.f, 0.f}; y3[pt] = (f32x4){0.f, 0.f, 0.f, 0.f}; }
                const int whalf = __builtin_amdgcn_readfirstlane(ltile) >> 1;
#pragma unroll
                for (int ks = 0; ks < 4; ++ks) {
                  if (d ? (ks >= whalf) : (ks <= whalf)) {
                    const f32x4 c0 = *(const f32x4*)(cs + 32 * ks + 8 * q), c1 = *(const f32x4*)(cs + 32 * ks + 8 * q + 4);
                    float gv[8];
#pragma unroll
                    for (int j = 0; j < 8; ++j) {
                        const int sx = 32 * ks + 8 * q + j; const float cb = (j & 1) ? __uint_as_float(cbv[ks][j >> 1] & 0xffff0000u) : __uint_as_float(cbv[ks][j >> 1] << 16);
                        const float css = (j < 4) ? c0[j & 3] : c1[j & 3];
                        float val = cb * __builtin_amdgcn_exp2f(csl - css);
                        if (ks == whalf) {
                            const bool keep = d ? (sx >= l) : (sx <= l);
                            val = keep ? val : 0.f;
                            if (d == 0 && sx == l) val += ddt;
                        }
                        gv[j] = val;
                    }
                    union { u32x4 u; bf16x8 h; } gf; gf.u = (u32x4){pg8::cvt_pk_bf16(gv[0], gv[1]), pg8::cvt_pk_bf16(gv[2], gv[3]), pg8::cvt_pk_bf16(gv[4], gv[5]), pg8::cvt_pk_bf16(gv[6], gv[7])};
#pragma unroll
                    for (int pt = 0; pt < 4; ++pt) { const bf16x8 xf = *(const bf16x8*)(xdT + (16 * pt + fr) * 136 + 32 * ks + 8 * q); y2[pt] = __builtin_amdgcn_mfma_f32_16x16x32_bf16(xf, gf.h, y2[pt], 0, 0, 0); }
                  }
#pragma unroll
                    for (int pt = 0; pt < 4; ++pt) { const bf16x8 sf = *(const bf16x8*)(stb + (16 * pt + fr) * 136 + 32 * ks + 8 * q); y3[pt] = __builtin_amdgcn_mfma_f32_16x16x32_bf16(sf, cmf[ks], y3[pt], 0, 0, 0); }
                }
#pragma unroll
                for (int pt = 0; pt < 4; ++pt) {
                    const f32x4 v = y2[pt] + el * y3[pt]; u32x2 o; o.x = pg8::cvt_pk_bf16(v[0], v[1]); o.y = pg8::cvt_pk_bf16(v[2], v[3]);
                    *(u32x2*)(Y + (tok0 + l) * 2048 + hh * 64 + 16 * pt + 4 * q) = o;
                }
                const float etot = __builtin_amdgcn_exp2f(total);
#pragma unroll
                for (int pt = 0; pt < 4; ++pt) st[pt] *= etot;
#pragma unroll
                for (int ks = 0; ks < 4; ++ks) {
#pragma unroll
                    for (int pt = 0; pt < 4; ++pt) { const bf16x8 xf = *(const bf16x8*)(xdwT + (16 * pt + fr) * 136 + 32 * ks + 8 * q); st[pt] = __builtin_amdgcn_mfma_f32_16x16x32_bf16(btf[ks], xf, st[pt], 0, 0, 0); }
                }
            }
            SCAN_LOAD_C(cn);
            SCAN_XRAW_WRITE();
            SCAN_LOAD_A(cnn);
            LDS_BAR();
        }
#undef SCAN_LOAD_A
#undef SCAN_CH
#undef SCAN_XRAW_WRITE
#undef SCAN_LOAD_C
    }
}
__device__ __forceinline__ void ph_gn_scale(const Params& P) {
    bf16_t* proj = (bf16_t*)(P.ws + OFF_R);
    const int lane = threadIdx.x & 63, wid = threadIdx.x >> 6;
    for (int it = blockIdx.x * 8 + wid; it < T_TOK * 4; it += gridDim.x * 8) {
        const int row = it >> 2, grp = it & 3;
        bf16_t* ptr = proj + (size_t)row * LDP + grp * 512 + lane * 8;
        const u32x4 v = *(const u32x4*)ptr; float f[8]; float ss = 0.f;
#pragma unroll
        for (int j = 0; j < 4; ++j) { f[2 * j] = __uint_as_float(v[j] << 16); f[2 * j + 1] = __uint_as_float(v[j] & 0xffff0000u); ss += f[2 * j] * f[2 * j] + f[2 * j + 1] * f[2 * j + 1]; }
        ss = wave_sum(ss);
        const float rstd = rsqrtf(ss * (1.0f / 512.f) + EPS);
        const float* w = P.ssd_norm_w + grp * 512 + lane * 8; u32x4 o;
#pragma unroll
        for (int j = 0; j < 4; ++j) o[j] = pack2(f[2 * j] * rstd * w[2 * j], f[2 * j + 1] * rstd * w[2 * j + 1]);
        *(u32x4*)ptr = o;
    }
}
__device__ __forceinline__ void ph_ffn_conv(const Params& P, int layer, int half) {
    const bf16_t* hup = (const bf16_t*)(P.ws + OFF_R); bf16_t* gout = (bf16_t*)(P.ws + OFF_G);
    const float* cw = P.ffn_conv_w + (size_t)layer * 3 * 5632; const float* cb = P.ffn_conv_b + (size_t)layer * 5632;
    for (int it = blockIdx.x * NT + threadIdx.x; it < (T_TOK / 16) * (FH / 8); it += gridDim.x * NT) {
        const int oc = (it % (FH / 8)) * 8, t0 = (it / (FH / 8)) * 16, lt0 = t0 & (SEQ - 1);
        const int pn = oc >> 7, w = oc & 127, gcol = pn * 256 + w, vcol = gcol + 128;
        const int gch = half * FH + oc, vch = 2816 + gch;
        float wg[3][8], wv[3][8], bg[8], bv[8];
#pragma unroll
        for (int k = 0; k < 3; ++k) {
            const f32x4 a0 = *(const f32x4*)(cw + k * 5632 + gch), a1 = *(const f32x4*)(cw + k * 5632 + gch + 4), c0 = *(const f32x4*)(cw + k * 5632 + vch), c1 = *(const f32x4*)(cw + k * 5632 + vch + 4);
#pragma unroll
            for (int j = 0; j < 4; ++j) { wg[k][j] = a0[j]; wg[k][4 + j] = a1[j]; wv[k][j] = c0[j]; wv[k][4 + j] = c1[j]; }
        }
        { const f32x4 a0 = *(const f32x4*)(cb + gch), a1 = *(const f32x4*)(cb + gch + 4), c0 = *(const f32x4*)(cb + vch), c1 = *(const f32x4*)(cb + vch + 4);
#pragma unroll
          for (int j = 0; j < 4; ++j) { bg[j] = a0[j]; bg[4 + j] = a1[j]; bv[j] = c0[j]; bv[4 + j] = c1[j]; } }
        const bf16_t* base = hup + (size_t)t0 * 2816;
        float gp[8], vp[8], gc[8], vc[8];
        const u32x4 z4 = {0u, 0u, 0u, 0u};
        unpack8(lt0 > 0 ? *(const u32x4*)(base - 2816 + gcol) : z4, gp); unpack8(lt0 > 0 ? *(const u32x4*)(base - 2816 + vcol) : z4, vp);
        unpack8(*(const u32x4*)(base + gcol), gc); unpack8(*(const u32x4*)(base + vcol), vc);
#pragma unroll
        for (int i = 0; i < 16; ++i) {
            float gn[8], vn[8];
            const bool has = (lt0 + i + 1 < SEQ);
            unpack8(has ? *(const u32x4*)(base + (size_t)(i + 1) * 2816 + gcol) : z4, gn); unpack8(has ? *(const u32x4*)(base + (size_t)(i + 1) * 2816 + vcol) : z4, vn);
            u32x4 o;
#pragma unroll
            for (int j = 0; j < 4; ++j) {
                const float g0 = bg[2 * j] + wg[0][2 * j] * gp[2 * j] + wg[1][2 * j] * gc[2 * j] + wg[2][2 * j] * gn[2 * j];
                const float g1 = bg[2 * j + 1] + wg[0][2 * j + 1] * gp[2 * j + 1] + wg[1][2 * j + 1] * gc[2 * j + 1] + wg[2][2 * j + 1] * gn[2 * j + 1];
                const float v0 = bv[2 * j] + wv[0][2 * j] * vp[2 * j] + wv[1][2 * j] * vc[2 * j] + wv[2][2 * j] * vn[2 * j];
                const float v1 = bv[2 * j + 1] + wv[0][2 * j + 1] * vp[2 * j + 1] + wv[1][2 * j + 1] * vc[2 * j + 1] + wv[2][2 * j + 1] * vn[2 * j + 1];
                o[j] = pg8::cvt_pk_bf16(g0 * fsig(g0) * v0, g1 * fsig(g1) * v1);
            }
            *(u32x4*)(gout + (size_t)(t0 + i) * FH + oc) = o;
#pragma unroll
            for (int j = 0; j < 8; ++j) { gp[j] = gc[j]; vp[j] = vc[j]; gc[j] = gn[j]; vc[j] = vn[j]; }
        }
    }
}
__device__ __forceinline__ void ph_s5_naive(const Params& P) {
    const bf16_t* u = (const bf16_t*)(P.ws + OFF_ABUF); float* scr = (float*)(P.ws + OFF_R); bf16_t* gout = (bf16_t*)(P.ws + OFF_G);
    const int lane = threadIdx.x & 63, wid = threadIdx.x >> 6;
    for (int item = blockIdx.x + gridDim.x * wid; item < 256; item += gridDim.x * 8) {
        const int g = item & 63, b = item >> 6;
        for (int d = 0; d < 2; ++d) {
            const float lr = P.s5_a_re[(d * 64 + g) * 64 + lane], li = P.s5_a_im[(d * 64 + g) * 64 + lane];
            const float step = expf(P.s5_log_step[d * 64 + g]);
            const float mag = expf(lr * step), ang = li * step;
            const double angd = (double)ang, two_pi = 6.283185307179586476925;
            const float angr = (float)(angd - two_pi * rint(angd / two_pi));
            const float lbr = mag * cosf(angr), lbi = mag * sinf(angr);
            const float nr = lbr - 1.0f, den = lr * lr + li * li;
            const float qr = (nr * lr + lbi * li) / den, qi = (lbi * lr - nr * li) / den;
            float Br[16], Bi[16], Cr[16], Ci[16];
#pragma unroll
            for (int h = 0; h < 16; ++h) {
                const float br = P.s5_b_re[(g * 64 + lane) * 16 + h], bi = P.s5_b_im[(g * 64 + lane) * 16 + h];
                Br[h] = qr * br - qi * bi; Bi[h] = qr * bi + qi * br;
                Cr[h] = P.s5_c_re[((d * 64 + g) * 16 + h) * 64 + lane]; Ci[h] = P.s5_c_im[((d * 64 + g) * 16 + h) * 64 + lane];
            }
            float hr = 0.f, hi = 0.f;
            for (int s = 0; s < SEQ; ++s) {
                const int lt = d ? SEQ - 1 - s : s; const size_t tok = (size_t)b * SEQ + lt;
                const float uv = bf2f(u[tok * DM + g * 16 + (lane & 15)]);
                float dr = 0.f, di = 0.f;
#pragma unroll
                for (int h = 0; h < 16; ++h) { const float uh = __shfl(uv, h); dr += Br[h] * uh; di += Bi[h] * uh; }
                const float nhr = lbr * hr - lbi * hi + dr, nhi = lbr * hi + lbi * hr + di; hr = nhr; hi = nhi;
                float yv = 0.f;
#pragma unroll
                for (int h = 0; h < 16; ++h) { const float s1 = wave_sum(hr * Cr[h] - hi * Ci[h]); if ((lane & 15) == h) yv = s1; }
                if (lane < 16) {
                    if (d == 0) scr[tok * DM + g * 16 + lane] = yv;
                    else { const float y = scr[tok * DM + g * 16 + lane] + yv + P.s5_d[g * 16 + lane] * uv;
                           const float ge = 0.5f * y * (1.0f + tanhf(0.7978845608028654f * (y + 0.044715f * y * y * y)));
                           gout[tok * DM + g * 16 + lane] = f2bf(ge); }
                }
            }
        }
    }
}

constexpr size_t OFF_S5M = OFF_R + 96 * MiB;
__device__ __forceinline__ void s5_lambda(const Params& P, int d, int g, int p, float& lbr, float& lbi, float& qr, float& qi) {
    const float lr = P.s5_a_re[(d * 64 + g) * 64 + p], li = P.s5_a_im[(d * 64 + g) * 64 + p];
    const float step = expf(P.s5_log_step[d * 64 + g]);
    const float mag = expf(lr * step), ang = li * step;
    const double angd = (double)ang, two_pi = 6.283185307179586476925;
    const float angr = (float)(angd - two_pi * rint(angd / two_pi));
    lbr = mag * cosf(angr); lbi = mag * sinf(angr);
    const float nr = lbr - 1.0f, den = lr * lr + li * li;
    qr = (nr * lr + lbi * li) / den; qi = (lbi * lr - nr * li) / den;
}
__device__ __forceinline__ void ph_s5_setup(const Params& P, unsigned char* ldsraw) {
    float* pw = (float*)ldsraw;
    float* Bb = pw + 2 * 17 * 64 * 2;
    float* Cc = Bb + 2 * 64 * 16 * 2;
    float* Kt = Cc + 2 * 16 * 64 * 2;
    const int tid = threadIdx.x;
    for (int item = blockIdx.x; item < 256; item += gridDim.x) {
        const int g = item >> 2, part = item & 3;
        bf16_t* A1 = (bf16_t*)(P.ws + OFF_S5M) + (size_t)g * (65536 + 131072); bf16_t* A2 = A1 + 65536;
        __syncthreads();
        if (tid < 128) {
            const int d = tid >> 6, p = tid & 63; float lbr, lbi, qr, qi; s5_lambda(P, d, g, p, lbr, lbi, qr, qi);
            float pr = 1.f, pi = 0.f;
            for (int j = 0; j <= 16; ++j) { pw[((d * 17 + j) * 64 + p) * 2] = pr; pw[((d * 17 + j) * 64 + p) * 2 + 1] = pi; const float t = pr * lbr - pi * lbi; pi = pr * lbi + pi * lbr; pr = t; }
            for (int h = 0; h < 16; ++h) {
                const float br = P.s5_b_re[(g * 64 + p) * 16 + h], bi = P.s5_b_im[(g * 64 + p) * 16 + h];
                Bb[((d * 64 + p) * 16 + h) * 2] = qr * br - qi * bi; Bb[((d * 64 + p) * 16 + h) * 2 + 1] = qr * bi + qi * br;
                Cc[((d * 16 + h) * 64 + p) * 2] = P.s5_c_re[((d * 64 + g) * 16 + h) * 64 + p]; Cc[((d * 16 + h) * 64 + p) * 2 + 1] = P.s5_c_im[((d * 64 + g) * 16 + h) * 64 + p];
            }
        }
        __syncthreads();
        for (int i = tid; i < 16384; i += NT) {
            const int k = i & 255, R = 64 * part + (i >> 8), sx = k >> 4, hp = k & 15, d = R >> 7, ri = (R >> 6) & 1, p = R & 63;
            const int e = d ? sx : 15 - sx;
            const float pr = pw[((d * 17 + e) * 64 + p) * 2], pi = pw[((d * 17 + e) * 64 + p) * 2 + 1], br = Bb[((d * 64 + p) * 16 + hp) * 2], bi = Bb[((d * 64 + p) * 16 + hp) * 2 + 1];
            A1[(size_t)R * 256 + k] = f2bf(ri ? (pr * bi + pi * br) : (pr * br - pi * bi));
        }
        for (int i = tid; i < 2048; i += NT) {
            const int hp = i & 15, hl = (i >> 4) & 3, j = (i >> 6) & 15, d = i >> 10, h = 4 * part + hl;
            float acc = 0.f;
            for (int p = 0; p < 64; ++p) {
                const float pr = pw[((d * 17 + j) * 64 + p) * 2], pi = pw[((d * 17 + j) * 64 + p) * 2 + 1], br = Bb[((d * 64 + p) * 16 + hp) * 2], bi = Bb[((d * 64 + p) * 16 + hp) * 2 + 1];
                const float er = pr * br - pi * bi, ei = pr * bi + pi * br;
                acc += Cc[((d * 16 + h) * 64 + p) * 2] * er - Cc[((d * 16 + h) * 64 + p) * 2 + 1] * ei;
            }
            Kt[i] = acc;
        }
        __syncthreads();
        for (int i = tid; i < 16384; i += NT) {
            const int k = i & 255, rr = i >> 8, tau = rr >> 2, hl = rr & 3, h = 4 * part + hl, row = tau * 16 + h, sx = k >> 4, hp = k & 15;
            float v = 0.f;
            if (sx <= tau) v += Kt[(((tau - sx)) * 4 + hl) * 16 + hp];
            if (sx >= tau) v += Kt[((16 + sx - tau) * 4 + hl) * 16 + hp];
            if (sx == tau && hp == h) v += P.s5_d[g * 16 + h];
            A2[(size_t)row * 512 + k] = f2bf(v);
        }
        for (int i = tid; i < 16384; i += NT) {
            const int kk = i & 255, rr = i >> 8, tau = rr >> 2, h = 4 * part + (rr & 3), row = tau * 16 + h, d = kk >> 7, ri = (kk >> 6) & 1, p = kk & 63;
            const int e = d ? 16 - tau : tau + 1;
            const float pr = pw[((d * 17 + e) * 64 + p) * 2], pi = pw[((d * 17 + e) * 64 + p) * 2 + 1], cr = Cc[((d * 16 + h) * 64 + p) * 2], ci = Cc[((d * 16 + h) * 64 + p) * 2 + 1];
            A2[(size_t)row * 512 + 256 + kk] = f2bf(ri ? -(cr * pi + ci * pr) : (cr * pr - ci * pi));
        }
    }
}
__device__ __forceinline__ void ph_s5_main(const Params& P, unsigned char* ldsraw) {
    const bf16_t* u = (const bf16_t*)(P.ws + OFF_ABUF); float* scr = (float*)(P.ws + OFF_R); bf16_t* gout = (bf16_t*)(P.ws + OFF_G);
    bf16_t* Sc = (bf16_t*)ldsraw;
    float* tbuf = (float*)(ldsraw + 256 * 264 * 2);
    bf16_t* atile = (bf16_t*)(ldsraw + 256 * 264 * 2 + 8192);
    const int tid = threadIdx.x, lane = tid & 63, wid = tid >> 6, fr = lane & 15, q = lane >> 4;
    for (int item = blockIdx.x; item < 256; item += gridDim.x) {
        const int g = (item & 7) + 8 * (item >> 5), b = (item >> 3) & 3;
        const bf16_t* A1 = (const bf16_t*)(P.ws + OFF_S5M) + (size_t)g * (65536 + 131072); const bf16_t* A2 = A1 + 65536;
        float* sl = scr + (size_t)item * 65536;
        bf16x8 uf[2][8];
#pragma unroll
        for (int ct = 0; ct < 2; ++ct)
#pragma unroll
            for (int ks = 0; ks < 8; ++ks) {
                const int c = 32 * wid + 16 * ct + fr; const size_t tok = (size_t)b * SEQ + c * 16 + 2 * ks + (q >> 1);
                uf[ct][ks] = *(const bf16x8*)(u + tok * DM + g * 16 + 8 * (q & 1));
            }
        {
            const int srow = tid >> 5, spc = (tid & 31) * 8;
            *(u32x4*)(atile + srow * 264 + spc) = *(const u32x4*)(A1 + (size_t)srow * 256 + spc);
            u32x4 r0, r1 = *(const u32x4*)(A1 + (size_t)(16 + srow) * 256 + spc), r2 = *(const u32x4*)(A1 + (size_t)(32 + srow) * 256 + spc), r3 = *(const u32x4*)(A1 + (size_t)(48 + srow) * 256 + spc);
            __syncthreads();
#define S5A_STEP(Rt, RL, RW) do { \
                RL = *(const u32x4*)(A1 + (size_t)((((Rt) + 4) & 15) * 16 + srow) * 256 + spc); \
                const bf16_t* at = atile + ((Rt) & 1) * (16 * 264) + fr * 264 + 8 * q; \
                f32x4 a0 = {0.f, 0.f, 0.f, 0.f}, a1 = {0.f, 0.f, 0.f, 0.f}; \
                _Pragma("unroll") for (int ks = 0; ks < 8; ++ks) { const bf16x8 af = *(const bf16x8*)(at + ks * 32); \
                    a0 = __builtin_amdgcn_mfma_f32_16x16x32_bf16(af, uf[0][ks], a0, 0, 0, 0); a1 = __builtin_amdgcn_mfma_f32_16x16x32_bf16(af, uf[1][ks], a1, 0, 0, 0); } \
                *(f32x4*)(sl + (size_t)(32 * wid + fr) * 256 + (Rt) * 16 + 4 * q) = a0; \
                *(f32x4*)(sl + (size_t)(32 * wid + 16 + fr) * 256 + (Rt) * 16 + 4 * q) = a1; \
                *(u32x4*)(atile + (((Rt) + 1) & 1) * (16 * 264) + srow * 264 + spc) = RW; \
                LDS_BAR(); } while (0)
            for (int R4 = 0; R4 < 16; R4 += 4) { S5A_STEP(R4, r0, r1); S5A_STEP(R4 + 1, r1, r2); S5A_STEP(R4 + 2, r2, r3); S5A_STEP(R4 + 3, r3, r0); }
#undef S5A_STEP
        }
        asm volatile("s_waitcnt vmcnt(0)" ::: "memory");
        __syncthreads();
        {
            float L0r, L0i, L1r, L1i, qr_, qi_;
            s5_lambda(P, 0, g, lane, L0r, L0i, qr_, qi_); s5_lambda(P, 1, g, lane, L1r, L1i, qr_, qi_);
#pragma unroll
            for (int i = 0; i < 4; ++i) { float t = L0r * L0r - L0i * L0i; L0i = 2.f * L0r * L0i; L0r = t; t = L1r * L1r - L1i * L1i; L1i = 2.f * L1r * L1i; L1r = t; }
            float h0r = 0.f, h0i = 0.f, h1r = 0.f, h1i = 0.f;
            for (int j0 = 0; j0 < 32; j0 += 8) {
                float x0r[8], x0i[8], x1r[8], x1i[8];
#pragma unroll
                for (int i = 0; i < 8; ++i) { const int j = 32 * wid + j0 + i, c0 = j, c1 = 255 - j;
                    x0r[i] = sl[(size_t)c0 * 256 + lane]; x0i[i] = sl[(size_t)c0 * 256 + 64 + lane]; x1r[i] = sl[(size_t)c1 * 256 + 128 + lane]; x1i[i] = sl[(size_t)c1 * 256 + 192 + lane]; }
#pragma unroll
                for (int i = 0; i < 8; ++i) { float t = L0r * h0r - L0i * h0i + x0r[i]; h0i = L0r * h0i + L0i * h0r + x0i[i]; h0r = t; t = L1r * h1r - L1i * h1i + x1r[i]; h1i = L1r * h1i + L1i * h1r + x1i[i]; h1r = t; }
            }
            *(f32x4*)(tbuf + ((wid * 64 + lane) * 4)) = (f32x4){h0r, h0i, h1r, h1i};
            __syncthreads();
            float P0r = L0r, P0i = L0i, P1r = L1r, P1i = L1i;
#pragma unroll
            for (int i = 0; i < 5; ++i) { float t = P0r * P0r - P0i * P0i; P0i = 2.f * P0r * P0i; P0r = t; t = P1r * P1r - P1i * P1i; P1i = 2.f * P1r * P1i; P1r = t; }
            h0r = 0.f; h0i = 0.f; h1r = 0.f; h1i = 0.f;
            for (int w2 = 0; w2 < wid; ++w2) { const f32x4 tv = *(const f32x4*)(tbuf + ((w2 * 64 + lane) * 4));
                float t = P0r * h0r - P0i * h0i + tv[0]; h0i = P0r * h0i + P0i * h0r + tv[1]; h0r = t; t = P1r * h1r - P1i * h1i + tv[2]; h1i = P1r * h1i + P1i * h1r + tv[3]; h1r = t; }
            for (int j0 = 0; j0 < 32; j0 += 8) {
                float x0r[8], x0i[8], x1r[8], x1i[8];
#pragma unroll
                for (int i = 0; i < 8; ++i) { const int j = 32 * wid + j0 + i, c0 = j, c1 = 255 - j;
                    x0r[i] = sl[(size_t)c0 * 256 + lane]; x0i[i] = sl[(size_t)c0 * 256 + 64 + lane]; x1r[i] = sl[(size_t)c1 * 256 + 128 + lane]; x1i[i] = sl[(size_t)c1 * 256 + 192 + lane]; }
#pragma unroll
                for (int i = 0; i < 8; ++i) { const int j = 32 * wid + j0 + i, c0 = j, c1 = 255 - j;
                    Sc[c0 * 264 + lane] = f2bf(h0r); Sc[c0 * 264 + 64 + lane] = f2bf(h0i); Sc[c1 * 264 + 128 + lane] = f2bf(h1r); Sc[c1 * 264 + 192 + lane] = f2bf(h1i);
                    float t = L0r * h0r - L0i * h0i + x0r[i]; h0i = L0r * h0i + L0i * h0r + x0i[i]; h0r = t; t = L1r * h1r - L1i * h1i + x1r[i]; h1i = L1r * h1i + L1i * h1r + x1i[i]; h1r = t; }
            }
        }
        __syncthreads();
        {
            const int srow = tid >> 5, spc = (tid & 31) * 8;
#define S5C_SRC(h) (A2 + (size_t)((((h) & 31) >> 1) * 16 + srow) * 512 + ((h) & 1) * 256 + spc)
            *(u32x4*)(atile + srow * 264 + spc) = *(const u32x4*)S5C_SRC(0);
            u32x4 r0, r1 = *(const u32x4*)S5C_SRC(1), r2 = *(const u32x4*)S5C_SRC(2), r3 = *(const u32x4*)S5C_SRC(3);
            __syncthreads();
            f32x4 a0 = {0.f, 0.f, 0.f, 0.f}, a1 = {0.f, 0.f, 0.f, 0.f};
#define S5C_STEP(hs, RL, RW) do { \
                RL = *(const u32x4*)S5C_SRC((hs) + 4); \
                const bf16_t* at = atile + ((hs) & 1) * (16 * 264) + fr * 264 + 8 * q; \
                if (((hs) & 1) == 0) { \
                    _Pragma("unroll") for (int ks = 0; ks < 8; ++ks) { const bf16x8 af = *(const bf16x8*)(at + ks * 32); \
                        a0 = __builtin_amdgcn_mfma_f32_16x16x32_bf16(af, uf[0][ks], a0, 0, 0, 0); a1 = __builtin_amdgcn_mfma_f32_16x16x32_bf16(af, uf[1][ks], a1, 0, 0, 0); } \
                } else { \
                    _Pragma("unroll") for (int ks = 0; ks < 8; ++ks) { const bf16x8 af = *(const bf16x8*)(at + ks * 32); \
                        const bf16x8 b0 = *(const bf16x8*)(Sc + (32 * wid + fr) * 264 + ks * 32 + 8 * q), b1 = *(const bf16x8*)(Sc + (32 * wid + 16 + fr) * 264 + ks * 32 + 8 * q); \
                        a0 = __builtin_amdgcn_mfma_f32_16x16x32_bf16(af, b0, a0, 0, 0, 0); a1 = __builtin_amdgcn_mfma_f32_16x16x32_bf16(af, b1, a1, 0, 0, 0); } \
                    const int ch = g * 16 + 4 * q, rt = (hs) >> 1; \
                    _Pragma("unroll") for (int ct = 0; ct < 2; ++ct) { \
                        const int c = 32 * wid + 16 * ct + fr; const size_t tok = (size_t)b * SEQ + c * 16 + rt; \
                        const f32x4 av = ct ? a1 : a0; float y[4]; \
                        _Pragma("unroll") for (int r = 0; r < 4; ++r) { const float yy = av[r]; y[r] = yy * fsig(1.5957691216057308f * (yy + 0.044715f * yy * yy * yy)); } \
                        u32x2 o; o.x = pg8::cvt_pk_bf16(y[0], y[1]); o.y = pg8::cvt_pk_bf16(y[2], y[3]); \
                        *(u32x2*)(gout + tok * DM + ch) = o; } \
                    a0 = (f32x4){0.f, 0.f, 0.f, 0.f}; a1 = (f32x4){0.f, 0.f, 0.f, 0.f}; \
                } \
                *(u32x4*)(atile + (((hs) + 1) & 1) * (16 * 264) + srow * 264 + spc) = RW; \
                LDS_BAR(); } while (0)
            for (int h4 = 0; h4 < 32; h4 += 4) { S5C_STEP(h4, r0, r1); S5C_STEP(h4 + 1, r1, r2); S5C_STEP(h4 + 2, r2, r3); S5C_STEP(h4 + 3, r3, r0); }
#undef S5C_STEP
#undef S5C_SRC
        }
        __syncthreads();
    }
}

#define XB_TMO      128
#define XB_XCNT(j)  (256  + 64 * (j))
#define XB_XSUB(j)  (1280 + 64 * (j))
#define XB_XGEN(j)  (2304 + 64 * (j))
#define XB_TOP      3328
#define XB_TOPGEN   3392
#define XCD_BAR_WORDS 3456
#define XB_SPIN_CAP (1u << 18)
constexpr size_t OFF_BAR = 255 * MiB;
constexpr int LDS_ST_OFF = (int)LDS_BYTES - 16;
__device__ __forceinline__ unsigned xb_ld(unsigned* p)              { return __hip_atomic_load(p, __ATOMIC_RELAXED, __HIP_MEMORY_SCOPE_AGENT); }
__device__ __forceinline__ unsigned xb_add(unsigned* p, unsigned v) { return __hip_atomic_fetch_add(p, v, __ATOMIC_RELAXED, __HIP_MEMORY_SCOPE_AGENT); }
__device__ __forceinline__ unsigned xb_xcc_id() { return (unsigned)__builtin_amdgcn_s_getreg((3 << 11) | 20) & 0xFu; }
#define XB_SPIN(cond, bar) do { unsigned _sp = 0; while (cond) { __builtin_amdgcn_s_sleep(1); \
    if ((++_sp & 255u) == 0u) { if (xb_ld(&(bar)[XB_TMO])) break; if (_sp > XB_SPIN_CAP) { atomicAdd(&(bar)[XB_TMO], 1u); break; } } } } while (0)
struct XcdBarrier { unsigned* bar; unsigned x; volatile PG8_LAS unsigned* st; };
__device__ __forceinline__ XcdBarrier xcd_barrier_post(unsigned* bar, volatile PG8_LAS unsigned* st) {
    XcdBarrier b; b.bar = bar; b.x = xb_xcc_id(); b.st = st;
    if (threadIdx.x == 0) (void)xb_add(&bar[XB_XCNT(b.x)], 1u);
    return b;
}
__device__ __forceinline__ void xcd_barrier_complete(unsigned* bar, unsigned x, unsigned& nloc, unsigned& nx) {
    const unsigned G = gridDim.x * gridDim.y * gridDim.z;
    unsigned sum, cnt, mine, sp = 0u;
    for (;;) {
        sum = 0u; cnt = 0u; mine = 0u;
#pragma unroll
        for (unsigned j = 0; j < 16; ++j) { const unsigned c = xb_ld(&bar[XB_XCNT(j)]); sum += c; cnt += (c > 0u) ? 1u : 0u; mine = (j == x) ? c : mine; }
        if (sum == G) break;
        __builtin_amdgcn_s_sleep(1);
        if ((++sp & 255u) == 0u) { if (xb_ld(&bar[XB_TMO])) break; if (sp > XB_SPIN_CAP) { atomicAdd(&bar[XB_TMO], 1u); break; } }
    }
    nloc = mine > 0u ? mine : 1u; nx = cnt > 0u ? cnt : 1u;
}
__device__ __forceinline__ void xcd_barrier(const XcdBarrier& b) {
    asm volatile("s_waitcnt vmcnt(0)" ::: "memory");
    __syncthreads();
    if (threadIdx.x == 0) {
        unsigned* bar = b.bar;
        __builtin_amdgcn_s_waitcnt(0);
        unsigned nloc = b.st[0], nx = b.st[1];
        if (nloc == 0u) { xcd_barrier_complete(bar, b.x, nloc, nx); b.st[0] = nloc; b.st[1] = nx; }
        const unsigned old = xb_add(&bar[XB_XSUB(b.x)], 1u);
        const unsigned gen = old / nloc;
        if (old + 1u == (gen + 1u) * nloc) {
            __builtin_amdgcn_fence(__ATOMIC_RELEASE, "agent");
            asm volatile("s_waitcnt vmcnt(0)" ::: "memory");
            const unsigned og = xb_add(&bar[XB_TOP], 1u);
            const unsigned tg = og / nx;
            if (og + 1u == (tg + 1u) * nx) xb_add(&bar[XB_TOPGEN], 1u);
            else XB_SPIN(xb_ld(&bar[XB_TOPGEN]) == tg, bar);
            __builtin_amdgcn_fence(__ATOMIC_ACQUIRE, "agent");
            xb_add(&bar[XB_XGEN(b.x)], 1u);
            asm volatile("s_waitcnt vmcnt(0)" ::: "memory");
        } else {
            XB_SPIN(xb_ld(&bar[XB_XGEN(b.x)]) == gen, bar);
            __builtin_amdgcn_fence(__ATOMIC_ACQUIRE, "agent");
            asm volatile("s_waitcnt vmcnt(0)" ::: "memory");
        }
    }
    __syncthreads();
}

constexpr int NPH = 32;
#define PH(k, body) if (lo <= (k) && (k) < hi) { { unsigned char* ws = P.ws; bf16_t* abuf = (bf16_t*)(ws + OFF_ABUF); bf16_t* proj = (bf16_t*)(ws + OFF_R); bf16_t* gbuf = (bf16_t*)(ws + OFF_G); bf16_t* hbuf = (bf16_t*)P.out; (void)abuf; (void)proj; (void)gbuf; (void)hbuf; body; } if ((k) + 1 < hi) xcd_barrier(xbar); }
#ifndef USE_NAIVE_GEMM
#define USE_NAIVE_GEMM 0
#endif
#define GEMM(A_, lda_, B_, ldb_, M_, N_, K_, EPI_, ...) { const GemmArgs g_ = mkgemm(A_, lda_, B_, ldb_, M_, N_, K_, EPI_, __VA_ARGS__); if (USE_NAIVE_GEMM) gemm_naive(g_, (float*)lds); else gemm_pg8<EPI_>((PG8_LAS unsigned char*)lds, g_); }
#define W_UPL ((bf16_t*)(ws + (layer ? W_UP1 : W_UP0)))
#define W_DNL ((bf16_t*)(ws + (layer ? W_DN1 : W_DN0)))
#define W_GTL ((bf16_t*)(ws + (layer ? W_GT1 : W_GT0)))
#define W_PPL ((bf16_t*)(ws + (layer ? W_PP1 : W_PP0)))
#define PPBUF ((bf16_t*)(ws + OFF_R))
#define PBF ((bf16_t*)(ws + OFF_R + 64 * MiB))
__device__ __forceinline__ void ffn_section(const Params& P, const int layer, const int base, const int lo, const int hi, const XcdBarrier& xbar, unsigned char* lds) {
    PH(base + 0, { if (layer == 0) ph_s5_setup(P, lds); ph_norm16(hbuf, P.ffn_norm_w + layer * DM, abuf, nullptr); })
    PH(base + 1, GEMM(abuf, DM, W_UPL, DM, T_TOK, 2816, DM, EPI_BF16, proj, 2816))
    PH(base + 2, ph_ffn_conv(P, layer, 0))
    PH(base + 3, GEMM(abuf, DM, W_UPL + (size_t)2816 * DM, DM, T_TOK, 2816, DM, EPI_BF16, proj, 2816))
    PH(base + 4, GEMM(gbuf, FH, W_DNL, 2816, T_TOK, DM, FH, EPI_RES16, hbuf, DM, (const float*)hbuf))
    PH(base + 5, ph_ffn_conv(P, layer, 1))
    PH(base + 6, GEMM(gbuf, FH, W_DNL + FH, 2816, T_TOK, DM, FH, EPI_RES16, hbuf, DM, (const float*)hbuf))
    PH(base + 7, { ph_norm16(hbuf, P.ple_norm_w + layer * DM, abuf, nullptr); ph_cvt_copy(P.p + (size_t)layer * T_TOK * 256, PBF, (size_t)T_TOK * 256); })
    PH(base + 8, { GEMM(PBF, 256, W_PPL, 256, T_TOK, DM, 256, EPI_BF16, PPBUF, DM) GEMM(abuf, DM, W_GTL, DM, T_TOK, DM, DM, EPI_PLE16, (layer ? gbuf : hbuf), DM, (const float*)hbuf, (const float*)PPBUF) })
}

__global__ void __launch_bounds__(NT, 2) mega(Params P) {
    extern __shared__ __attribute__((aligned(16))) unsigned char lds[];
    cg::grid_group grid = cg::this_grid();
    const int lo = P.ph_lo, hi = P.ph_hi;
    if (lo < 0) grid.sync();
    volatile PG8_LAS unsigned* xst = (volatile PG8_LAS unsigned*)((PG8_LAS unsigned char*)lds + LDS_ST_OFF);
    if (threadIdx.x < 4) xst[threadIdx.x] = 0u;
    __syncthreads();
    const XcdBarrier xbar = xcd_barrier_post((unsigned*)(P.ws + OFF_BAR), xst);
    PH(0, { cvt_weights0(P, (float*)lds); ph_norm(P.x, P.mix_norm_w, abuf, nullptr); })
    PH(1, GEMM(abuf, DM, (bf16_t*)(ws + W_IN) + (size_t)2048 * DM, DM, T_TOK, LDP, DM, EPI_BF16, proj, LDP))
    PH(2, ph_ssd_halo(P))
    PH(3, ph_ssd_bcconv(P, lds))
    PH(4, ph_ssd_scan(P, lds))
    PH(5, GEMM(abuf, DM, (bf16_t*)(ws + W_IN), DM, T_TOK, 2048, DM, EPI_ZGATE, proj, LDP, nullptr, nullptr, (const bf16_t*)(ws + OFF_YF), (const bf16_t*)P.out))
    PH(6, { ph_gn_scale(P); cvt_weights1(P, (float*)lds); })
    PH(7, GEMM(proj, LDP, (bf16_t*)(ws + W_OUT), 2048, T_TOK, DM, 2048, EPI_RESX, hbuf, DM, P.x))
    ffn_section(P, 0, 8, lo, hi, xbar, lds);
    PH(18, ph_norm16(hbuf, P.mix_norm_w + DM, abuf, nullptr))
    PH(19, ph_s5_main(P, lds))
    PH(20, GEMM(gbuf, DM, (bf16_t*)(ws + W_GLU), DM, T_TOK, 2048, DM, EPI_GLU16, hbuf, DM, (const float*)hbuf, nullptr, nullptr, nullptr, P.s5_b_glu))
    ffn_section(P, 1, 21, lo, hi, xbar, lds);
    PH(31, ph_norm16(gbuf, P.final_norm_w, nullptr, P.out))
}

extern "C" void kernel_launch(void* const* d_in, const int* in_sizes, int n_in, void* d_out, int out_size, void* d_ws, size_t ws_size, hipStream_t stream) {
    static int grid_blocks = 0;
    if (!grid_blocks) {
        int dev = 0, cus = 0, per_cu = 0;
        hipGetDevice(&dev);
        hipDeviceGetAttribute(&cus, hipDeviceAttributeMultiprocessorCount, dev);
        hipFuncSetAttribute((const void*)mega, hipFuncAttributeMaxDynamicSharedMemorySize, (int)LDS_BYTES);
        hipOccupancyMaxActiveBlocksPerMultiprocessor(&per_cu, (const void*)mega, NT, LDS_BYTES);
        if (per_cu < 1) per_cu = 1;
        grid_blocks = cus * per_cu;
        if (ws_size < 256 * MiB) fprintf(stderr, "workspace too small: %zu\n", ws_size);
    }
    Params P{};
    const float** pp = (const float**)&P;
    for (int i = 0; i < 30; ++i) pp[i] = (const float*)d_in[i];
    P.out = (float*)d_out; P.ws = (unsigned char*)d_ws;
#if COOP
    (void)hipMemsetAsync((unsigned char*)d_ws + OFF_BAR, 0, XCD_BAR_WORDS * 4, stream);
    P.ph_lo = 0; P.ph_hi = NPH;
    void* args[] = {&P};
    hipError_t e = hipLaunchCooperativeKernel((const void*)mega, dim3(grid_blocks), dim3(NT), args, LDS_BYTES, stream);
    if (e != hipSuccess) fprintf(stderr, "cooperative launch failed: %s (grid %d)\n", hipGetErrorString(e), grid_blocks);
#else
    for (int ph = 0; ph < NPH; ++ph) {
        P.ph_lo = ph; P.ph_hi = ph + 1;
        hipLaunchKernelGGL(mega, dim3(grid_blocks), dim3(NT), LDS_BYTES, stream, P);
    }
#endif
}
```

```cpp
#include <hip/hip_runtime.h>
#include <hip/hip_cooperative_groups.h>
#include <cstdio>
namespace cg = cooperative_groups;

#ifndef COOP
#define COOP 1
#endif

typedef unsigned short bf16_t;
typedef float f32x4 __attribute__((ext_vector_type(4)));
typedef unsigned u32x4 __attribute__((ext_vector_type(4)));
typedef unsigned u32x2 __attribute__((ext_vector_type(2)));

constexpr int NT = 512;
constexpr int T_TOK = 16384, DM = 1024, SEQ = 4096, NB = 4;
constexpr int LDP = 3328;
constexpr int FH = 1408;
constexpr float EPS = 1e-6f;
constexpr size_t MiB = 1u << 20;
constexpr size_t OFF_W0 = 0;
constexpr size_t W_IN = OFF_W0, W_OUT = W_IN + (size_t)5376 * 1024 * 2, W_UP0 = W_OUT + 4 * MiB, W_DN0 = W_UP0 + 11 * MiB, W_GT0 = W_DN0 + (size_t)1024 * 2816 * 2, W_PP0 = W_GT0 + 2 * MiB;
constexpr size_t OFF_ABUF = 34 * MiB;
constexpr size_t OFF_R = 66 * MiB;
constexpr size_t OFF_G = 186 * MiB;
constexpr size_t OFF_W1 = 230 * MiB;
constexpr size_t W_GLU = OFF_W1, W_UP1 = W_GLU + 4 * MiB, W_DN1 = W_UP1 + 11 * MiB, W_GT1 = W_DN1 + (size_t)1024 * 2816 * 2, W_PP1 = W_GT1 + 2 * MiB;
constexpr size_t OFF_YF = 186 * MiB;
constexpr size_t OFF_SMALL = 253 * MiB;
constexpr size_t LDS_BYTES = 160 * 1024;

struct Params {
    const float *x, *p, *ssd_w_in, *ssd_conv_w, *ssd_conv_b, *ssd_dt_bias, *ssd_a_log, *ssd_d, *ssd_norm_w, *ssd_w_out;
    const float *s5_a_re, *s5_a_im, *s5_log_step, *s5_b_re, *s5_b_im, *s5_c_re, *s5_c_im, *s5_d, *s5_w_glu, *s5_b_glu;
    const float *mix_norm_w, *ffn_norm_w, *ffn_w_up, *ffn_conv_w, *ffn_conv_b, *ffn_w_down, *ple_norm_w, *ple_w_gate, *ple_w_proj, *final_norm_w;
    float* out; unsigned char* ws;
    int ph_lo, ph_hi;
};

__device__ __forceinline__ int otid() { int t = (int)__builtin_amdgcn_workitem_id_x(); asm volatile("" : "+v"(t)); return t & (NT - 1); }
__device__ __forceinline__ float bf2f(bf16_t b) { return __uint_as_float(((unsigned)b) << 16); }
__device__ __forceinline__ bf16_t f2bf(float f) { unsigned u = __float_as_uint(f); u += 0x7FFFu + ((u >> 16) & 1u); return (bf16_t)(u >> 16); }
__device__ __forceinline__ unsigned pack2(float lo, float hi) { return (unsigned)f2bf(lo) | ((unsigned)f2bf(hi) << 16); }
__device__ __forceinline__ float siluf(float v) { return v / (1.0f + __expf(-v)); }
__device__ __forceinline__ float sigmf(float v) { return 1.0f / (1.0f + __expf(-v)); }
__device__ __forceinline__ float wave_sum(float v) {
#pragma unroll
    for (int o = 32; o >= 1; o >>= 1) v += __shfl_xor(v, o);
    return v;
}

#define PG8_LAS __attribute__((address_space(3)))
typedef short bf16x8 __attribute__((ext_vector_type(8)));
namespace pg8 {
constexpr int BM = 256, BK = 64, HALF = 128, HTB = HALF * BK * 2, STAGE_BYTES = 8 * HTB, NXCD = 8, WGM = 8;
__device__ __forceinline__ int lds_byte(int r, int c) { const int st = (r >> 4) * 2 + (c >> 5), rr = r & 15, cc = c & 31, ob = rr * 64 + cc * 2; return st * 1024 + (ob ^ (((ob >> 9) & 1) << 5)); }
__device__ __forceinline__ void stage_rc(int b, int& R, int& C) { const int st = b / 1024, sb = b % 1024, swz = sb ^ (((sb >> 9) & 1) << 5); R = (st >> 1) * 16 + swz / 64; C = (st & 1) * 32 + (swz % 64) / 2; }
__device__ __forceinline__ int perm32(int rho) { const int n = rho >> 4, i = rho & 15; return 8 * (i >> 2) + 4 * n + (i & 3); }
struct Unit { int pm, pn; };
struct StaticOrder {
    int nM, nN, nwg, G, c;
    __device__ void init(int M, int N, int G_, int c_) { nM = M / BM; nN = N / BM; nwg = nM * nN; G = G_; c = c_; }
    __device__ bool next(int i, Unit& u) const {
        const long L = (long)i * G + c; if (L >= nwg) return false;
        int wgid = (int)L; { const int q = nwg / NXCD, r = nwg % NXCD, xcd = wgid % NXCD, off = wgid / NXCD; wgid = (xcd < r ? xcd * (q + 1) : r * (q + 1) + (xcd - r) * q) + off; }
        const int nig = WGM * nN, gid = wgid / nig, fm = gid * WGM, gsz = (nM - fm) < WGM ? (nM - fm) : WGM;
        u.pm = fm + ((wgid % nig) % gsz); u.pn = (wgid % nig) / gsz; return true;
    }
};
typedef __bf16 bf16x2_t __attribute__((ext_vector_type(2)));
typedef float f32x2_t __attribute__((ext_vector_type(2)));
__device__ __forceinline__ unsigned cvt_pk_bf16(float lo, float hi) { const f32x2_t v = {lo, hi}; union { bf16x2_t b; unsigned u; } r; r.b = __builtin_convertvector(v, bf16x2_t); return r.u; }
}
__device__ __forceinline__ float fsig(float v) { return __builtin_amdgcn_rcpf(1.0f + __expf(-v)); }
__device__ __forceinline__ void unpack8(const u32x4 v, float (&f)[8]) {
#pragma unroll
    for (int j = 0; j < 4; ++j) { f[2 * j] = __uint_as_float(v[j] << 16); f[2 * j + 1] = __uint_as_float(v[j] & 0xffff0000u); }
}
__device__ __forceinline__ f32x4 bf4lo(unsigned a, unsigned b) { return (f32x4){__uint_as_float(a << 16), __uint_as_float(a & 0xffff0000u), __uint_as_float(b << 16), __uint_as_float(b & 0xffff0000u)}; }

struct WDesc { const float* W; bf16_t* Wt; int K, Nsrc, Ndst, mode, H, ntiles; };
__device__ __forceinline__ void cvt_tile(const WDesc& d, int tile, float* lds) {
    const int tid = threadIdx.x, nnt = d.Ndst / 64;
    const int n0 = (tile % nnt) * 64, k0 = (tile / nnt) * 64;
    int src0;
    if (d.mode == 0) src0 = (n0 < d.Nsrc) ? n0 : -1;
    else { const int pn = n0 / 256, w = n0 % 256; src0 = (w < 128) ? pn * 128 + w : d.H + pn * 128 + (w - 128); }
    __syncthreads();
#pragma unroll
    for (int i = 0; i < 2; ++i) {
        const int r = (tid >> 4) + 32 * i, c4 = (tid & 15) * 4;
        f32x4 v = {0.f, 0.f, 0.f, 0.f};
        if (src0 >= 0) v = *(const f32x4*)(d.W + (size_t)(k0 + r) * d.Nsrc + src0 + c4);
#pragma unroll
        for (int j = 0; j < 4; ++j) lds[r * 65 + c4 + j] = v[j];
    }
    __syncthreads();
    {
        const int nr = tid >> 3, kp = (tid & 7) * 8;
        u32x4 o;
#pragma unroll
        for (int j = 0; j < 4; ++j) o[j] = pg8::cvt_pk_bf16(lds[(kp + 2 * j) * 65 + nr], lds[(kp + 2 * j + 1) * 65 + nr]);
        *(u32x4*)(d.Wt + (size_t)(n0 + nr) * d.K + k0 + kp) = o;
    }
}
__device__ __forceinline__ WDesc mkdesc(const float* W, bf16_t* Wt, int K, int Nsrc, int Ndst, int mode, int H) { WDesc d; d.W = W; d.Wt = Wt; d.K = K; d.Nsrc = Nsrc; d.Ndst = Ndst; d.mode = mode; d.H = H; d.ntiles = (K / 64) * (Ndst / 64); return d; }
#define CVT_ONE(W, Wt, K, Ns, Nd, mode, H) { const int n_ = ((K) / 64) * ((Nd) / 64); if (tt >= 0 && tt < n_) { const WDesc d_ = mkdesc(W, Wt, K, Ns, Nd, mode, H); cvt_tile(d_, tt, lds); } tt -= n_; }
__device__ __forceinline__ void cvt_weights0(const Params& P, float* lds) {
    unsigned char* ws = P.ws;
    for (int t = blockIdx.x; t < 1344 + 512 + 1408 + 704 + 256 + 64; t += gridDim.x) {
        int tt = t;
        CVT_ONE(P.ssd_w_in, (bf16_t*)(ws + W_IN), 1024, 5184, 5376, 0, 0)
        CVT_ONE(P.ssd_w_out, (bf16_t*)(ws + W_OUT), 2048, 1024, 1024, 0, 0)
        CVT_ONE(P.ffn_w_up, (bf16_t*)(ws + W_UP0), 1024, 5632, 5632, 1, 2816)
        CVT_ONE(P.ffn_w_down, (bf16_t*)(ws + W_DN0), 2816, 1024, 1024, 0, 0)
        CVT_ONE(P.ple_w_gate, (bf16_t*)(ws + W_GT0), 1024, 1024, 1024, 0, 0)
        CVT_ONE(P.ple_w_proj, (bf16_t*)(ws + W_PP0), 256, 1024, 1024, 0, 0)
    }
}
__device__ __forceinline__ void cvt_weights1(const Params& P, float* lds) {
    unsigned char* ws = P.ws;
    for (int t = blockIdx.x; t < 512 + 1408 + 704 + 256 + 64; t += gridDim.x) {
        int tt = t;
        CVT_ONE(P.s5_w_glu, (bf16_t*)(ws + W_GLU), 1024, 2048, 2048, 1, 1024)
        CVT_ONE(P.ffn_w_up + (size_t)1024 * 5632, (bf16_t*)(ws + W_UP1), 1024, 5632, 5632, 1, 2816)
        CVT_ONE(P.ffn_w_down + (size_t)2816 * 1024, (bf16_t*)(ws + W_DN1), 2816, 1024, 1024, 0, 0)
        CVT_ONE(P.ple_w_gate + (size_t)1024 * 1024, (bf16_t*)(ws + W_GT1), 1024, 1024, 1024, 0, 0)
        CVT_ONE(P.ple_w_proj + (size_t)256 * 1024, (bf16_t*)(ws + W_PP1), 256, 1024, 1024, 0, 0)
    }
}
__device__ __forceinline__ void ph_norm(const float* src, const float* w, bf16_t* dstb, float* dstf) {
    const int lane = threadIdx.x & 63, wid = threadIdx.x >> 6;
    for (int row = blockIdx.x * 8 + wid; row < T_TOK; row += gridDim.x * 8) {
        const float* s = src + (size_t)row * DM;
        f32x4 v[4]; float ss = 0.f;
#pragma unroll
        for (int i = 0; i < 4; ++i) { v[i] = *(const f32x4*)(s + lane * 4 + 256 * i); ss += v[i][0] * v[i][0] + v[i][1] * v[i][1] + v[i][2] * v[i][2] + v[i][3] * v[i][3]; }
        ss = wave_sum(ss);
        const float rstd = rsqrtf(ss * (1.0f / DM) + EPS);
#pragma unroll
        for (int i = 0; i < 4; ++i) {
            const f32x4 wv = *(const f32x4*)(w + lane * 4 + 256 * i);
            const f32x4 o = v[i] * rstd * wv;
            if (dstb) { u32x2 pk; pk.x = pack2(o[0], o[1]); pk.y = pack2(o[2], o[3]); *(u32x2*)(dstb + (size_t)row * DM + lane * 4 + 256 * i) = pk; }
            else *(f32x4*)(dstf + (size_t)row * DM + lane * 4 + 256 * i) = o;
        }
    }
}
__device__ __forceinline__ void ph_norm16(const bf16_t* src, const float* w, bf16_t* dstb, float* dstf) {
    const int lane = threadIdx.x & 63, wid = threadIdx.x >> 6;
    for (int row = blockIdx.x * 8 + wid; row < T_TOK; row += gridDim.x * 8) {
        const bf16_t* sp = src + (size_t)row * DM;
        float v[2][8]; float ss = 0.f;
#pragma unroll
        for (int i = 0; i < 2; ++i) { unpack8(*(const u32x4*)(sp + lane * 8 + 512 * i), v[i]);
#pragma unroll
            for (int j = 0; j < 8; ++j) ss += v[i][j] * v[i][j]; }
        ss = wave_sum(ss);
        const float rstd = rsqrtf(ss * (1.0f / DM) + EPS);
#pragma unroll
        for (int i = 0; i < 2; ++i) {
            const f32x4 w0 = *(const f32x4*)(w + lane * 8 + 512 * i), w1 = *(const f32x4*)(w + lane * 8 + 512 * i + 4);
            float o[8];
#pragma unroll
            for (int j = 0; j < 4; ++j) { o[j] = v[i][j] * rstd * w0[j]; o[4 + j] = v[i][4 + j] * rstd * w1[j]; }
            if (dstb) { u32x4 pk; pk.x = pg8::cvt_pk_bf16(o[0], o[1]); pk.y = pg8::cvt_pk_bf16(o[2], o[3]); pk.z = pg8::cvt_pk_bf16(o[4], o[5]); pk.w = pg8::cvt_pk_bf16(o[6], o[7]); *(u32x4*)(dstb + (size_t)row * DM + lane * 8 + 512 * i) = pk; }
            else { *(f32x4*)(dstf + (size_t)row * DM + lane * 8 + 512 * i) = (f32x4){o[0], o[1], o[2], o[3]}; *(f32x4*)(dstf + (size_t)row * DM + lane * 8 + 512 * i + 4) = (f32x4){o[4], o[5], o[6], o[7]}; }
        }
    }
}
__device__ __forceinline__ void ph_cvt_copy(const float* src, bf16_t* dst, size_t n) {
    for (size_t i = ((size_t)blockIdx.x * NT + threadIdx.x) * 4; i < n; i += (size_t)gridDim.x * NT * 4) {
        const f32x4 v = *(const f32x4*)(src + i); u32x2 pk; pk.x = pack2(v[0], v[1]); pk.y = pack2(v[2], v[3]); *(u32x2*)(dst + i) = pk;
    }
}

enum { EPI_BF16 = 0, EPI_RES = 1, EPI_F32 = 2, EPI_PLE = 3, EPI_GLU = 4, EPI_ZGATE = 5, EPI_RESX = 6, EPI_RES16 = 7, EPI_PLE16 = 8, EPI_GLU16 = 9 };
struct GemmArgs {
    const bf16_t* A; int lda; const bf16_t* Bt; int ldb; int M, N, K; int epi;
    void* out; int ldc; const float* res; const float* aux; const bf16_t* y1; const bf16_t* y2; const float* bias;
};
__device__ __forceinline__ void epi_store(const GemmArgs& g, int row, int pn, int tc, float acc, float accp) {
    const int col = pn * 256 + tc;
    switch (g.epi) {
        case EPI_BF16: ((bf16_t*)g.out)[(size_t)row * g.ldc + col] = f2bf(acc); break;
        case EPI_RES: { const size_t o = (size_t)row * g.ldc + col; ((float*)g.out)[o] = g.res[o] + acc; } break;
        case EPI_F32: ((float*)g.out)[(size_t)row * g.ldc + col] = acc; break;
        case EPI_PLE: { const size_t o = (size_t)row * g.ldc + col; ((float*)g.out)[o] = g.res[o] + g.aux[o] * sigmf(acc); } break;
        case EPI_GLU: { const int oc = pn * 128 + tc; const size_t o = (size_t)row * g.ldc + oc; ((float*)g.out)[o] = g.res[o] + (acc + g.bias[oc]) * sigmf(accp + g.bias[1024 + oc]); } break;
        case EPI_ZGATE: { const size_t yo = (size_t)row * 2048 + col; ((bf16_t*)g.out)[(size_t)row * g.ldc + col] = f2bf((bf2f(g.y1[yo]) + bf2f(g.y2[yo])) * siluf(acc)); } break;
    }
}
__device__ __forceinline__ void gemm_naive(const GemmArgs& g, float* lds) {
    float* As = lds;
    float* Bs = lds + 32 * 132;
    const int tid = threadIdx.x, ty = tid >> 4, tx = tid & 15;
    const int nM = g.M / 128, nN = g.N / 256;
    for (int tile = blockIdx.x; tile < nM * nN; tile += gridDim.x) {
        const int pm = tile % nM, pn = tile / nM;
        float acc[4][16];
#pragma unroll
        for (int i = 0; i < 4; ++i)
#pragma unroll
            for (int j = 0; j < 16; ++j) acc[i][j] = 0.f;
        for (int k0 = 0; k0 < g.K; k0 += 32) {
            __syncthreads();
            { const int r = tid >> 2, kk = (tid & 3) * 8;
              const u32x4 v = *(const u32x4*)(g.A + (size_t)(pm * 128 + r) * g.lda + k0 + kk);
#pragma unroll
              for (int j = 0; j < 4; ++j) { As[(kk + 2 * j) * 132 + r] = __uint_as_float(v[j] << 16); As[(kk + 2 * j + 1) * 132 + r] = __uint_as_float(v[j] & 0xffff0000u); } }
#pragma unroll
            for (int h = 0; h < 2; ++h) { const int r = (tid >> 2) + 128 * h, kk = (tid & 3) * 8;
              const u32x4 v = *(const u32x4*)(g.Bt + (size_t)(pn * 256 + r) * g.ldb + k0 + kk);
#pragma unroll
              for (int j = 0; j < 4; ++j) { Bs[(kk + 2 * j) * 260 + r] = __uint_as_float(v[j] << 16); Bs[(kk + 2 * j + 1) * 260 + r] = __uint_as_float(v[j] & 0xffff0000u); } }
            __syncthreads();
#pragma unroll 4
            for (int kk = 0; kk < 32; ++kk) {
                const f32x4 a = *(const f32x4*)(As + kk * 132 + ty * 4);
                const f32x4 b0 = *(const f32x4*)(Bs + kk * 260 + tx * 8), b1 = *(const f32x4*)(Bs + kk * 260 + tx * 8 + 4);
                const f32x4 b2 = *(const f32x4*)(Bs + kk * 260 + 128 + tx * 8), b3 = *(const f32x4*)(Bs + kk * 260 + 128 + tx * 8 + 4);
#pragma unroll
                for (int i = 0; i < 4; ++i)
#pragma unroll
                    for (int j = 0; j < 4; ++j) { acc[i][j] += a[i] * b0[j]; acc[i][4 + j] += a[i] * b1[j]; acc[i][8 + j] += a[i] * b2[j]; acc[i][12 + j] += a[i] * b3[j]; }
            }
        }
#pragma unroll
        for (int i = 0; i < 4; ++i) {
            const int row = pm * 128 + ty * 4 + i;
#pragma unroll
            for (int j = 0; j < 8; ++j) {
                if (g.epi == EPI_GLU) epi_store(g, row, pn, tx * 8 + j, acc[i][j], acc[i][8 + j]);
                else { epi_store(g, row, pn, tx * 8 + j, acc[i][j], 0.f); epi_store(g, row, pn, 128 + tx * 8 + j, acc[i][8 + j], 0.f); }
            }
        }
    }
}
__device__ __forceinline__ GemmArgs mkgemm(const bf16_t* A, int lda, const bf16_t* Bt, int ldb, int M, int N, int K, int epi, void* out, int ldc,
                                           const float* res = nullptr, const float* aux = nullptr, const bf16_t* y1 = nullptr, const bf16_t* y2 = nullptr, const float* bias = nullptr) {
    GemmArgs g; g.A = A; g.lda = lda; g.Bt = Bt; g.ldb = ldb; g.M = M; g.N = N; g.K = K; g.epi = epi; g.out = out; g.ldc = ldc; g.res = res; g.aux = aux; g.y1 = y1; g.y2 = y2; g.bias = bias; return g;
}

template <int EPI>
__device__ __forceinline__ void epi_tile(const GemmArgs& g, const f32x4 (&acc)[2][2][4][2], const pg8::Unit& u, int wr, int wc, int fr, int fq) {
    const int row0 = u.pm * 256 + wr * 64 + fr;
    if constexpr (EPI == EPI_RESX || EPI == EPI_RES16 || EPI == EPI_PLE16 || EPI == EPI_GLU16) {
        constexpr int NBJ = (EPI == EPI_GLU16) ? 1 : 2;
        const int col0 = (EPI == EPI_GLU16 ? u.pn * 128 : u.pn * 256) + wc * 32 + 8 * fq;
        f32x4 bv[2] = {{0.f, 0.f, 0.f, 0.f}, {0.f, 0.f, 0.f, 0.f}}, bg[2] = {{0.f, 0.f, 0.f, 0.f}, {0.f, 0.f, 0.f, 0.f}};
        if constexpr (EPI == EPI_GLU16) {
#pragma unroll
            for (int n = 0; n < 2; ++n) { bv[n] = *(const f32x4*)(g.bias + col0 + 4 * n); bg[n] = *(const f32x4*)(g.bias + 1024 + col0 + 4 * n); }
        }
#pragma unroll
        for (int ai = 0; ai < 2; ++ai)
#pragma unroll
            for (int m = 0; m < 4; ++m) {
                const int row = row0 + ai * 128 + m * 16;
#pragma unroll
                for (int bj = 0; bj < NBJ; ++bj) {
                    const size_t o = (size_t)row * g.ldc + col0 + bj * 128;
                    f32x4 r0, r1;
                    if constexpr (EPI == EPI_RESX) { r0 = *(const f32x4*)(g.res + o); r1 = *(const f32x4*)(g.res + o + 4); }
                    else { const u32x4 rr = *(const u32x4*)((const bf16_t*)g.res + o); r0 = bf4lo(rr[0], rr[1]); r1 = bf4lo(rr[2], rr[3]); }
                    f32x4 v0 = acc[ai][bj][m][0], v1 = acc[ai][bj][m][1];
                    if constexpr (EPI == EPI_PLE16) {
                        const u32x4 aa = *(const u32x4*)((const bf16_t*)g.aux + o); const f32x4 a0 = bf4lo(aa[0], aa[1]), a1 = bf4lo(aa[2], aa[3]);
#pragma unroll
                        for (int j = 0; j < 4; ++j) { v0[j] = a0[j] * fsig(v0[j]); v1[j] = a1[j] * fsig(v1[j]); }
                    }
                    if constexpr (EPI == EPI_GLU16) {
                        const f32x4 g0 = acc[ai][1][m][0] + bg[0], g1 = acc[ai][1][m][1] + bg[1];
                        v0 += bv[0]; v1 += bv[1];
#pragma unroll
                        for (int j = 0; j < 4; ++j) { v0[j] *= fsig(g0[j]); v1[j] *= fsig(g1[j]); }
                    }
                    v0 += r0; v1 += r1;
                    u32x4 w; w.x = pg8::cvt_pk_bf16(v0[0], v0[1]); w.y = pg8::cvt_pk_bf16(v0[2], v0[3]); w.z = pg8::cvt_pk_bf16(v1[0], v1[1]); w.w = pg8::cvt_pk_bf16(v1[2], v1[3]);
                    *(u32x4*)((bf16_t*)g.out + o) = w;
                }
                asm volatile("" ::: "memory");
            }
    } else if constexpr (EPI == EPI_BF16 || EPI == EPI_ZGATE) {
        const int col0 = u.pn * 256 + wc * 32 + 8 * fq;
#pragma unroll
        for (int ai = 0; ai < 2; ++ai)
#pragma unroll
            for (int m = 0; m < 4; ++m) {
                const int row = row0 + ai * 128 + m * 16;
#pragma unroll
                for (int bj = 0; bj < 2; ++bj) {
                    f32x4 v0 = acc[ai][bj][m][0], v1 = acc[ai][bj][m][1];
                    const int col = col0 + bj * 128;
                    if constexpr (EPI == EPI_ZGATE) {
                        const u32x4 a = *(const u32x4*)(g.y1 + (size_t)row * 2048 + col), b = *(const u32x4*)(g.y2 + (size_t)row * 2048 + col);
                        const f32x4 y0 = bf4lo(a[0], a[1]) + bf4lo(b[0], b[1]), y1v = bf4lo(a[2], a[3]) + bf4lo(b[2], b[3]);
#pragma unroll
                        for (int j = 0; j < 4; ++j) { v0[j] = y0[j] * v0[j] * fsig(v0[j]); v1[j] = y1v[j] * v1[j] * fsig(v1[j]); }
                    }
                    u32x4 w; w.x = pg8::cvt_pk_bf16(v0[0], v0[1]); w.y = pg8::cvt_pk_bf16(v0[2], v0[3]); w.z = pg8::cvt_pk_bf16(v1[0], v1[1]); w.w = pg8::cvt_pk_bf16(v1[2], v1[3]);
                    *(u32x4*)((bf16_t*)g.out + (size_t)row * g.ldc + col) = w;
                }
                if constexpr (EPI == EPI_ZGATE) asm volatile("" ::: "memory");
            }
    } else if constexpr (EPI == EPI_GLU) {
        const int col0 = u.pn * 128 + wc * 32 + 4 * fq;
        f32x4 bv[2], bg[2];
#pragma unroll
        for (int n = 0; n < 2; ++n) { bv[n] = *(const f32x4*)(g.bias + col0 + 16 * n); bg[n] = *(const f32x4*)(g.bias + 1024 + col0 + 16 * n); }
#pragma unroll
        for (int ai = 0; ai < 2; ++ai)
#pragma unroll
            for (int m = 0; m < 4; ++m) {
                const int row = row0 + ai * 128 + m * 16;
#pragma unroll
                for (int n = 0; n < 2; ++n) {
                    const size_t o = (size_t)row * g.ldc + col0 + 16 * n;
                    const f32x4 r = *(const f32x4*)(g.res + o), v = acc[ai][0][m][n] + bv[n], gt = acc[ai][1][m][n] + bg[n];
                    f32x4 ov;
#pragma unroll
                    for (int j = 0; j < 4; ++j) ov[j] = r[j] + v[j] * fsig(gt[j]);
                    *(f32x4*)((float*)g.out + o) = ov;
                }
                asm volatile("" ::: "memory");
            }
    } else {
        const int col0 = u.pn * 256 + wc * 32 + 4 * fq;
#pragma unroll
        for (int ai = 0; ai < 2; ++ai)
#pragma unroll
            for (int m = 0; m < 4; ++m) {
                const int row = row0 + ai * 128 + m * 16;
#pragma unroll
                for (int bj = 0; bj < 2; ++bj)
#pragma unroll
                    for (int n = 0; n < 2; ++n) {
                        const size_t o = (size_t)row * g.ldc + col0 + bj * 128 + n * 16;
                        f32x4 ov = acc[ai][bj][m][n];
                        if constexpr (EPI == EPI_RES) ov += *(const f32x4*)(g.res + o);
                        if constexpr (EPI == EPI_PLE) { const f32x4 r = *(const f32x4*)(g.res + o), a = *(const f32x4*)(g.aux + o);
#pragma unroll
                            for (int j = 0; j < 4; ++j) ov[j] = r[j] + a[j] * fsig(ov[j]); }
                        *(f32x4*)((float*)g.out + o) = ov;
                    }
                if constexpr (EPI != EPI_F32) asm volatile("" ::: "memory");
            }
    }
}

template <int EPI>
__device__ __forceinline__ void gemm_pg8(PG8_LAS unsigned char* lds, const GemmArgs g) {
    using namespace pg8;
    constexpr bool PERM = (EPI == EPI_BF16 || EPI == EPI_ZGATE || EPI == EPI_RESX || EPI == EPI_RES16 || EPI == EPI_PLE16 || EPI == EPI_GLU16);
    const int tid = otid(), wid = __builtin_amdgcn_readfirstlane(tid >> 6), lane = tid & 63, wr = wid >> 2, wc = wid & 3, fr = lane & 15, fq = lane >> 4;
    const int K = g.K, nt = K / BK;
    StaticOrder S; S.init(g.M, g.N, (int)gridDim.x, (int)blockIdx.x);
    unsigned voffA[2], voffB[2];
#pragma unroll
    for (int i = 0; i < 2; ++i) { int R, C; stage_rc(tid * 16 + i * 8192, R, C); const int Rb = PERM ? ((R & ~31) + perm32(R & 31)) : R;
        voffA[i] = (unsigned)(R * g.lda + C) * 2u; voffB[i] = (unsigned)(Rb * g.ldb + C) * 2u; }
    const size_t kstep = (size_t)(BK * 2);
    const size_t hstepA = (size_t)HALF * g.lda * 2, hstepB = (size_t)HALF * g.ldb * 2;
    const size_t tstepA = 2 * hstepA, tstepB = 2 * hstepB;
    const unsigned ldsw = (unsigned)wid * 1024u;
    const int aoff = lds_byte(wr * 64 + fr, fq * 8), boff = lds_byte(wc * 32 + fr, fq * 8);
#define PG8_SA(b, h) (((b) * 2 + (h)) * HTB)
#define PG8_SB(b, h) ((4 + (b) * 2 + (h)) * HTB)
#define PG8_STAGE(bufoff, gbase, voff) do { _Pragma("unroll") for (int _i = 0; _i < 2; ++_i) \
        __builtin_amdgcn_global_load_lds((const unsigned*)((const char*)(gbase) + (voff)[_i]), (PG8_LAS unsigned*)(lds + (bufoff) + ldsw + _i * 8192), 16, 0, 0); } while (0)
#define PG8_LDA(dst, b, h) do { _Pragma("unroll") for (int m = 0; m < 4; ++m) _Pragma("unroll") for (int k = 0; k < 2; ++k) dst[m][k] = *(const PG8_LAS bf16x8*)(lds + PG8_SA(b, h) + aoff + m * 2048 + k * 1024); } while (0)
#define PG8_LDB(dst, b, h) do { _Pragma("unroll") for (int n = 0; n < 2; ++n) _Pragma("unroll") for (int k = 0; k < 2; ++k) dst[n][k] = *(const PG8_LAS bf16x8*)(lds + PG8_SB(b, h) + boff + n * 2048 + k * 1024); } while (0)
#define PG8_MMA(ai, bj, At, Bt) do { __builtin_amdgcn_s_setprio(1); _Pragma("unroll") for (int m = 0; m < 4; ++m) _Pragma("unroll") for (int n = 0; n < 2; ++n) _Pragma("unroll") for (int k = 0; k < 2; ++k) \
        acc[ai][bj][m][n] = __builtin_amdgcn_mfma_f32_16x16x32_bf16(Bt[n][k], At[m][k], acc[ai][bj][m][n], 0, 0, 0); __builtin_amdgcn_s_setprio(0); } while (0)
#define PG8_WAIT_V(n) asm volatile("s_waitcnt vmcnt(" #n ")" ::: "memory")
#define PG8_WAIT_L(n) asm volatile("s_waitcnt lgkmcnt(" #n ")" ::: "memory")
#define PG8_BAR __builtin_amdgcn_s_barrier()
#define PG8_SCHED __builtin_amdgcn_sched_barrier(0)
    Unit cur, nxt; int ui = 0;
    if (!S.next(0, cur)) return;
    f32x4 acc[2][2][4][2];
#pragma unroll
    for (int a = 0; a < 2; ++a)
#pragma unroll
        for (int b = 0; b < 2; ++b)
#pragma unroll
            for (int m = 0; m < 4; ++m)
#pragma unroll
                for (int n = 0; n < 2; ++n) acc[a][b][m][n] = (f32x4){0.f, 0.f, 0.f, 0.f};
    bf16x8 At[4][2], B0[2][2], B1[2][2];
    const char* cA = (const char*)g.A + (size_t)cur.pm * tstepA; const char* cB = (const char*)g.Bt + (size_t)cur.pn * tstepB;
    PG8_STAGE(PG8_SB(0, 0), cB, voffB); PG8_STAGE(PG8_SA(0, 0), cA, voffA); PG8_STAGE(PG8_SB(0, 1), cB + hstepB, voffB); PG8_STAGE(PG8_SA(0, 1), cA + hstepA, voffA);
    if (wr == 1) PG8_BAR;
    PG8_WAIT_V(4); PG8_BAR;
    PG8_STAGE(PG8_SB(1, 0), cB + kstep, voffB); PG8_STAGE(PG8_SA(1, 0), cA + kstep, voffA); PG8_STAGE(PG8_SB(1, 1), cB + hstepB + kstep, voffB);
    PG8_WAIT_V(6); PG8_BAR;
    for (;;) {
        const bool has_next = S.next(ui + 1, nxt);
        const char* nA = has_next ? (const char*)g.A + (size_t)nxt.pm * tstepA : cA; const char* nB = has_next ? (const char*)g.Bt + (size_t)nxt.pn * tstepB : cB;
        for (int t = 0; t < nt; t += 2) {
            const bool last = (t == nt - 2);
            const char* a1 = cA + (size_t)(t + 1) * kstep;
            const char* a2 = last ? nA : cA + (size_t)(t + 2) * kstep; const char* b2 = last ? nB : cB + (size_t)(t + 2) * kstep;
            const char* a3 = a2 + kstep; const char* b3 = b2 + kstep;
            PG8_LDB(B0, 0, 0); PG8_SCHED; PG8_LDA(At, 0, 0); PG8_STAGE(PG8_SA(1, 1), a1 + hstepA, voffA);
            PG8_WAIT_L(8); PG8_BAR; PG8_WAIT_L(0); PG8_MMA(0, 0, At, B0); PG8_BAR; PG8_SCHED;
            PG8_LDB(B1, 0, 1); PG8_STAGE(PG8_SB(0, 0), b2, voffB);
            PG8_BAR; PG8_WAIT_L(0); PG8_MMA(0, 1, At, B1); PG8_BAR;
            PG8_LDA(At, 0, 1); PG8_STAGE(PG8_SA(0, 0), a2, voffA);
            PG8_BAR; PG8_WAIT_L(0); PG8_MMA(1, 0, At, B0); PG8_BAR; PG8_SCHED;
            PG8_STAGE(PG8_SB(0, 1), b2 + hstepB, voffB);
            PG8_WAIT_V(6); PG8_BAR; PG8_MMA(1, 1, At, B1); PG8_BAR;
            PG8_LDB(B0, 1, 0); PG8_SCHED; PG8_LDA(At, 1, 0); PG8_STAGE(PG8_SA(0, 1), a2 + hstepA, voffA);
            PG8_WAIT_L(8); PG8_BAR; PG8_WAIT_L(0); PG8_MMA(0, 0, At, B0); PG8_BAR; PG8_SCHED;
            PG8_LDB(B1, 1, 1); PG8_STAGE(PG8_SB(1, 0), b3, voffB);
            PG8_BAR; PG8_WAIT_L(0); PG8_MMA(0, 1, At, B1); PG8_BAR;
            PG8_LDA(At, 1, 1); PG8_STAGE(PG8_SA(1, 0), a3, voffA);
            PG8_BAR; PG8_WAIT_L(0); PG8_MMA(1, 0, At, B0); PG8_BAR; PG8_SCHED;
            PG8_STAGE(PG8_SB(1, 1), b3 + hstepB, voffB);
            PG8_WAIT_V(6); PG8_BAR; PG8_MMA(1, 1, At, B1); PG8_BAR;
        }
        epi_tile<EPI>(g, acc, cur, wr, wc, fr, fq);
        if (!has_next) break;
#pragma unroll
        for (int a = 0; a < 2; ++a)
#pragma unroll
            for (int b = 0; b < 2; ++b)
#pragma unroll
                for (int m = 0; m < 4; ++m)
#pragma unroll
                    for (int n = 0; n < 2; ++n) acc[a][b][m][n] = (f32x4){0.f, 0.f, 0.f, 0.f};
        cur = nxt; cA = nA; cB = nB; ++ui;
    }
    PG8_WAIT_V(0);
    if (wr == 0) PG8_BAR;
    PG8_BAR;
#undef PG8_SA
#undef PG8_SB
#undef PG8_STAGE
#undef PG8_LDA
#undef PG8_LDB
#undef PG8_MMA
#undef PG8_WAIT_V
#undef PG8_WAIT_L
#undef PG8_BAR
#undef PG8_SCHED
}

__device__ __forceinline__ void ph_ssd_halo(const Params& P) {
    bf16_t* proj = (bf16_t*)(P.ws + OFF_R); bf16_t* halo = (bf16_t*)(P.ws + OFF_SMALL);
    const int gt = blockIdx.x * NT + threadIdx.x, gs = gridDim.x * NT;
    for (int i = gt; i < 512 * 4 * 256; i += gs) {
        const int ch = i & 255, hr = (i >> 8) & 3, item = i >> 10;
        const int g = item & 3, c = (item >> 2) & 31, b = item >> 7;
        const int lt = c * 128 + (hr < 2 ? hr - 2 : 126 + hr);
        const int col = 2048 + (ch >> 7) * 512 + g * 128 + (ch & 127);
        bf16_t v = 0;
        if (lt >= 0 && lt < SEQ) v = proj[(size_t)(b * SEQ + lt) * LDP + col];
        halo[i] = v;
    }
    for (int i = gt; i < T_TOK * 64; i += gs) {
        const int j = i & 63, t = i >> 6;
        const float xr = bf2f(proj[(size_t)t * LDP + 3072 + j]) + P.ssd_dt_bias[j];
        const float sp = fmaxf(xr, 0.f) + log1pf(__expf(-fabsf(xr)));
        ((float*)(proj + (size_t)t * LDP + 3136))[j] = sp;
    }
}
constexpr size_t OFF_CB = OFF_R + 104 * MiB;
__device__ __forceinline__ void ph_ssd_bcconv(const Params& P, unsigned char* ldsraw) {
    bf16_t* proj = (bf16_t*)(P.ws + OFF_R); const bf16_t* halo = (const bf16_t*)(P.ws + OFF_SMALL); bf16_t* CBg = (bf16_t*)(P.ws + OFF_CB);
    bf16_t* tile = (bf16_t*)ldsraw;
    bf16_t* cv = tile + 132 * 256;
    const int tid = threadIdx.x, lane = tid & 63, wid = tid >> 6, fr = lane & 15, q = lane >> 4;
    for (int item = blockIdx.x; item < 512; item += gridDim.x) {
        const int g = item & 3, c = (item >> 2) & 31, b = item >> 7;
        const size_t r0 = (size_t)b * SEQ + c * 128;
        __syncthreads();
        for (int i = tid; i < 132 * 32; i += NT) {
            const int co = i & 31, r = i >> 5, ch = co * 8;
            const int col = 2048 + (ch >> 7) * 512 + g * 128 + (ch & 127);
            u32x4 v;
            if (r < 2) v = *(const u32x4*)(halo + (size_t)item * 1024 + r * 256 + ch);
            else if (r >= 130) v = *(const u32x4*)(halo + (size_t)item * 1024 + (r - 128) * 256 + ch);
            else v = *(const u32x4*)(proj + (r0 + r - 2) * LDP + col);
            *(u32x4*)(tile + r * 256 + ch) = v;
        }
        __syncthreads();
        for (int i = tid; i < 128 * 32; i += NT) {
            const int co = i & 31, r = i >> 5, ch = co * 8;
            const int col = 2048 + (ch >> 7) * 512 + g * 128 + (ch & 127);
            float acc[8];
            { const f32x4 b0 = *(const f32x4*)(P.ssd_conv_b + col), b1 = *(const f32x4*)(P.ssd_conv_b + col + 4);
#pragma unroll
              for (int j = 0; j < 4; ++j) { acc[j] = b0[j]; acc[4 + j] = b1[j]; } }
#pragma unroll
            for (int k = 0; k < 5; ++k) {
                float xv[8]; unpack8(*(const u32x4*)(tile + (r + k) * 256 + ch), xv);
                const f32x4 w0 = *(const f32x4*)(P.ssd_conv_w + k * 3072 + col), w1 = *(const f32x4*)(P.ssd_conv_w + k * 3072 + col + 4);
#pragma unroll
                for (int j = 0; j < 4; ++j) { acc[j] += xv[j] * w0[j]; acc[4 + j] += xv[4 + j] * w1[j]; }
            }
            u32x4 o;
#pragma unroll
            for (int j = 0; j < 4; ++j) o[j] = pg8::cvt_pk_bf16(acc[2 * j] * fsig(acc[2 * j]), acc[2 * j + 1] * fsig(acc[2 * j + 1]));
            *(u32x4*)(cv + r * 264 + ch) = o;
            if (ch >= 128) *(u32x4*)(proj + (r0 + r) * LDP + col) = o;
        }
        __syncthreads();
        for (int i = tid; i < 2048; i += NT) {
            const int n = i >> 4, to = (i & 15) * 8; u32x4 o;
#pragma unroll
            for (int j = 0; j < 4; ++j) o[j] = (unsigned)cv[(to + 2 * j) * 264 + n] | ((unsigned)cv[(to + 2 * j + 1) * 264 + n] << 16);
            *(u32x4*)(proj + (r0 + n) * LDP + 2048 + g * 128 + to) = o;
        }
        bf16x8 af[4];
#pragma unroll
        for (int ks = 0; ks < 4; ++ks) af[ks] = *(const bf16x8*)(cv + (16 * wid + fr) * 264 + 32 * ks + 8 * q);
        bf16_t* cbo = CBg + (size_t)item * 16384;
#pragma unroll
        for (int lt = 0; lt < 8; ++lt) {
            f32x4 acc = {0.f, 0.f, 0.f, 0.f};
#pragma unroll
            for (int ks = 0; ks < 4; ++ks) { const bf16x8 bfr = *(const bf16x8*)(cv + (16 * lt + fr) * 264 + 128 + 32 * ks + 8 * q); acc = __builtin_amdgcn_mfma_f32_16x16x32_bf16(af[ks], bfr, acc, 0, 0, 0); }
            u32x2 o; o.x = pg8::cvt_pk_bf16(acc[0], acc[1]); o.y = pg8::cvt_pk_bf16(acc[2], acc[3]);
            *(u32x2*)(cbo + (16 * lt + fr) * 128 + 16 * wid + 4 * q) = o;
        }
    }
}
__device__ __forceinline__ void ph_ssd_scan_naive(const Params& P, unsigned char* ldsraw) {
    const bf16_t* proj = (const bf16_t*)(P.ws + OFF_R);
    bf16_t* Bs = (bf16_t*)ldsraw;
    bf16_t* Cs = Bs + 64 * 128;
    float* xs = (float*)(Cs + 64 * 128);
    float* dts = xs + 64 * 64;
    const int tid = threadIdx.x, p = tid >> 3, ng = tid & 7;
    for (int item = blockIdx.x; item < 256; item += gridDim.x) {
        const int d = item & 1, hh = (item >> 1) & 31, b = item >> 6, g = hh >> 3;
        const float a = -__expf(P.ssd_a_log[d * 32 + hh]), dsk = P.ssd_d[hh];
        bf16_t* Y = d ? (bf16_t*)P.out : (bf16_t*)(P.ws + OFF_YF);
        float h[16];
#pragma unroll
        for (int j = 0; j < 16; ++j) h[j] = 0.f;
        for (int blk = 0; blk < SEQ / 64; ++blk) {
            __syncthreads();
            for (int i = tid; i < 64 * 128; i += NT) {
                const int n = i & 127, r = i >> 7; const int lt = d ? SEQ - 1 - (blk * 64 + r) : blk * 64 + r;
                const size_t ro = (size_t)(b * SEQ + lt) * LDP;
                Bs[i] = proj[(size_t)(b * SEQ + (lt & ~127) + n) * LDP + 2048 + g * 128 + (lt & 127)]; Cs[i] = proj[ro + 2560 + g * 128 + n];
            }
            for (int i = tid; i < 64 * 64; i += NT) {
                const int pp = i & 63, r = i >> 6; const int lt = d ? SEQ - 1 - (blk * 64 + r) : blk * 64 + r;
                const int col = hh * 64 + pp;
                float acc = P.ssd_conv_b[col];
#pragma unroll
                for (int k = 0; k < 5; ++k) { const int l2 = lt + k - 2; if (l2 >= 0 && l2 < SEQ) acc += bf2f(proj[(size_t)(b * SEQ + l2) * LDP + col]) * P.ssd_conv_w[k * 3072 + col]; }
                xs[i] = siluf(acc);
            }
            if (tid < 64) { const int lt = d ? SEQ - 1 - (blk * 64 + tid) : blk * 64 + tid; dts[tid] = ((const float*)(proj + (size_t)(b * SEQ + lt) * LDP + 3136))[d * 32 + hh]; }
            __syncthreads();
            for (int r = 0; r < 64; ++r) {
                const float dt = dts[r], xv = xs[r * 64 + p], dA = __expf(dt * a), dx = dt * xv;
                float part = 0.f;
#pragma unroll
                for (int j = 0; j < 16; ++j) { h[j] = h[j] * dA + dx * bf2f(Bs[r * 128 + ng * 16 + j]); part += bf2f(Cs[r * 128 + ng * 16 + j]) * h[j]; }
                part += __shfl_xor(part, 1); part += __shfl_xor(part, 2); part += __shfl_xor(part, 4);
                if (ng == 0) { const int lt = d ? SEQ - 1 - (blk * 64 + r) : blk * 64 + r; Y[(size_t)(b * SEQ + lt) * 2048 + hh * 64 + p] = f2bf(part + (d == 0 ? dsk * xv : 0.f)); }
            }
        }
    }
}
#define LDS_BAR() do { asm volatile("s_waitcnt lgkmcnt(0)" ::: "memory"); __builtin_amdgcn_s_barrier(); asm volatile("" ::: "memory"); } while (0)
__device__ __forceinline__ void ph_ssd_scan(const Params& P, unsigned char* ldsraw) {
    const bf16_t* proj = (const bf16_t*)(P.ws + OFF_R); const bf16_t* CBg = (const bf16_t*)(P.ws + OFF_CB);
    bf16_t* xdT = (bf16_t*)ldsraw;
    bf16_t* xdwT = xdT + 64 * 136;
    bf16_t* stb = xdwT + 64 * 136;
    bf16_t* xraw = stb + 64 * 136;
    float* cs = (float*)(xraw + 132 * 72);
    float* dts = cs + 128;
    float* tot = dts + 128;
    float* cwl = tot + 4;
    float* csA = cwl + 384;
    float* dtsA = csA + 32 * 128;
    float* totA = dtsA + 32 * 128;
    const int tid = threadIdx.x, lane = tid & 63, wid = tid >> 6, fr = lane & 15, q = lane >> 4;
    const int ltile = (wid < 4) ? wid : 11 - wid;
    for (int item = blockIdx.x; item < 256; item += gridDim.x) {
        const int d = item & 1, hh = (item >> 1) & 31, b = item >> 6, g = hh >> 3;
        const float a = -__expf(P.ssd_a_log[d * 32 + hh]), dsk = P.ssd_d[hh];
        bf16_t* Y = d ? (bf16_t*)P.out : (bf16_t*)(P.ws + OFF_YF);
        __syncthreads();
        for (int i = tid; i < 384; i += NT) cwl[i] = (i < 320) ? P.ssd_conv_w[(i >> 6) * 3072 + hh * 64 + (i & 63)] : P.ssd_conv_b[hh * 64 + i - 320];
        for (int k4 = 0; k4 < 4; ++k4) {
            const int cc = wid + 8 * k4; const size_t t0_ = (size_t)b * SEQ + cc * 128;
            const float dta = ((const float*)(proj + (t0_ + 2 * lane) * LDP + 3136))[d * 32 + hh], dtb = ((const float*)(proj + (t0_ + 2 * lane + 1) * LDP + 3136))[d * 32 + hh];
            const float ad0 = dta * a * 1.4426950408889634f, ad1 = dtb * a * 1.4426950408889634f, v = ad0 + ad1; float inc = v;
#pragma unroll
            for (int o = 1; o < 64; o <<= 1) { const float t = __shfl_up(inc, o); if (lane >= o) inc += t; }
            const float excl = inc - v, totl = __shfl(inc, 63);
            if (d == 0) { csA[cc * 128 + 2 * lane] = excl + ad0; csA[cc * 128 + 2 * lane + 1] = inc; } else { csA[cc * 128 + 2 * lane] = totl - excl; csA[cc * 128 + 2 * lane + 1] = totl - excl - ad0; }
            dtsA[cc * 128 + 2 * lane] = dta; dtsA[cc * 128 + 2 * lane + 1] = dtb; if (lane == 0) totA[cc] = totl;
        }
        f32x4 st[4];
#pragma unroll
        for (int pt = 0; pt < 4; ++pt) st[pt] = (f32x4){0.f, 0.f, 0.f, 0.f};
        u32x4 xp[3]; u32x4 cbv[4]; bf16x8 cmf[4], btf[4];
        const int whs = __builtin_amdgcn_readfirstlane(ltile) >> 1;
#pragma unroll
        for (int k0_ = 0; k0_ < 4; ++k0_) cbv[k0_] = (u32x4){0u, 0u, 0u, 0u};
#define SCAN_LOAD_A(cc) do { const size_t t0_ = (size_t)b * SEQ + (cc) * 128; \
            _Pragma("unroll") for (int e_ = 0; e_ < 3; ++e_) { const int i_ = tid + e_ * NT; const int r_ = i_ >> 3, pc_ = (i_ & 7) * 8; const int lt_ = (cc) * 128 + r_ - 2; \
                xp[e_] = (u32x4){0u, 0u, 0u, 0u}; if (i_ < 132 * 8 && lt_ >= 0 && lt_ < SEQ) xp[e_] = *(const u32x4*)(proj + ((size_t)b * SEQ + lt_) * LDP + hh * 64 + pc_); } } while (0)
#define SCAN_LOAD_C(cc) do { const size_t t0_ = (size_t)b * SEQ + (cc) * 128; const int l_ = 16 * ltile + fr, n_ = 16 * wid + fr; \
            const bf16_t* cbrow_ = CBg + (size_t)((b * 32 + (cc)) * 4 + g) * 16384 + l_ * 128 + 8 * q; const bf16_t* cmrow_ = proj + (t0_ + l_) * LDP + 2560 + g * 128 + 8 * q; \
            const bf16_t* btrow_ = proj + (t0_ + n_) * LDP + 2048 + g * 128 + 8 * q; \
            _Pragma("unroll") for (int ks_ = 0; ks_ < 4; ++ks_) { if (d ? (ks_ >= whs) : (ks_ <= whs)) cbv[ks_] = *(const u32x4*)(cbrow_ + 32 * ks_); cmf[ks_] = *(const bf16x8*)(cmrow_ + 32 * ks_); btf[ks_] = *(const bf16x8*)(btrow_ + 32 * ks_); } } while (0)
#define SCAN_CH(i_) (d ? 31 - ((i_) < 31 ? (i_) : 31) : ((i_) < 31 ? (i_) : 31))
#define SCAN_XRAW_WRITE() do { _Pragma("unroll") for (int e = 0; e < 3; ++e) { const int i = tid + e * NT; if (i < 132 * 8) *(u32x4*)(xraw + (i >> 3) * 72 + (i & 7) * 8) = xp[e]; } } while (0)
        { const int c0_ = SCAN_CH(0), c1_ = SCAN_CH(1); SCAN_LOAD_A(c0_); SCAN_LOAD_C(c0_); SCAN_XRAW_WRITE(); SCAN_LOAD_A(c1_); }
        __syncthreads();
        for (int ci = 0; ci < 32; ++ci) {
            const int c = d ? 31 - ci : ci; const size_t tok0 = (size_t)b * SEQ + c * 128;
            const int cn = SCAN_CH(ci + 1), cnn = SCAN_CH(ci + 2);
            const float* cs = csA + c * 128; const float* dts = dtsA + c * 128;
#pragma unroll
            for (int pt = 0; pt < 4; ++pt) { u32x2 o; o.x = pg8::cvt_pk_bf16(st[pt][0], st[pt][1]); o.y = pg8::cvt_pk_bf16(st[pt][2], st[pt][3]); *(u32x2*)(stb + (16 * pt + fr) * 136 + 16 * wid + 4 * q) = o; }
            const float total = totA[c];
            {
                const int tp = tid & 63, oc = (tid >> 6) * 8;
                float w5[5][8], accA[8], accB[8];
#pragma unroll
                for (int k = 0; k < 5; ++k) { const f32x4 w0 = *(const f32x4*)(cwl + k * 64 + oc), w1 = *(const f32x4*)(cwl + k * 64 + oc + 4);
#pragma unroll
                    for (int j = 0; j < 4; ++j) { w5[k][j] = w0[j]; w5[k][4 + j] = w1[j]; } }
                { const f32x4 b0 = *(const f32x4*)(cwl + 320 + oc), b1 = *(const f32x4*)(cwl + 320 + oc + 4);
#pragma unroll
                  for (int j = 0; j < 4; ++j) { accA[j] = b0[j]; accA[4 + j] = b1[j]; accB[j] = b0[j]; accB[4 + j] = b1[j]; } }
#pragma unroll
                for (int k = 0; k < 6; ++k) {
                    float xr[8]; unpack8(*(const u32x4*)(xraw + (2 * tp + k) * 72 + oc), xr);
#pragma unroll
                    for (int j = 0; j < 8; ++j) { if (k < 5) accA[j] += xr[j] * w5[k < 5 ? k : 0][j]; if (k > 0) accB[j] += xr[j] * w5[k > 0 ? k - 1 : 0][j]; }
                }
                const float dtA = dts[2 * tp], dtB = dts[2 * tp + 1], wA = __builtin_amdgcn_exp2f(total - cs[2 * tp]), wB = __builtin_amdgcn_exp2f(total - cs[2 * tp + 1]);
#pragma unroll
                for (int j = 0; j < 8; ++j) {
                    const float xa = accA[j] * fsig(accA[j]) * dtA, xb_ = accB[j] * fsig(accB[j]) * dtB;
                    ((unsigned*)(xdT + (oc + j) * 136))[tp] = pg8::cvt_pk_bf16(xa, xb_);
                    ((unsigned*)(xdwT + (oc + j) * 136))[tp] = pg8::cvt_pk_bf16(xa * wA, xb_ * wB);
                }
            }
            LDS_BAR();
            {
                int l = 16 * ltile + fr; asm volatile("" : "+v"(l));
                const float csl = cs[l], el = __builtin_amdgcn_exp2f(csl), ddt = dsk * __builtin_amdgcn_rcpf(dts[l]);
                f32x4 y2[4], y3[4];
#pragma unroll
                for (int pt = 0; pt < 4; ++pt) { y2[pt] = (f32x4){0.f, 0.f, 0.f, 0.f}; y3[pt] = (f32x4){0.f, 0.f, 0.f, 0.f}; }
                const int whalf = __builtin_amdgcn_readfirstlane(ltile) >> 1;
#pragma unroll
                for (int ks = 0; ks < 4; ++ks) {
                  if (d ? (ks >= whalf) : (ks <= whalf)) {
                    const f32x4 c0 = *(const f32x4*)(cs + 32 * ks + 8 * q), c1 = *(const f32x4*)(cs + 32 * ks + 8 * q + 4);
                    float gv[8];
#pragma unroll
                    for (int j = 0; j < 8; ++j) {
                        const int sx = 32 * ks + 8 * q + j; const float cb = (j & 1) ? __uint_as_float(cbv[ks][j >> 1] & 0xffff0000u) : __uint_as_float(cbv[ks][j >> 1] << 16);
                        const float css = (j < 4) ? c0[j & 3] : c1[j & 3];
                        float val = cb * __builtin_amdgcn_exp2f(csl - css);
                        if (ks == whalf) {
                            const bool keep = d ? (sx >= l) : (sx <= l);
                            val = keep ? val : 0.f;
                            if (d == 0 && sx == l) val += ddt;
                        }
                        gv[j] = val;
                    }
                    union { u32x4 u; bf16x8 h; } gf; gf.u = (u32x4){pg8::cvt_pk_bf16(gv[0], gv[1]), pg8::cvt_pk_bf16(gv[2], gv[3]), pg8::cvt_pk_bf16(gv[4], gv[5]), pg8::cvt_pk_bf16(gv[6], gv[7])};
#pragma unroll
                    for (int pt = 0; pt < 4; ++pt) { const bf16x8 xf = *(const bf16x8*)(xdT + (16 * pt + fr) * 136 + 32 * ks + 8 * q); y2[pt] = __builtin_amdgcn_mfma_f32_16x16x32_bf16(xf, gf.h, y2[pt], 0, 0, 0); }
                  }
#pragma unroll
                    for (int pt = 0; pt < 4; ++pt) { const bf16x8 sf = *(const bf16x8*)(stb + (16 * pt + fr) * 136 + 32 * ks + 8 * q); y3[pt] = __builtin_amdgcn_mfma_f32_16x16x32_bf16(sf, cmf[ks], y3[pt], 0, 0, 0); }
                }
#pragma unroll
                for (int pt = 0; pt < 4; ++pt) {
                    const f32x4 v = y2[pt] + el * y3[pt]; u32x2 o; o.x = pg8::cvt_pk_bf16(v[0], v[1]); o.y = pg8::cvt_pk_bf16(v[2], v[3]);
                    *(u32x2*)(Y + (tok0 + l) * 2048 + hh * 64 + 16 * pt + 4 * q) = o;
                }
                const float etot = __builtin_amdgcn_exp2f(total);
#pragma unroll
                for (int pt = 0; pt < 4; ++pt) st[pt] *= etot;
#pragma unroll
                for (int ks = 0; ks < 4; ++ks) {
#pragma unroll
                    for (int pt = 0; pt < 4; ++pt) { const bf16x8 xf = *(const bf16x8*)(xdwT + (16 * pt + fr) * 136 + 32 * ks + 8 * q); st[pt] = __builtin_amdgcn_mfma_f32_16x16x32_bf16(btf[ks], xf, st[pt], 0, 0, 0); }
                }
            }
            SCAN_LOAD_C(cn);
            SCAN_XRAW_WRITE();
            SCAN_LOAD_A(cnn);
            LDS_BAR();
        }
#undef SCAN_LOAD_A
#undef SCAN_CH
#undef SCAN_XRAW_WRITE
#undef SCAN_LOAD_C
    }
}
__device__ __forceinline__ void ph_gn_scale(const Params& P) {
    bf16_t* proj = (bf16_t*)(P.ws + OFF_R);
    const int lane = threadIdx.x & 63, wid = threadIdx.x >> 6;
    for (int it = blockIdx.x * 8 + wid; it < T_TOK * 4; it += gridDim.x * 8) {
        const int row = it >> 2, grp = it & 3;
        bf16_t* ptr = proj + (size_t)row * LDP + grp * 512 + lane * 8;
        const u32x4 v = *(const u32x4*)ptr; float f[8]; float ss = 0.f;
#pragma unroll
        for (int j = 0; j < 4; ++j) { f[2 * j] = __uint_as_float(v[j] << 16); f[2 * j + 1] = __uint_as_float(v[j] & 0xffff0000u); ss += f[2 * j] * f[2 * j] + f[2 * j + 1] * f[2 * j + 1]; }
        ss = wave_sum(ss);
        const float rstd = rsqrtf(ss * (1.0f / 512.f) + EPS);
        const float* w = P.ssd_norm_w + grp * 512 + lane * 8; u32x4 o;
#pragma unroll
        for (int j = 0; j < 4; ++j) o[j] = pack2(f[2 * j] * rstd * w[2 * j], f[2 * j + 1] * rstd * w[2 * j + 1]);
        *(u32x4*)ptr = o;
    }
}
__device__ __forceinline__ void ph_ffn_conv(const Params& P, int layer, int half) {
    const bf16_t* hup = (const bf16_t*)(P.ws + OFF_R); bf16_t* gout = (bf16_t*)(P.ws + OFF_G);
    const float* cw = P.ffn_conv_w + (size_t)layer * 3 * 5632; const float* cb = P.ffn_conv_b + (size_t)layer * 5632;
    for (int it = blockIdx.x * NT + threadIdx.x; it < (T_TOK / 16) * (FH / 8); it += gridDim.x * NT) {
        const int oc = (it % (FH / 8)) * 8, t0 = (it / (FH / 8)) * 16, lt0 = t0 & (SEQ - 1);
        const int pn = oc >> 7, w = oc & 127, gcol = pn * 256 + w, vcol = gcol + 128;
        const int gch = half * FH + oc, vch = 2816 + gch;
        float wg[3][8], wv[3][8], bg[8], bv[8];
#pragma unroll
        for (int k = 0; k < 3; ++k) {
            const f32x4 a0 = *(const f32x4*)(cw + k * 5632 + gch), a1 = *(const f32x4*)(cw + k * 5632 + gch + 4), c0 = *(const f32x4*)(cw + k * 5632 + vch), c1 = *(const f32x4*)(cw + k * 5632 + vch + 4);
#pragma unroll
            for (int j = 0; j < 4; ++j) { wg[k][j] = a0[j]; wg[k][4 + j] = a1[j]; wv[k][j] = c0[j]; wv[k][4 + j] = c1[j]; }
        }
        { const f32x4 a0 = *(const f32x4*)(cb + gch), a1 = *(const f32x4*)(cb + gch + 4), c0 = *(const f32x4*)(cb + vch), c1 = *(const f32x4*)(cb + vch + 4);
#pragma unroll
          for (int j = 0; j < 4; ++j) { bg[j] = a0[j]; bg[4 + j] = a1[j]; bv[j] = c0[j]; bv[4 + j] = c1[j]; } }
        const bf16_t* base = hup + (size_t)t0 * 2816;
        float gp[8], vp[8], gc[8], vc[8];
        const u32x4 z4 = {0u, 0u, 0u, 0u};
        unpack8(lt0 > 0 ? *(const u32x4*)(base - 2816 + gcol) : z4, gp); unpack8(lt0 > 0 ? *(const u32x4*)(base - 2816 + vcol) : z4, vp);
        unpack8(*(const u32x4*)(base + gcol), gc); unpack8(*(const u32x4*)(base + vcol), vc);
#pragma unroll
        for (int i = 0; i < 16; ++i) {
            float gn[8], vn[8];
            const bool has = (lt0 + i + 1 < SEQ);
            unpack8(has ? *(const u32x4*)(base + (size_t)(i + 1) * 2816 + gcol) : z4, gn); unpack8(has ? *(const u32x4*)(base + (size_t)(i + 1) * 2816 + vcol) : z4, vn);
            u32x4 o;
#pragma unroll
            for (int j = 0; j < 4; ++j) {
                const float g0 = bg[2 * j] + wg[0][2 * j] * gp[2 * j] + wg[1][2 * j] * gc[2 * j] + wg[2][2 * j] * gn[2 * j];
                const float g1 = bg[2 * j + 1] + wg[0][2 * j + 1] * gp[2 * j + 1] + wg[1][2 * j + 1] * gc[2 * j + 1] + wg[2][2 * j + 1] * gn[2 * j + 1];
                const float v0 = bv[2 * j] + wv[0][2 * j] * vp[2 * j] + wv[1][2 * j] * vc[2 * j] + wv[2][2 * j] * vn[2 * j];
                const float v1 = bv[2 * j + 1] + wv[0][2 * j + 1] * vp[2 * j + 1] + wv[1][2 * j + 1] * vc[2 * j + 1] + wv[2][2 * j + 1] * vn[2 * j + 1];
                o[j] = pg8::cvt_pk_bf16(g0 * fsig(g0) * v0, g1 * fsig(g1) * v1);
            }
            *(u32x4*)(gout + (size_t)(t0 + i) * FH + oc) = o;
#pragma unroll
            for (int j = 0; j < 8; ++j) { gp[j] = gc[j]; vp[j] = vc[j]; gc[j] = gn[j]; vc[j] = vn[j]; }
        }
    }
}
__device__ __forceinline__ void ph_s5_naive(const Params& P) {
    const bf16_t* u = (const bf16_t*)(P.ws + OFF_ABUF); float* scr = (float*)(P.ws + OFF_R); bf16_t* gout = (bf16_t*)(P.ws + OFF_G);
    const int lane = threadIdx.x & 63, wid = threadIdx.x >> 6;
    for (int item = blockIdx.x + gridDim.x * wid; item < 256; item += gridDim.x * 8) {
        const int g = item & 63, b = item >> 6;
        for (int d = 0; d < 2; ++d) {
            const float lr = P.s5_a_re[(d * 64 + g) * 64 + lane], li = P.s5_a_im[(d * 64 + g) * 64 + lane];
            const float step = expf(P.s5_log_step[d * 64 + g]);
            const float mag = expf(lr * step), ang = li * step;
            const double angd = (double)ang, two_pi = 6.283185307179586476925;
            const float angr = (float)(angd - two_pi * rint(angd / two_pi));
            const float lbr = mag * cosf(angr), lbi = mag * sinf(angr);
            const float nr = lbr - 1.0f, den = lr * lr + li * li;
            const float qr = (nr * lr + lbi * li) / den, qi = (lbi * lr - nr * li) / den;
            float Br[16], Bi[16], Cr[16], Ci[16];
#pragma unroll
            for (int h = 0; h < 16; ++h) {
                const float br = P.s5_b_re[(g * 64 + lane) * 16 + h], bi = P.s5_b_im[(g * 64 + lane) * 16 + h];
                Br[h] = qr * br - qi * bi; Bi[h] = qr * bi + qi * br;
                Cr[h] = P.s5_c_re[((d * 64 + g) * 16 + h) * 64 + lane]; Ci[h] = P.s5_c_im[((d * 64 + g) * 16 + h) * 64 + lane];
            }
            float hr = 0.f, hi = 0.f;
            for (int s = 0; s < SEQ; ++s) {
                const int lt = d ? SEQ - 1 - s : s; const size_t tok = (size_t)b * SEQ + lt;
                const float uv = bf2f(u[tok * DM + g * 16 + (lane & 15)]);
                float dr = 0.f, di = 0.f;
#pragma unroll
                for (int h = 0; h < 16; ++h) { const float uh = __shfl(uv, h); dr += Br[h] * uh; di += Bi[h] * uh; }
                const float nhr = lbr * hr - lbi * hi + dr, nhi = lbr * hi + lbi * hr + di; hr = nhr; hi = nhi;
                float yv = 0.f;
#pragma unroll
                for (int h = 0; h < 16; ++h) { const float s1 = wave_sum(hr * Cr[h] - hi * Ci[h]); if ((lane & 15) == h) yv = s1; }
                if (lane < 16) {
                    if (d == 0) scr[tok * DM + g * 16 + lane] = yv;
                    else { const float y = scr[tok * DM + g * 16 + lane] + yv + P.s5_d[g * 16 + lane] * uv;
                           const float ge = 0.5f * y * (1.0f + tanhf(0.7978845608028654f * (y + 0.044715f * y * y * y)));
                           gout[tok * DM + g * 16 + lane] = f2bf(ge); }
                }
            }
        }
    }
}

constexpr size_t OFF_S5M = OFF_R + 96 * MiB;
__device__ __forceinline__ void s5_lambda(const Params& P, int d, int g, int p, float& lbr, float& lbi, float& qr, float& qi) {
    const float lr = P.s5_a_re[(d * 64 + g) * 64 + p], li = P.s5_a_im[(d * 64 + g) * 64 + p];
    const float step = expf(P.s5_log_step[d * 64 + g]);
    const float mag = expf(lr * step), ang = li * step;
    const double angd = (double)ang, two_pi = 6.283185307179586476925;
    const float angr = (float)(angd - two_pi * rint(angd / two_pi));
    lbr = mag * cosf(angr); lbi = mag * sinf(angr);
    const float nr = lbr - 1.0f, den = lr * lr + li * li;
    qr = (nr * lr + lbi * li) / den; qi = (lbi * lr - nr * li) / den;
}
__device__ __forceinline__ void ph_s5_setup(const Params& P, unsigned char* ldsraw) {
    float* pw = (float*)ldsraw;
    float* Bb = pw + 2 * 17 * 64 * 2;
    float* Cc = Bb + 2 * 64 * 16 * 2;
    float* Kt = Cc + 2 * 16 * 64 * 2;
    const int tid = threadIdx.x;
    for (int item = blockIdx.x; item < 256; item += gridDim.x) {
        const int g = item >> 2, part = item & 3;
        bf16_t* A1 = (bf16_t*)(P.ws + OFF_S5M) + (size_t)g * (65536 + 131072); bf16_t* A2 = A1 + 65536;
        __syncthreads();
        if (tid < 128) {
            const int d = tid >> 6, p = tid & 63; float lbr, lbi, qr, qi; s5_lambda(P, d, g, p, lbr, lbi, qr, qi);
            float pr = 1.f, pi = 0.f;
            for (int j = 0; j <= 16; ++j) { pw[((d * 17 + j) * 64 + p) * 2] = pr; pw[((d * 17 + j) * 64 + p) * 2 + 1] = pi; const float t = pr * lbr - pi * lbi; pi = pr * lbi + pi * lbr; pr = t; }
            for (int h = 0; h < 16; ++h) {
                const float br = P.s5_b_re[(g * 64 + p) * 16 + h], bi = P.s5_b_im[(g * 64 + p) * 16 + h];
                Bb[((d * 64 + p) * 16 + h) * 2] = qr * br - qi * bi; Bb[((d * 64 + p) * 16 + h) * 2 + 1] = qr * bi + qi * br;
                Cc[((d * 16 + h) * 64 + p) * 2] = P.s5_c_re[((d * 64 + g) * 16 + h) * 64 + p]; Cc[((d * 16 + h) * 64 + p) * 2 + 1] = P.s5_c_im[((d * 64 + g) * 16 + h) * 64 + p];
            }
        }
        __syncthreads();
        for (int i = tid; i < 16384; i += NT) {
            const int k = i & 255, R = 64 * part + (i >> 8), sx = k >> 4, hp = k & 15, d = R >> 7, ri = (R >> 6) & 1, p = R & 63;
            const int e = d ? sx : 15 - sx;
            const float pr = pw[((d * 17 + e) * 64 + p) * 2], pi = pw[((d * 17 + e) * 64 + p) * 2 + 1], br = Bb[((d * 64 + p) * 16 + hp) * 2], bi = Bb[((d * 64 + p) * 16 + hp) * 2 + 1];
            A1[(size_t)R * 256 + k] = f2bf(ri ? (pr * bi + pi * br) : (pr * br - pi * bi));
        }
        for (int i = tid; i < 2048; i += NT) {
            const int hp = i & 15, hl = (i >> 4) & 3, j = (i >> 6) & 15, d = i >> 10, h = 4 * part + hl;
            float acc = 0.f;
            for (int p = 0; p < 64; ++p) {
                const float pr = pw[((d * 17 + j) * 64 + p) * 2], pi = pw[((d * 17 + j) * 64 + p) * 2 + 1], br = Bb[((d * 64 + p) * 16 + hp) * 2], bi = Bb[((d * 64 + p) * 16 + hp) * 2 + 1];
                const float er = pr * br - pi * bi, ei = pr * bi + pi * br;
                acc += Cc[((d * 16 + h) * 64 + p) * 2] * er - Cc[((d * 16 + h) * 64 + p) * 2 + 1] * ei;
            }
            Kt[i] = acc;
        }
        __syncthreads();
        for (int i = tid; i < 16384; i += NT) {
            const int k = i & 255, rr = i >> 8, tau = rr >> 2, hl = rr & 3, h = 4 * part + hl, row = tau * 16 + h, sx = k >> 4, hp = k & 15;
            float v = 0.f;
            if (sx <= tau) v += Kt[(((tau - sx)) * 4 + hl) * 16 + hp];
            if (sx >= tau) v += Kt[((16 + sx - tau) * 4 + hl) * 16 + hp];
            if (sx == tau && hp == h) v += P.s5_d[g * 16 + h];
            A2[(size_t)row * 512 + k] = f2bf(v);
        }
        for (int i = tid; i < 16384; i += NT) {
            const int kk = i & 255, rr = i >> 8, tau = rr >> 2, h = 4 * part + (rr & 3), row = tau * 16 + h, d = kk >> 7, ri = kk & 1, p = (kk >> 1) & 63;
            const int e = d ? 16 - tau : tau + 1;
            const float pr = pw[((d * 17 + e) * 64 + p) * 2], pi = pw[((d * 17 + e) * 64 + p) * 2 + 1], cr = Cc[((d * 16 + h) * 64 + p) * 2], ci = Cc[((d * 16 + h) * 64 + p) * 2 + 1];
            A2[(size_t)row * 512 + 256 + kk] = f2bf(ri ? -(cr * pi + ci * pr) : (cr * pr - ci * pi));
        }
    }
}
__device__ __forceinline__ void ph_s5_main(const Params& P, unsigned char* ldsraw) {
    const bf16_t* u = (const bf16_t*)(P.ws + OFF_ABUF); float* scr = (float*)(P.ws + OFF_R); bf16_t* gout = (bf16_t*)(P.ws + OFF_G);
    bf16_t* Sc = (bf16_t*)ldsraw;
    float* tbuf = (float*)(ldsraw + 256 * 264 * 2);
    bf16_t* atile = (bf16_t*)(ldsraw + 256 * 264 * 2 + 8192);
    const int tid = threadIdx.x, lane = tid & 63, wid = tid >> 6, fr = lane & 15, q = lane >> 4;
    for (int item = blockIdx.x; item < 256; item += gridDim.x) {
        const int g = (item & 7) + 8 * (item >> 5), b = (item >> 3) & 3;
        const bf16_t* A1 = (const bf16_t*)(P.ws + OFF_S5M) + (size_t)g * (65536 + 131072); const bf16_t* A2 = A1 + 65536;
        float* sl = scr + (size_t)item * 65536;
        bf16x8 uf[2][8];
#pragma unroll
        for (int ct = 0; ct < 2; ++ct)
#pragma unroll
            for (int ks = 0; ks < 8; ++ks) {
                const int c = 32 * wid + 16 * ct + fr; const size_t tok = (size_t)b * SEQ + c * 16 + 2 * ks + (q >> 1);
                uf[ct][ks] = *(const bf16x8*)(u + tok * DM + g * 16 + 8 * (q & 1));
            }
        {
            const int srow = tid >> 5, spc = (tid & 31) * 8;
            *(u32x4*)(atile + srow * 264 + spc) = *(const u32x4*)(A1 + (size_t)srow * 256 + spc);
            u32x4 r0, r1 = *(const u32x4*)(A1 + (size_t)(16 + srow) * 256 + spc), r2 = *(const u32x4*)(A1 + (size_t)(32 + srow) * 256 + spc), r3 = *(const u32x4*)(A1 + (size_t)(48 + srow) * 256 + spc);
            __syncthreads();
#define S5A_STEP(Rt, RL, RW) do { \
                RL = *(const u32x4*)(A1 + (size_t)((((Rt) + 4) & 15) * 16 + srow) * 256 + spc); \
                const bf16_t* at = atile + ((Rt) & 1) * (16 * 264) + fr * 264 + 8 * q; \
                f32x4 a0 = {0.f, 0.f, 0.f, 0.f}, a1 = {0.f, 0.f, 0.f, 0.f}; \
                _Pragma("unroll") for (int ks = 0; ks < 8; ++ks) { const bf16x8 af = *(const bf16x8*)(at + ks * 32); \
                    a0 = __builtin_amdgcn_mfma_f32_16x16x32_bf16(af, uf[0][ks], a0, 0, 0, 0); a1 = __builtin_amdgcn_mfma_f32_16x16x32_bf16(af, uf[1][ks], a1, 0, 0, 0); } \
                *(f32x4*)(sl + (size_t)(32 * wid + fr) * 256 + (Rt) * 16 + 4 * q) = a0; \
                *(f32x4*)(sl + (size_t)(32 * wid + 16 + fr) * 256 + (Rt) * 16 + 4 * q) = a1; \
                *(u32x4*)(atile + (((Rt) + 1) & 1) * (16 * 264) + srow * 264 + spc) = RW; \
                LDS_BAR(); } while (0)
            for (int R4 = 0; R4 < 16; R4 += 4) { S5A_STEP(R4, r0, r1); S5A_STEP(R4 + 1, r1, r2); S5A_STEP(R4 + 2, r2, r3); S5A_STEP(R4 + 3, r3, r0); }
#undef S5A_STEP
        }
        asm volatile("s_waitcnt vmcnt(0)" ::: "memory");
        __syncthreads();
        {
            float L0r, L0i, L1r, L1i, qr_, qi_;
            s5_lambda(P, 0, g, lane, L0r, L0i, qr_, qi_); s5_lambda(P, 1, g, lane, L1r, L1i, qr_, qi_);
#pragma unroll
            for (int i = 0; i < 4; ++i) { float t = L0r * L0r - L0i * L0i; L0i = 2.f * L0r * L0i; L0r = t; t = L1r * L1r - L1i * L1i; L1i = 2.f * L1r * L1i; L1r = t; }
            float h0r = 0.f, h0i = 0.f, h1r = 0.f, h1i = 0.f;
            for (int j0 = 0; j0 < 32; j0 += 8) {
                float x0r[8], x0i[8], x1r[8], x1i[8];
#pragma unroll
                for (int i = 0; i < 8; ++i) { const int j = 32 * wid + j0 + i, c0 = j, c1 = 255 - j;
                    x0r[i] = sl[(size_t)c0 * 256 + lane]; x0i[i] = sl[(size_t)c0 * 256 + 64 + lane]; x1r[i] = sl[(size_t)c1 * 256 + 128 + lane]; x1i[i] = sl[(size_t)c1 * 256 + 192 + lane]; }
#pragma unroll
                for (int i = 0; i < 8; ++i) { float t = L0r * h0r - L0i * h0i + x0r[i]; h0i = L0r * h0i + L0i * h0r + x0i[i]; h0r = t; t = L1r * h1r - L1i * h1i + x1r[i]; h1i = L1r * h1i + L1i * h1r + x1i[i]; h1r = t; }
            }
            *(f32x4*)(tbuf + ((wid * 64 + lane) * 4)) = (f32x4){h0r, h0i, h1r, h1i};
            __syncthreads();
            float P0r = L0r, P0i = L0i, P1r = L1r, P1i = L1i;
#pragma unroll
            for (int i = 0; i < 5; ++i) { float t = P0r * P0r - P0i * P0i; P0i = 2.f * P0r * P0i; P0r = t; t = P1r * P1r - P1i * P1i; P1i = 2.f * P1r * P1i; P1r = t; }
            h0r = 0.f; h0i = 0.f; h1r = 0.f; h1i = 0.f;
            for (int w2 = 0; w2 < wid; ++w2) { const f32x4 tv = *(const f32x4*)(tbuf + ((w2 * 64 + lane) * 4));
                float t = P0r * h0r - P0i * h0i + tv[0]; h0i = P0r * h0i + P0i * h0r + tv[1]; h0r = t; t = P1r * h1r - P1i * h1i + tv[2]; h1i = P1r * h1i + P1i * h1r + tv[3]; h1r = t; }
            for (int j0 = 0; j0 < 32; j0 += 8) {
                float x0r[8], x0i[8], x1r[8], x1i[8];
#pragma unroll
                for (int i = 0; i < 8; ++i) { const int j = 32 * wid + j0 + i, c0 = j, c1 = 255 - j;
                    x0r[i] = sl[(size_t)c0 * 256 + lane]; x0i[i] = sl[(size_t)c0 * 256 + 64 + lane]; x1r[i] = sl[(size_t)c1 * 256 + 128 + lane]; x1i[i] = sl[(size_t)c1 * 256 + 192 + lane]; }
#pragma unroll
                for (int i = 0; i < 8; ++i) { const int j = 32 * wid + j0 + i, c0 = j, c1 = 255 - j;
                    ((unsigned*)(Sc + c0 * 264))[lane] = pg8::cvt_pk_bf16(h0r, h0i); ((unsigned*)(Sc + c1 * 264 + 128))[lane] = pg8::cvt_pk_bf16(h1r, h1i);
                    float t = L0r * h0r - L0i * h0i + x0r[i]; h0i = L0r * h0i + L0i * h0r + x0i[i]; h0r = t; t = L1r * h1r - L1i * h1i + x1r[i]; h1i = L1r * h1i + L1i * h1r + x1i[i]; h1r = t; }
            }
        }
        __syncthreads();
        {
            const int srow = tid >> 5, spc = (tid & 31) * 8;
#define S5C_SRC(h) (A2 + (size_t)((((h) & 31) >> 1) * 16 + srow) * 512 + ((h) & 1) * 256 + spc)
            *(u32x4*)(atile + srow * 264 + spc) = *(const u32x4*)S5C_SRC(0);
            u32x4 r0, r1 = *(const u32x4*)S5C_SRC(1), r2 = *(const u32x4*)S5C_SRC(2), r3 = *(const u32x4*)S5C_SRC(3);
            __syncthreads();
            f32x4 a0 = {0.f, 0.f, 0.f, 0.f}, a1 = {0.f, 0.f, 0.f, 0.f};
#define S5C_STEP(hs, RL, RW) do { \
                RL = *(const u32x4*)S5C_SRC((hs) + 4); \
                const bf16_t* at = atile + ((hs) & 1) * (16 * 264) + fr * 264 + 8 * q; \
                if (((hs) & 1) == 0) { \
                    _Pragma("unroll") for (int ks = 0; ks < 8; ++ks) { const bf16x8 af = *(const bf16x8*)(at + ks * 32); \
                        a0 = __builtin_amdgcn_mfma_f32_16x16x32_bf16(af, uf[0][ks], a0, 0, 0, 0); a1 = __builtin_amdgcn_mfma_f32_16x16x32_bf16(af, uf[1][ks], a1, 0, 0, 0); } \
                } else { \
                    _Pragma("unroll") for (int ks = 0; ks < 8; ++ks) { const bf16x8 af = *(const bf16x8*)(at + ks * 32); \
                        const bf16x8 b0 = *(const bf16x8*)(Sc + (32 * wid + fr) * 264 + ks * 32 + 8 * q), b1 = *(const bf16x8*)(Sc + (32 * wid + 16 + fr) * 264 + ks * 32 + 8 * q); \
                        a0 = __builtin_amdgcn_mfma_f32_16x16x32_bf16(af, b0, a0, 0, 0, 0); a1 = __builtin_amdgcn_mfma_f32_16x16x32_bf16(af, b1, a1, 0, 0, 0); } \
                    const int ch = g * 16 + 4 * q, rt = (hs) >> 1; \
                    _Pragma("unroll") for (int ct = 0; ct < 2; ++ct) { \
                        const int c = 32 * wid + 16 * ct + fr; const size_t tok = (size_t)b * SEQ + c * 16 + rt; \
                        const f32x4 av = ct ? a1 : a0; float y[4]; \
                        _Pragma("unroll") for (int r = 0; r < 4; ++r) { const float yy = av[r]; y[r] = yy * fsig(1.5957691216057308f * (yy + 0.044715f * yy * yy * yy)); } \
                        u32x2 o; o.x = pg8::cvt_pk_bf16(y[0], y[1]); o.y = pg8::cvt_pk_bf16(y[2], y[3]); \
                        *(u32x2*)(gout + tok * DM + ch) = o; } \
                    a0 = (f32x4){0.f, 0.f, 0.f, 0.f}; a1 = (f32x4){0.f, 0.f, 0.f, 0.f}; \
                } \
                *(u32x4*)(atile + (((hs) + 1) & 1) * (16 * 264) + srow * 264 + spc) = RW; \
                LDS_BAR(); } while (0)
            for (int h4 = 0; h4 < 32; h4 += 4) { S5C_STEP(h4, r0, r1); S5C_STEP(h4 + 1, r1, r2); S5C_STEP(h4 + 2, r2, r3); S5C_STEP(h4 + 3, r3, r0); }
#undef S5C_STEP
#undef S5C_SRC
        }
        __syncthreads();
    }
}

#define XB_TMO      128
#define XB_XCNT(j)  (256  + 64 * (j))
#define XB_XSUB(j)  (1280 + 64 * (j))
#define XB_XGEN(j)  (2304 + 64 * (j))
#define XB_TOP      3328
#define XB_TOPGEN   3392
#define XCD_BAR_WORDS 3456
#define XB_SPIN_CAP (1u << 18)
constexpr size_t OFF_BAR = 255 * MiB;
constexpr int LDS_ST_OFF = (int)LDS_BYTES - 16;
__device__ __forceinline__ unsigned xb_ld(unsigned* p)              { return __hip_atomic_load(p, __ATOMIC_RELAXED, __HIP_MEMORY_SCOPE_AGENT); }
__device__ __forceinline__ unsigned xb_add(unsigned* p, unsigned v) { return __hip_atomic_fetch_add(p, v, __ATOMIC_RELAXED, __HIP_MEMORY_SCOPE_AGENT); }
__device__ __forceinline__ unsigned xb_xcc_id() { return (unsigned)__builtin_amdgcn_s_getreg((3 << 11) | 20) & 0xFu; }
#define XB_SPIN(cond, bar) do { unsigned _sp = 0; while (cond) { __builtin_amdgcn_s_sleep(1); \
    if ((++_sp & 255u) == 0u) { if (xb_ld(&(bar)[XB_TMO])) break; if (_sp > XB_SPIN_CAP) { atomicAdd(&(bar)[XB_TMO], 1u); break; } } } } while (0)
struct XcdBarrier { unsigned* bar; unsigned x; volatile PG8_LAS unsigned* st; };
__device__ __forceinline__ XcdBarrier xcd_barrier_post(unsigned* bar, volatile PG8_LAS unsigned* st) {
    XcdBarrier b; b.bar = bar; b.x = xb_xcc_id(); b.st = st;
    if (threadIdx.x == 0) (void)xb_add(&bar[XB_XCNT(b.x)], 1u);
    return b;
}
__device__ __forceinline__ void xcd_barrier_complete(unsigned* bar, unsigned x, unsigned& nloc, unsigned& nx) {
    const unsigned G = gridDim.x * gridDim.y * gridDim.z;
    unsigned sum, cnt, mine, sp = 0u;
    for (;;) {
        sum = 0u; cnt = 0u; mine = 0u;
#pragma unroll
        for (unsigned j = 0; j < 16; ++j) { const unsigned c = xb_ld(&bar[XB_XCNT(j)]); sum += c; cnt += (c > 0u) ? 1u : 0u; mine = (j == x) ? c : mine; }
        if (sum == G) break;
        __builtin_amdgcn_s_sleep(1);
        if ((++sp & 255u) == 0u) { if (xb_ld(&bar[XB_TMO])) break; if (sp > XB_SPIN_CAP) { atomicAdd(&bar[XB_TMO], 1u); break; } }
    }
    nloc = mine > 0u ? mine : 1u; nx = cnt > 0u ? cnt : 1u;
}
__device__ __forceinline__ void xcd_barrier(const XcdBarrier& b) {
    asm volatile("s_waitcnt vmcnt(0)" ::: "memory");
    __syncthreads();
    if (threadIdx.x == 0) {
        unsigned* bar = b.bar;
        __builtin_amdgcn_s_waitcnt(0);
        unsigned nloc = b.st[0], nx = b.st[1];
        if (nloc == 0u) { xcd_barrier_complete(bar, b.x, nloc, nx); b.st[0] = nloc; b.st[1] = nx; }
        const unsigned old = xb_add(&bar[XB_XSUB(b.x)], 1u);
        const unsigned gen = old / nloc;
        if (old + 1u == (gen + 1u) * nloc) {
            __builtin_amdgcn_fence(__ATOMIC_RELEASE, "agent");
            asm volatile("s_waitcnt vmcnt(0)" ::: "memory");
            const unsigned og = xb_add(&bar[XB_TOP], 1u);
            const unsigned tg = og / nx;
            if (og + 1u == (tg + 1u) * nx) xb_add(&bar[XB_TOPGEN], 1u);
            else XB_SPIN(xb_ld(&bar[XB_TOPGEN]) == tg, bar);
            __builtin_amdgcn_fence(__ATOMIC_ACQUIRE, "agent");
            xb_add(&bar[XB_XGEN(b.x)], 1u);
            asm volatile("s_waitcnt vmcnt(0)" ::: "memory");
        } else {
            XB_SPIN(xb_ld(&bar[XB_XGEN(b.x)]) == gen, bar);
            __builtin_amdgcn_fence(__ATOMIC_ACQUIRE, "agent");
            asm volatile("s_waitcnt vmcnt(0)" ::: "memory");
        }
    }
    __syncthreads();
}

constexpr int NPH = 32;
#define PH(k, body) if (lo <= (k) && (k) < hi) { { unsigned char* ws = P.ws; bf16_t* abuf = (bf16_t*)(ws + OFF_ABUF); bf16_t* proj = (bf16_t*)(ws + OFF_R); bf16_t* gbuf = (bf16_t*)(ws + OFF_G); bf16_t* hbuf = (bf16_t*)P.out; (void)abuf; (void)proj; (void)gbuf; (void)hbuf; body; } if ((k) + 1 < hi) xcd_barrier(xbar); }
#ifndef USE_NAIVE_GEMM
#define USE_NAIVE_GEMM 0
#endif
#define GEMM(A_, lda_, B_, ldb_, M_, N_, K_, EPI_, ...) { const GemmArgs g_ = mkgemm(A_, lda_, B_, ldb_, M_, N_, K_, EPI_, __VA_ARGS__); if (USE_NAIVE_GEMM) gemm_naive(g_, (float*)lds); else gemm_pg8<EPI_>((PG8_LAS unsigned char*)lds, g_); }
#define W_UPL ((bf16_t*)(ws + (layer ? W_UP1 : W_UP0)))
#define W_DNL ((bf16_t*)(ws + (layer ? W_DN1 : W_DN0)))
#define W_GTL ((bf16_t*)(ws + (layer ? W_GT1 : W_GT0)))
#define W_PPL ((bf16_t*)(ws + (layer ? W_PP1 : W_PP0)))
#define PPBUF ((bf16_t*)(ws + OFF_R))
#define PBF ((bf16_t*)(ws + OFF_R + 64 * MiB))
__device__ __forceinline__ void ffn_section(const Params& P, const int layer, const int base, const int lo, const int hi, const XcdBarrier& xbar, unsigned char* lds) {
    PH(base + 0, { if (layer == 0) ph_s5_setup(P, lds); ph_norm16(hbuf, P.ffn_norm_w + layer * DM, abuf, nullptr); })
    PH(base + 1, GEMM(abuf, DM, W_UPL, DM, T_TOK, 2816, DM, EPI_BF16, proj, 2816))
    PH(base + 2, ph_ffn_conv(P, layer, 0))
    PH(base + 3, GEMM(abuf, DM, W_UPL + (size_t)2816 * DM, DM, T_TOK, 2816, DM, EPI_BF16, proj, 2816))
    PH(base + 4, GEMM(gbuf, FH, W_DNL, 2816, T_TOK, DM, FH, EPI_RES16, hbuf, DM, (const float*)hbuf))
    PH(base + 5, ph_ffn_conv(P, layer, 1))
    PH(base + 6, GEMM(gbuf, FH, W_DNL + FH, 2816, T_TOK, DM, FH, EPI_RES16, hbuf, DM, (const float*)hbuf))
    PH(base + 7, { ph_norm16(hbuf, P.ple_norm_w + layer * DM, abuf, nullptr); ph_cvt_copy(P.p + (size_t)layer * T_TOK * 256, PBF, (size_t)T_TOK * 256); })
    PH(base + 8, { GEMM(PBF, 256, W_PPL, 256, T_TOK, DM, 256, EPI_BF16, PPBUF, DM) GEMM(abuf, DM, W_GTL, DM, T_TOK, DM, DM, EPI_PLE16, (layer ? gbuf : hbuf), DM, (const float*)hbuf, (const float*)PPBUF) })
}

__global__ void __launch_bounds__(NT, 2) mega(Params P) {
    extern __shared__ __attribute__((aligned(16))) unsigned char lds[];
    cg::grid_group grid = cg::this_grid();
    const int lo = P.ph_lo, hi = P.ph_hi;
    if (lo < 0) grid.sync();
    volatile PG8_LAS unsigned* xst = (volatile PG8_LAS unsigned*)((PG8_LAS unsigned char*)lds + LDS_ST_OFF);
    if (threadIdx.x < 4) xst[threadIdx.x] = 0u;
    __syncthreads();
    const XcdBarrier xbar = xcd_barrier_post((unsigned*)(P.ws + OFF_BAR), xst);
    PH(0, { cvt_weights0(P, (float*)lds); ph_norm(P.x, P.mix_norm_w, abuf, nullptr); })
    PH(1, GEMM(abuf, DM, (bf16_t*)(ws + W_IN) + (size_t)2048 * DM, DM, T_TOK, LDP, DM, EPI_BF16, proj, LDP))
    PH(2, ph_ssd_halo(P))
    PH(3, ph_ssd_bcconv(P, lds))
    PH(4, ph_ssd_scan(P, lds))
    PH(5, GEMM(abuf, DM, (bf16_t*)(ws + W_IN), DM, T_TOK, 2048, DM, EPI_ZGATE, proj, LDP, nullptr, nullptr, (const bf16_t*)(ws + OFF_YF), (const bf16_t*)P.out))
    PH(6, { ph_gn_scale(P); cvt_weights1(P, (float*)lds); })
    PH(7, GEMM(proj, LDP, (bf16_t*)(ws + W_OUT), 2048, T_TOK, DM, 2048, EPI_RESX, hbuf, DM, P.x))
    ffn_section(P, 0, 8, lo, hi, xbar, lds);
    PH(18, ph_norm16(hbuf, P.mix_norm_w + DM, abuf, nullptr))
    PH(19, ph_s5_main(P, lds))
    PH(20, GEMM(gbuf, DM, (bf16_t*)(ws + W_GLU), DM, T_TOK, 2048, DM, EPI_GLU16, hbuf, DM, (const float*)hbuf, nullptr, nullptr, nullptr, P.s5_b_glu))
    ffn_section(P, 1, 21, lo, hi, xbar, lds);
    PH(31, ph_norm16(gbuf, P.final_norm_w, nullptr, P.out))
}

extern "C" void kernel_launch(void* const* d_in, const int* in_sizes, int n_in, void* d_out, int out_size, void* d_ws, size_t ws_size, hipStream_t stream) {
    static int grid_blocks = 0;
    if (!grid_blocks) {
        int dev = 0, cus = 0, per_cu = 0;
        hipGetDevice(&dev);
        hipDeviceGetAttribute(&cus, hipDeviceAttributeMultiprocessorCount, dev);
        hipFuncSetAttribute((const void*)mega, hipFuncAttributeMaxDynamicSharedMemorySize, (int)LDS_BYTES);
        hipOccupancyMaxActiveBlocksPerMultiprocessor(&per_cu, (const void*)mega, NT, LDS_BYTES);
        if (per_cu < 1) per_cu = 1;
        grid_blocks = cus * per_cu;
        if (ws_size < 256 * MiB) fprintf(stderr, "workspace too small: %zu\n", ws_size);
    }
    Params P{};
    const float** pp = (const float**)&P;
    for (int i = 0; i < 30; ++i) pp[i] = (const float*)d_in[i];
    P.out = (float*)d_out; P.ws = (unsigned char*)d_ws;
#if COOP
    (void)hipMemsetAsync((unsigned char*)d_ws + OFF_BAR, 0, XCD_BAR_WORDS * 4, stream);
    P.ph_lo = 0; P.ph_hi = NPH;
    void* args[] = {&P};
    hipError_t e = hipLaunchCooperativeKernel((const void*)mega, dim3(grid_blocks), dim3(NT), args, LDS_BYTES, stream);
    if (e != hipSuccess) fprintf(stderr, "cooperative launch failed: %s (grid %d)\n", hipGetErrorString(e), grid_blocks);
#else
    for (int ph = 0; ph < NPH; ++ph) {
        P.ph_lo = ph; P.ph_hi = ph + 1;
        hipLaunchKernelGGL(mega, dim3(grid_blocks), dim3(NT), LDS_BYTES, stream, P);
    }
#endif
}
```

```cpp
#include <hip/hip_runtime.h>
#include <hip/hip_cooperative_groups.h>
#include <cstdio>
namespace cg = cooperative_groups;

#ifndef COOP
#define COOP 1
#endif

typedef unsigned short bf16_t;
typedef float f32x4 __attribute__((ext_vector_type(4)));
typedef unsigned u32x4 __attribute__((ext_vector_type(4)));
typedef unsigned u32x2 __attribute__((ext_vector_type(2)));

constexpr int NT = 512;
constexpr int T_TOK = 16384, DM = 1024, SEQ = 4096, NB = 4;
constexpr int LDP = 3328;
constexpr int FH = 1408;
constexpr float EPS = 1e-6f;
constexpr size_t MiB = 1u << 20;
constexpr size_t OFF_W0 = 0;
constexpr size_t W_IN = OFF_W0, W_OUT = W_IN + (size_t)5376 * 1024 * 2, W_UP0 = W_OUT + 4 * MiB, W_DN0 = W_UP0 + 11 * MiB, W_GT0 = W_DN0 + (size_t)1024 * 2816 * 2, W_PP0 = W_GT0 + 2 * MiB;
constexpr size_t OFF_ABUF = 34 * MiB;
constexpr size_t OFF_R = 66 * MiB;
constexpr size_t OFF_G = 186 * MiB;
constexpr size_t OFF_W1 = 230 * MiB;
constexpr size_t W_GLU = OFF_W1, W_UP1 = W_GLU + 4 * MiB, W_DN1 = W_UP1 + 11 * MiB, W_GT1 = W_DN1 + (size_t)1024 * 2816 * 2, W_PP1 = W_GT1 + 2 * MiB;
constexpr size_t OFF_YF = 186 * MiB;
constexpr size_t OFF_SMALL = 253 * MiB;
constexpr size_t LDS_BYTES = 160 * 1024;

struct Params {
    const float *x, *p, *ssd_w_in, *ssd_conv_w, *ssd_conv_b, *ssd_dt_bias, *ssd_a_log, *ssd_d, *ssd_norm_w, *ssd_w_out;
    const float *s5_a_re, *s5_a_im, *s5_log_step, *s5_b_re, *s5_b_im, *s5_c_re, *s5_c_im, *s5_d, *s5_w_glu, *s5_b_glu;
    const float *mix_norm_w, *ffn_norm_w, *ffn_w_up, *ffn_conv_w, *ffn_conv_b, *ffn_w_down, *ple_norm_w, *ple_w_gate, *ple_w_proj, *final_norm_w;
    float* out; unsigned char* ws;
    int ph_lo, ph_hi;
};

__device__ __forceinline__ int otid() { int t = (int)__builtin_amdgcn_workitem_id_x(); asm volatile("" : "+v"(t)); return t & (NT - 1); }
__device__ __forceinline__ float bf2f(bf16_t b) { return __uint_as_float(((unsigned)b) << 16); }
__device__ __forceinline__ bf16_t f2bf(float f) { unsigned u = __float_as_uint(f); u += 0x7FFFu + ((u >> 16) & 1u); return (bf16_t)(u >> 16); }
__device__ __forceinline__ unsigned pack2(float lo, float hi) { return (unsigned)f2bf(lo) | ((unsigned)f2bf(hi) << 16); }
__device__ __forceinline__ float siluf(float v) { return v / (1.0f + __expf(-v)); }
__device__ __forceinline__ float sigmf(float v) { return 1.0f / (1.0f + __expf(-v)); }
__device__ __forceinline__ float wave_sum(float v) {
#pragma unroll
    for (int o = 32; o >= 1; o >>= 1) v += __shfl_xor(v, o);
    return v;
}

#define PG8_LAS __attribute__((address_space(3)))
typedef short bf16x8 __attribute__((ext_vector_type(8)));
namespace pg8 {
constexpr int BM = 256, BK = 64, HALF = 128, HTB = HALF * BK * 2, STAGE_BYTES = 8 * HTB, NXCD = 8, WGM = 8;
__device__ __forceinline__ int lds_byte(int r, int c) { const int st = (r >> 4) * 2 + (c >> 5), rr = r & 15, cc = c & 31, ob = rr * 64 + cc * 2; return st * 1024 + (ob ^ (((ob >> 9) & 1) << 5)); }
__device__ __forceinline__ void stage_rc(int b, int& R, int& C) { const int st = b / 1024, sb = b % 1024, swz = sb ^ (((sb >> 9) & 1) << 5); R = (st >> 1) * 16 + swz / 64; C = (st & 1) * 32 + (swz % 64) / 2; }
__device__ __forceinline__ int perm32(int rho) { const int n = rho >> 4, i = rho & 15; return 8 * (i >> 2) + 4 * n + (i & 3); }
struct Unit { int pm, pn; };
struct StaticOrder {
    int nM, nN, nwg, G, c;
    __device__ void init(int M, int N, int G_, int c_) { nM = M / BM; nN = N / BM; nwg = nM * nN; G = G_; c = c_; }
    __device__ bool next(int i, Unit& u) const {
        const long L = (long)i * G + c; if (L >= nwg) return false;
        int wgid = (int)L; { const int q = nwg / NXCD, r = nwg % NXCD, xcd = wgid % NXCD, off = wgid / NXCD; wgid = (xcd < r ? xcd * (q + 1) : r * (q + 1) + (xcd - r) * q) + off; }
        const int nig = WGM * nN, gid = wgid / nig, fm = gid * WGM, gsz = (nM - fm) < WGM ? (nM - fm) : WGM;
        u.pm = fm + ((wgid % nig) % gsz); u.pn = (wgid % nig) / gsz; return true;
    }
};
typedef __bf16 bf16x2_t __attribute__((ext_vector_type(2)));
typedef float f32x2_t __attribute__((ext_vector_type(2)));
__device__ __forceinline__ unsigned cvt_pk_bf16(float lo, float hi) { const f32x2_t v = {lo, hi}; union { bf16x2_t b; unsigned u; } r; r.b = __builtin_convertvector(v, bf16x2_t); return r.u; }
}
__device__ __forceinline__ float fsig(float v) { return __builtin_amdgcn_rcpf(1.0f + __expf(-v)); }
__device__ __forceinline__ void unpack8(const u32x4 v, float (&f)[8]) {
#pragma unroll
    for (int j = 0; j < 4; ++j) { f[2 * j] = __uint_as_float(v[j] << 16); f[2 * j + 1] = __uint_as_float(v[j] & 0xffff0000u); }
}
__device__ __forceinline__ f32x4 bf4lo(unsigned a, unsigned b) { return (f32x4){__uint_as_float(a << 16), __uint_as_float(a & 0xffff0000u), __uint_as_float(b << 16), __uint_as_float(b & 0xffff0000u)}; }

struct WDesc { const float* W; bf16_t* Wt; int K, Nsrc, Ndst, mode, H, ntiles; };
__device__ __forceinline__ void cvt_tile(const WDesc& d, int tile, float* lds) {
    const int tid = threadIdx.x, nnt = d.Ndst / 64;
    const int n0 = (tile % nnt) * 64, k0 = (tile / nnt) * 64;
    int src0;
    if (d.mode == 0) src0 = (n0 < d.Nsrc) ? n0 : -1;
    else { const int pn = n0 / 256, w = n0 % 256; src0 = (w < 128) ? pn * 128 + w : d.H + pn * 128 + (w - 128); }
    __syncthreads();
#pragma unroll
    for (int i = 0; i < 2; ++i) {
        const int r = (tid >> 4) + 32 * i, c4 = (tid & 15) * 4;
        f32x4 v = {0.f, 0.f, 0.f, 0.f};
        if (src0 >= 0) v = *(const f32x4*)(d.W + (size_t)(k0 + r) * d.Nsrc + src0 + c4);
#pragma unroll
        for (int j = 0; j < 4; ++j) lds[r * 65 + c4 + j] = v[j];
    }
    __syncthreads();
    {
        const int nr = tid >> 3, kp = (tid & 7) * 8;
        u32x4 o;
#pragma unroll
        for (int j = 0; j < 4; ++j) o[j] = pg8::cvt_pk_bf16(lds[(kp + 2 * j) * 65 + nr], lds[(kp + 2 * j + 1) * 65 + nr]);
        *(u32x4*)(d.Wt + (size_t)(n0 + nr) * d.K + k0 + kp) = o;
    }
}
__device__ __forceinline__ WDesc mkdesc(const float* W, bf16_t* Wt, int K, int Nsrc, int Ndst, int mode, int H) { WDesc d; d.W = W; d.Wt = Wt; d.K = K; d.Nsrc = Nsrc; d.Ndst = Ndst; d.mode = mode; d.H = H; d.ntiles = (K / 64) * (Ndst / 64); return d; }
#define CVT_ONE(W, Wt, K, Ns, Nd, mode, H) { const int n_ = ((K) / 64) * ((Nd) / 64); if (tt >= 0 && tt < n_) { const WDesc d_ = mkdesc(W, Wt, K, Ns, Nd, mode, H); cvt_tile(d_, tt, lds); } tt -= n_; }
__device__ __forceinline__ void cvt_weights0(const Params& P, float* lds) {
    unsigned char* ws = P.ws;
    for (int t = blockIdx.x; t < 1344 + 512 + 1408 + 704 + 256 + 64; t += gridDim.x) {
        int tt = t;
        CVT_ONE(P.ssd_w_in, (bf16_t*)(ws + W_IN), 1024, 5184, 5376, 0, 0)
        CVT_ONE(P.ssd_w_out, (bf16_t*)(ws + W_OUT), 2048, 1024, 1024, 0, 0)
        CVT_ONE(P.ffn_w_up, (bf16_t*)(ws + W_UP0), 1024, 5632, 5632, 1, 2816)
        CVT_ONE(P.ffn_w_down, (bf16_t*)(ws + W_DN0), 2816, 1024, 1024, 0, 0)
        CVT_ONE(P.ple_w_gate, (bf16_t*)(ws + W_GT0), 1024, 1024, 1024, 0, 0)
        CVT_ONE(P.ple_w_proj, (bf16_t*)(ws + W_PP0), 256, 1024, 1024, 0, 0)
    }
}
__device__ __forceinline__ void cvt_weights1(const Params& P, float* lds) {
    unsigned char* ws = P.ws;
    for (int t = blockIdx.x; t < 512 + 1408 + 704 + 256 + 64; t += gridDim.x) {
        int tt = t;
        CVT_ONE(P.s5_w_glu, (bf16_t*)(ws + W_GLU), 1024, 2048, 2048, 1, 1024)
        CVT_ONE(P.ffn_w_up + (size_t)1024 * 5632, (bf16_t*)(ws + W_UP1), 1024, 5632, 5632, 1, 2816)
        CVT_ONE(P.ffn_w_down + (size_t)2816 * 1024, (bf16_t*)(ws + W_DN1), 2816, 1024, 1024, 0, 0)
        CVT_ONE(P.ple_w_gate + (size_t)1024 * 1024, (bf16_t*)(ws + W_GT1), 1024, 1024, 1024, 0, 0)
        CVT_ONE(P.ple_w_proj + (size_t)256 * 1024, (bf16_t*)(ws + W_PP1), 256, 1024, 1024, 0, 0)
    }
}
__device__ __forceinline__ void ph_norm(const float* src, const float* w, bf16_t* dstb, float* dstf) {
    const int lane = threadIdx.x & 63, wid = threadIdx.x >> 6;
    for (int row = blockIdx.x * 8 + wid; row < T_TOK; row += gridDim.x * 8) {
        const float* s = src + (size_t)row * DM;
        f32x4 v[4]; float ss = 0.f;
#pragma unroll
        for (int i = 0; i < 4; ++i) { v[i] = *(const f32x4*)(s + lane * 4 + 256 * i); ss += v[i][0] * v[i][0] + v[i][1] * v[i][1] + v[i][2] * v[i][2] + v[i][3] * v[i][3]; }
        ss = wave_sum(ss);
        const float rstd = rsqrtf(ss * (1.0f / DM) + EPS);
#pragma unroll
        for (int i = 0; i < 4; ++i) {
            const f32x4 wv = *(const f32x4*)(w + lane * 4 + 256 * i);
            const f32x4 o = v[i] * rstd * wv;
            if (dstb) { u32x2 pk; pk.x = pack2(o[0], o[1]); pk.y = pack2(o[2], o[3]); *(u32x2*)(dstb + (size_t)row * DM + lane * 4 + 256 * i) = pk; }
            else *(f32x4*)(dstf + (size_t)row * DM + lane * 4 + 256 * i) = o;
        }
    }
}
__device__ __forceinline__ void ph_norm16(const bf16_t* src, const float* w, bf16_t* dstb, float* dstf) {
    const int lane = threadIdx.x & 63, wid = threadIdx.x >> 6;
    for (int row = blockIdx.x * 8 + wid; row < T_TOK; row += gridDim.x * 8) {
        const bf16_t* sp = src + (size_t)row * DM;
        float v[2][8]; float ss = 0.f;
#pragma unroll
        for (int i = 0; i < 2; ++i) { unpack8(*(const u32x4*)(sp + lane * 8 + 512 * i), v[i]);
#pragma unroll
            for (int j = 0; j < 8; ++j) ss += v[i][j] * v[i][j]; }
        ss = wave_sum(ss);
        const float rstd = rsqrtf(ss * (1.0f / DM) + EPS);
#pragma unroll
        for (int i = 0; i < 2; ++i) {
            const f32x4 w0 = *(const f32x4*)(w + lane * 8 + 512 * i), w1 = *(const f32x4*)(w + lane * 8 + 512 * i + 4);
            float o[8];
#pragma unroll
            for (int j = 0; j < 4; ++j) { o[j] = v[i][j] * rstd * w0[j]; o[4 + j] = v[i][4 + j] * rstd * w1[j]; }
            if (dstb) { u32x4 pk; pk.x = pg8::cvt_pk_bf16(o[0], o[1]); pk.y = pg8::cvt_pk_bf16(o[2], o[3]); pk.z = pg8::cvt_pk_bf16(o[4], o[5]); pk.w = pg8::cvt_pk_bf16(o[6], o[7]); *(u32x4*)(dstb + (size_t)row * DM + lane * 8 + 512 * i) = pk; }
            else { *(f32x4*)(dstf + (size_t)row * DM + lane * 8 + 512 * i) = (f32x4){o[0], o[1], o[2], o[3]}; *(f32x4*)(dstf + (size_t)row * DM + lane * 8 + 512 * i + 4) = (f32x4){o[4], o[5], o[6], o[7]}; }
        }
    }
}
__device__ __forceinline__ void ph_cvt_copy(const float* src, bf16_t* dst, size_t n) {
    for (size_t i = ((size_t)blockIdx.x * NT + threadIdx.x) * 4; i < n; i += (size_t)gridDim.x * NT * 4) {
        const f32x4 v = *(const f32x4*)(src + i); u32x2 pk; pk.x = pack2(v[0], v[1]); pk.y = pack2(v[2], v[3]); *(u32x2*)(dst + i) = pk;
    }
}

enum { EPI_BF16 = 0, EPI_RES = 1, EPI_F32 = 2, EPI_PLE = 3, EPI_GLU = 4, EPI_ZGATE = 5, EPI_RESX = 6, EPI_RES16 = 7, EPI_PLE16 = 8, EPI_GLU16 = 9 };
struct GemmArgs {
    const bf16_t* A; int lda; const bf16_t* Bt; int ldb; int M, N, K; int epi;
    void* out; int ldc; const float* res; const float* aux; const bf16_t* y1; const bf16_t* y2; const float* bias;
};
__device__ __forceinline__ void epi_store(const GemmArgs& g, int row, int pn, int tc, float acc, float accp) {
    const int col = pn * 256 + tc;
    switch (g.epi) {
        case EPI_BF16: ((bf16_t*)g.out)[(size_t)row * g.ldc + col] = f2bf(acc); break;
        case EPI_RES: { const size_t o = (size_t)row * g.ldc + col; ((float*)g.out)[o] = g.res[o] + acc; } break;
        case EPI_F32: ((float*)g.out)[(size_t)row * g.ldc + col] = acc; break;
        case EPI_PLE: { const size_t o = (size_t)row * g.ldc + col; ((float*)g.out)[o] = g.res[o] + g.aux[o] * sigmf(acc); } break;
        case EPI_GLU: { const int oc = pn * 128 + tc; const size_t o = (size_t)row * g.ldc + oc; ((float*)g.out)[o] = g.res[o] + (acc + g.bias[oc]) * sigmf(accp + g.bias[1024 + oc]); } break;
        case EPI_ZGATE: { const size_t yo = (size_t)row * 2048 + col; ((bf16_t*)g.out)[(size_t)row * g.ldc + col] = f2bf((bf2f(g.y1[yo]) + bf2f(g.y2[yo])) * siluf(acc)); } break;
    }
}
__device__ __forceinline__ void gemm_naive(const GemmArgs& g, float* lds) {
    float* As = lds;
    float* Bs = lds + 32 * 132;
    const int tid = threadIdx.x, ty = tid >> 4, tx = tid & 15;
    const int nM = g.M / 128, nN = g.N / 256;
    for (int tile = blockIdx.x; tile < nM * nN; tile += gridDim.x) {
        const int pm = tile % nM, pn = tile / nM;
        float acc[4][16];
#pragma unroll
        for (int i = 0; i < 4; ++i)
#pragma unroll
            for (int j = 0; j < 16; ++j) acc[i][j] = 0.f;
        for (int k0 = 0; k0 < g.K; k0 += 32) {
            __syncthreads();
            { const int r = tid >> 2, kk = (tid & 3) * 8;
              const u32x4 v = *(const u32x4*)(g.A + (size_t)(pm * 128 + r) * g.lda + k0 + kk);
#pragma unroll
              for (int j = 0; j < 4; ++j) { As[(kk + 2 * j) * 132 + r] = __uint_as_float(v[j] << 16); As[(kk + 2 * j + 1) * 132 + r] = __uint_as_float(v[j] & 0xffff0000u); } }
#pragma unroll
            for (int h = 0; h < 2; ++h) { const int r = (tid >> 2) + 128 * h, kk = (tid & 3) * 8;
              const u32x4 v = *(const u32x4*)(g.Bt + (size_t)(pn * 256 + r) * g.ldb + k0 + kk);
#pragma unroll
              for (int j = 0; j < 4; ++j) { Bs[(kk + 2 * j) * 260 + r] = __uint_as_float(v[j] << 16); Bs[(kk + 2 * j + 1) * 260 + r] = __uint_as_float(v[j] & 0xffff0000u); } }
            __syncthreads();
#pragma unroll 4
            for (int kk = 0; kk < 32; ++kk) {
                const f32x4 a = *(const f32x4*)(As + kk * 132 + ty * 4);
                const f32x4 b0 = *(const f32x4*)(Bs + kk * 260 + tx * 8), b1 = *(const f32x4*)(Bs + kk * 260 + tx * 8 + 4);
                const f32x4 b2 = *(const f32x4*)(Bs + kk * 260 + 128 + tx * 8), b3 = *(const f32x4*)(Bs + kk * 260 + 128 + tx * 8 + 4);
#pragma unroll
                for (int i = 0; i < 4; ++i)
#pragma unroll
                    for (int j = 0; j < 4; ++j) { acc[i][j] += a[i] * b0[j]; acc[i][4 + j] += a[i] * b1[j]; acc[i][8 + j] += a[i] * b2[j]; acc[i][12 + j] += a[i] * b3[j]; }
            }
        }
#pragma unroll
        for (int i = 0; i < 4; ++i) {
            const int row = pm * 128 + ty * 4 + i;
#pragma unroll
            for (int j = 0; j < 8; ++j) {
                if (g.epi == EPI_GLU) epi_store(g, row, pn, tx * 8 + j, acc[i][j], acc[i][8 + j]);
                else { epi_store(g, row, pn, tx * 8 + j, acc[i][j], 0.f); epi_store(g, row, pn, 128 + tx * 8 + j, acc[i][8 + j], 0.f); }
            }
        }
    }
}
__device__ __forceinline__ GemmArgs mkgemm(const bf16_t* A, int lda, const bf16_t* Bt, int ldb, int M, int N, int K, int epi, void* out, int ldc,
                                           const float* res = nullptr, const float* aux = nullptr, const bf16_t* y1 = nullptr, const bf16_t* y2 = nullptr, const float* bias = nullptr) {
    GemmArgs g; g.A = A; g.lda = lda; g.Bt = Bt; g.ldb = ldb; g.M = M; g.N = N; g.K = K; g.epi = epi; g.out = out; g.ldc = ldc; g.res = res; g.aux = aux; g.y1 = y1; g.y2 = y2; g.bias = bias; return g;
}

template <int EPI>
__device__ __forceinline__ void epi_tile(const GemmArgs& g, const f32x4 (&acc)[2][2][4][2], const pg8::Unit& u, int wr, int wc, int fr, int fq) {
    const int row0 = u.pm * 256 + wr * 64 + fr;
    if constexpr (EPI == EPI_RESX || EPI == EPI_RES16 || EPI == EPI_PLE16 || EPI == EPI_GLU16) {
        constexpr int NBJ = (EPI == EPI_GLU16) ? 1 : 2;
        const int col0 = (EPI == EPI_GLU16 ? u.pn * 128 : u.pn * 256) + wc * 32 + 8 * fq;
        f32x4 bv[2] = {{0.f, 0.f, 0.f, 0.f}, {0.f, 0.f, 0.f, 0.f}}, bg[2] = {{0.f, 0.f, 0.f, 0.f}, {0.f, 0.f, 0.f, 0.f}};
        if constexpr (EPI == EPI_GLU16) {
#pragma unroll
            for (int n = 0; n < 2; ++n) { bv[n] = *(const f32x4*)(g.bias + col0 + 4 * n); bg[n] = *(const f32x4*)(g.bias + 1024 + col0 + 4 * n); }
        }
#pragma unroll
        for (int ai = 0; ai < 2; ++ai)
#pragma unroll
            for (int m = 0; m < 4; ++m) {
                const int row = row0 + ai * 128 + m * 16;
#pragma unroll
                for (int bj = 0; bj < NBJ; ++bj) {
                    const size_t o = (size_t)row * g.ldc + col0 + bj * 128;
                    f32x4 r0, r1;
                    if constexpr (EPI == EPI_RESX) { r0 = *(const f32x4*)(g.res + o); r1 = *(const f32x4*)(g.res + o + 4); }
                    else { const u32x4 rr = *(const u32x4*)((const bf16_t*)g.res + o); r0 = bf4lo(rr[0], rr[1]); r1 = bf4lo(rr[2], rr[3]); }
                    f32x4 v0 = acc[ai][bj][m][0], v1 = acc[ai][bj][m][1];
                    if constexpr (EPI == EPI_PLE16) {
                        const u32x4 aa = *(const u32x4*)((const bf16_t*)g.aux + o); const f32x4 a0 = bf4lo(aa[0], aa[1]), a1 = bf4lo(aa[2], aa[3]);
#pragma unroll
                        for (int j = 0; j < 4; ++j) { v0[j] = a0[j] * fsig(v0[j]); v1[j] = a1[j] * fsig(v1[j]); }
                    }
                    if constexpr (EPI == EPI_GLU16) {
                        const f32x4 g0 = acc[ai][1][m][0] + bg[0], g1 = acc[ai][1][m][1] + bg[1];
                        v0 += bv[0]; v1 += bv[1];
#pragma unroll
                        for (int j = 0; j < 4; ++j) { v0[j] *= fsig(g0[j]); v1[j] *= fsig(g1[j]); }
                    }
                    v0 += r0; v1 += r1;
                    u32x4 w; w.x = pg8::cvt_pk_bf16(v0[0], v0[1]); w.y = pg8::cvt_pk_bf16(v0[2], v0[3]); w.z = pg8::cvt_pk_bf16(v1[0], v1[1]); w.w = pg8::cvt_pk_bf16(v1[2], v1[3]);
                    *(u32x4*)((bf16_t*)g.out + o) = w;
                }
                asm volatile("" ::: "memory");
            }
    } else if constexpr (EPI == EPI_BF16 || EPI == EPI_ZGATE) {
        const int col0 = u.pn * 256 + wc * 32 + 8 * fq;
#pragma unroll
        for (int ai = 0; ai < 2; ++ai)
#pragma unroll
            for (int m = 0; m < 4; ++m) {
                const int row = row0 + ai * 128 + m * 16;
#pragma unroll
                for (int bj = 0; bj < 2; ++bj) {
                    f32x4 v0 = acc[ai][bj][m][0], v1 = acc[ai][bj][m][1];
                    const int col = col0 + bj * 128;
                    if constexpr (EPI == EPI_ZGATE) {
                        const u32x4 a = *(const u32x4*)(g.y1 + (size_t)row * 2048 + col), b = *(const u32x4*)(g.y2 + (size_t)row * 2048 + col);
                        const f32x4 y0 = bf4lo(a[0], a[1]) + bf4lo(b[0], b[1]), y1v = bf4lo(a[2], a[3]) + bf4lo(b[2], b[3]);
#pragma unroll
                        for (int j = 0; j < 4; ++j) { v0[j] = y0[j] * v0[j] * fsig(v0[j]); v1[j] = y1v[j] * v1[j] * fsig(v1[j]); }
                    }
                    u32x4 w; w.x = pg8::cvt_pk_bf16(v0[0], v0[1]); w.y = pg8::cvt_pk_bf16(v0[2], v0[3]); w.z = pg8::cvt_pk_bf16(v1[0], v1[1]); w.w = pg8::cvt_pk_bf16(v1[2], v1[3]);
                    *(u32x4*)((bf16_t*)g.out + (size_t)row * g.ldc + col) = w;
                }
                if constexpr (EPI == EPI_ZGATE) asm volatile("" ::: "memory");
            }
    } else if constexpr (EPI == EPI_GLU) {
        const int col0 = u.pn * 128 + wc * 32 + 4 * fq;
        f32x4 bv[2], bg[2];
#pragma unroll
        for (int n = 0; n < 2; ++n) { bv[n] = *(const f32x4*)(g.bias + col0 + 16 * n); bg[n] = *(const f32x4*)(g.bias + 1024 + col0 + 16 * n); }
#pragma unroll
        for (int ai = 0; ai < 2; ++ai)
#pragma unroll
            for (int m = 0; m < 4; ++m) {
                const int row = row0 + ai * 128 + m * 16;
#pragma unroll
                for (int n = 0; n < 2; ++n) {
                    const size_t o = (size_t)row * g.ldc + col0 + 16 * n;
                    const f32x4 r = *(const f32x4*)(g.res + o), v = acc[ai][0][m][n] + bv[n], gt = acc[ai][1][m][n] + bg[n];
                    f32x4 ov;
#pragma unroll
                    for (int j = 0; j < 4; ++j) ov[j] = r[j] + v[j] * fsig(gt[j]);
                    *(f32x4*)((float*)g.out + o) = ov;
                }
                asm volatile("" ::: "memory");
            }
    } else {
        const int col0 = u.pn * 256 + wc * 32 + 4 * fq;
#pragma unroll
        for (int ai = 0; ai < 2; ++ai)
#pragma unroll
            for (int m = 0; m < 4; ++m) {
                const int row = row0 + ai * 128 + m * 16;
#pragma unroll
                for (int bj = 0; bj < 2; ++bj)
#pragma unroll
                    for (int n = 0; n < 2; ++n) {
                        const size_t o = (size_t)row * g.ldc + col0 + bj * 128 + n * 16;
                        f32x4 ov = acc[ai][bj][m][n];
                        if constexpr (EPI == EPI_RES) ov += *(const f32x4*)(g.res + o);
                        if constexpr (EPI == EPI_PLE) { const f32x4 r = *(const f32x4*)(g.res + o), a = *(const f32x4*)(g.aux + o);
#pragma unroll
                            for (int j = 0; j < 4; ++j) ov[j] = r[j] + a[j] * fsig(ov[j]); }
                        *(f32x4*)((float*)g.out + o) = ov;
                    }
                if constexpr (EPI != EPI_F32) asm volatile("" ::: "memory");
            }
    }
}

template <int EPI>
__device__ __forceinline__ void gemm_pg8(PG8_LAS unsigned char* lds, const GemmArgs g) {
    using namespace pg8;
    constexpr bool PERM = (EPI == EPI_BF16 || EPI == EPI_ZGATE || EPI == EPI_RESX || EPI == EPI_RES16 || EPI == EPI_PLE16 || EPI == EPI_GLU16);
    const int tid = otid(), wid = __builtin_amdgcn_readfirstlane(tid >> 6), lane = tid & 63, wr = wid >> 2, wc = wid & 3, fr = lane & 15, fq = lane >> 4;
    const int K = g.K, nt = K / BK;
    StaticOrder S; S.init(g.M, g.N, (int)gridDim.x, (int)blockIdx.x);
    unsigned voffA[2], voffB[2];
#pragma unroll
    for (int i = 0; i < 2; ++i) { int R, C; stage_rc(tid * 16 + i * 8192, R, C); const int Rb = PERM ? ((R & ~31) + perm32(R & 31)) : R;
        voffA[i] = (unsigned)(R * g.lda + C) * 2u; voffB[i] = (unsigned)(Rb * g.ldb + C) * 2u; }
    const size_t kstep = (size_t)(BK * 2);
    const size_t hstepA = (size_t)HALF * g.lda * 2, hstepB = (size_t)HALF * g.ldb * 2;
    const size_t tstepA = 2 * hstepA, tstepB = 2 * hstepB;
    const unsigned ldsw = (unsigned)wid * 1024u;
    const int aoff = lds_byte(wr * 64 + fr, fq * 8), boff = lds_byte(wc * 32 + fr, fq * 8);
#define PG8_SA(b, h) (((b) * 2 + (h)) * HTB)
#define PG8_SB(b, h) ((4 + (b) * 2 + (h)) * HTB)
#define PG8_STAGE(bufoff, gbase, voff) do { _Pragma("unroll") for (int _i = 0; _i < 2; ++_i) \
        __builtin_amdgcn_global_load_lds((const unsigned*)((const char*)(gbase) + (voff)[_i]), (PG8_LAS unsigned*)(lds + (bufoff) + ldsw + _i * 8192), 16, 0, 0); } while (0)
#define PG8_LDA(dst, b, h) do { _Pragma("unroll") for (int m = 0; m < 4; ++m) _Pragma("unroll") for (int k = 0; k < 2; ++k) dst[m][k] = *(const PG8_LAS bf16x8*)(lds + PG8_SA(b, h) + aoff + m * 2048 + k * 1024); } while (0)
#define PG8_LDB(dst, b, h) do { _Pragma("unroll") for (int n = 0; n < 2; ++n) _Pragma("unroll") for (int k = 0; k < 2; ++k) dst[n][k] = *(const PG8_LAS bf16x8*)(lds + PG8_SB(b, h) + boff + n * 2048 + k * 1024); } while (0)
#define PG8_MMA(ai, bj, At, Bt) do { __builtin_amdgcn_s_setprio(1); _Pragma("unroll") for (int m = 0; m < 4; ++m) _Pragma("unroll") for (int n = 0; n < 2; ++n) _Pragma("unroll") for (int k = 0; k < 2; ++k) \
        acc[ai][bj][m][n] = __builtin_amdgcn_mfma_f32_16x16x32_bf16(Bt[n][k], At[m][k], acc[ai][bj][m][n], 0, 0, 0); __builtin_amdgcn_s_setprio(0); } while (0)
#define PG8_WAIT_V(n) asm volatile("s_waitcnt vmcnt(" #n ")" ::: "memory")
#define PG8_WAIT_L(n) asm volatile("s_waitcnt lgkmcnt(" #n ")" ::: "memory")
#define PG8_BAR __builtin_amdgcn_s_barrier()
#define PG8_SCHED __builtin_amdgcn_sched_barrier(0)
    Unit cur, nxt; int ui = 0;
    if (!S.next(0, cur)) return;
    f32x4 acc[2][2][4][2];
#pragma unroll
    for (int a = 0; a < 2; ++a)
#pragma unroll
        for (int b = 0; b < 2; ++b)
#pragma unroll
            for (int m = 0; m < 4; ++m)
#pragma unroll
                for (int n = 0; n < 2; ++n) acc[a][b][m][n] = (f32x4){0.f, 0.f, 0.f, 0.f};
    bf16x8 At[4][2], B0[2][2], B1[2][2];
    const char* cA = (const char*)g.A + (size_t)cur.pm * tstepA; const char* cB = (const char*)g.Bt + (size_t)cur.pn * tstepB;
    PG8_STAGE(PG8_SB(0, 0), cB, voffB); PG8_STAGE(PG8_SA(0, 0), cA, voffA); PG8_STAGE(PG8_SB(0, 1), cB + hstepB, voffB); PG8_STAGE(PG8_SA(0, 1), cA + hstepA, voffA);
    if (wr == 1) PG8_BAR;
    PG8_WAIT_V(4); PG8_BAR;
    PG8_STAGE(PG8_SB(1, 0), cB + kstep, voffB); PG8_STAGE(PG8_SA(1, 0), cA + kstep, voffA); PG8_STAGE(PG8_SB(1, 1), cB + hstepB + kstep, voffB);
    PG8_WAIT_V(6); PG8_BAR;
    for (;;) {
        const bool has_next = S.next(ui + 1, nxt);
        const char* nA = has_next ? (const char*)g.A + (size_t)nxt.pm * tstepA : cA; const char* nB = has_next ? (const char*)g.Bt + (size_t)nxt.pn * tstepB : cB;
        for (int t = 0; t < nt; t += 2) {
            const bool last = (t == nt - 2);
            const char* a1 = cA + (size_t)(t + 1) * kstep;
            const char* a2 = last ? nA : cA + (size_t)(t + 2) * kstep; const char* b2 = last ? nB : cB + (size_t)(t + 2) * kstep;
            const char* a3 = a2 + kstep; const char* b3 = b2 + kstep;
            PG8_LDB(B0, 0, 0); PG8_SCHED; PG8_LDA(At, 0, 0); PG8_STAGE(PG8_SA(1, 1), a1 + hstepA, voffA);
            PG8_WAIT_L(8); PG8_BAR; PG8_WAIT_L(0); PG8_MMA(0, 0, At, B0); PG8_BAR; PG8_SCHED;
            PG8_LDB(B1, 0, 1); PG8_STAGE(PG8_SB(0, 0), b2, voffB);
            PG8_BAR; PG8_WAIT_L(0); PG8_MMA(0, 1, At, B1); PG8_BAR;
            PG8_LDA(At, 0, 1); PG8_STAGE(PG8_SA(0, 0), a2, voffA);
            PG8_BAR; PG8_WAIT_L(0); PG8_MMA(1, 0, At, B0); PG8_BAR; PG8_SCHED;
            PG8_STAGE(PG8_SB(0, 1), b2 + hstepB, voffB);
            PG8_WAIT_V(6); PG8_BAR; PG8_MMA(1, 1, At, B1); PG8_BAR;
            PG8_LDB(B0, 1, 0); PG8_SCHED; PG8_LDA(At, 1, 0); PG8_STAGE(PG8_SA(0, 1), a2 + hstepA, voffA);
            PG8_WAIT_L(8); PG8_BAR; PG8_WAIT_L(0); PG8_MMA(0, 0, At, B0); PG8_BAR; PG8_SCHED;
            PG8_LDB(B1, 1, 1); PG8_STAGE(PG8_SB(1, 0), b3, voffB);
            PG8_BAR; PG8_WAIT_L(0); PG8_MMA(0, 1, At, B1); PG8_BAR;
            PG8_LDA(At, 1, 1); PG8_STAGE(PG8_SA(1, 0), a3, voffA);
            PG8_BAR; PG8_WAIT_L(0); PG8_MMA(1, 0, At, B0); PG8_BAR; PG8_SCHED;
            PG8_STAGE(PG8_SB(1, 1), b3 + hstepB, voffB);
            PG8_WAIT_V(6); PG8_BAR; PG8_MMA(1, 1, At, B1); PG8_BAR;
        }
        epi_tile<EPI>(g, acc, cur, wr, wc, fr, fq);
        if (!has_next) break;
#pragma unroll
        for (int a = 0; a < 2; ++a)
#pragma unroll
            for (int b = 0; b < 2; ++b)
#pragma unroll
                for (int m = 0; m < 4; ++m)
#pragma unroll
                    for (int n = 0; n < 2; ++n) acc[a][b][m][n] = (f32x4){0.f, 0.f, 0.f, 0.f};
        cur = nxt; cA = nA; cB = nB; ++ui;
    }
    PG8_WAIT_V(0);
    if (wr == 0) PG8_BAR;
    PG8_BAR;
#undef PG8_SA
#undef PG8_SB
#undef PG8_STAGE
#undef PG8_LDA
#undef PG8_LDB
#undef PG8_MMA
#undef PG8_WAIT_V
#undef PG8_WAIT_L
#undef PG8_BAR
#undef PG8_SCHED
}

__device__ __forceinline__ void ph_ssd_halo(const Params& P) {
    bf16_t* proj = (bf16_t*)(P.ws + OFF_R); bf16_t* halo = (bf16_t*)(P.ws + OFF_SMALL);
    const int gt = blockIdx.x * NT + threadIdx.x, gs = gridDim.x * NT;
    for (int i = gt; i < 512 * 4 * 256; i += gs) {
        const int ch = i & 255, hr = (i >> 8) & 3, item = i >> 10;
        const int g = item & 3, c = (item >> 2) & 31, b = item >> 7;
        const int lt = c * 128 + (hr < 2 ? hr - 2 : 126 + hr);
        const int col = 2048 + (ch >> 7) * 512 + g * 128 + (ch & 127);
        bf16_t v = 0;
        if (lt >= 0 && lt < SEQ) v = proj[(size_t)(b * SEQ + lt) * LDP + col];
        halo[i] = v;
    }
    for (int i = gt; i < T_TOK * 64; i += gs) {
        const int j = i & 63, t = i >> 6;
        const float xr = bf2f(proj[(size_t)t * LDP + 3072 + j]) + P.ssd_dt_bias[j];
        const float sp = fmaxf(xr, 0.f) + log1pf(__expf(-fabsf(xr)));
        ((float*)(proj + (size_t)t * LDP + 3136))[j] = sp;
    }
}
constexpr size_t OFF_CB = OFF_R + 104 * MiB;
__device__ __forceinline__ void ph_ssd_bcconv(const Params& P, unsigned char* ldsraw) {
    bf16_t* proj = (bf16_t*)(P.ws + OFF_R); const bf16_t* halo = (const bf16_t*)(P.ws + OFF_SMALL); bf16_t* CBg = (bf16_t*)(P.ws + OFF_CB);
    bf16_t* tile = (bf16_t*)ldsraw;
    bf16_t* cv = tile + 132 * 256;
    const int tid = threadIdx.x, lane = tid & 63, wid = tid >> 6, fr = lane & 15, q = lane >> 4;
    for (int item = blockIdx.x; item < 512; item += gridDim.x) {
        const int g = item & 3, c = (item >> 2) & 31, b = item >> 7;
        const size_t r0 = (size_t)b * SEQ + c * 128;
        __syncthreads();
        for (int i = tid; i < 132 * 32; i += NT) {
            const int co = i & 31, r = i >> 5, ch = co * 8;
            const int col = 2048 + (ch >> 7) * 512 + g * 128 + (ch & 127);
            u32x4 v;
            if (r < 2) v = *(const u32x4*)(halo + (size_t)item * 1024 + r * 256 + ch);
            else if (r >= 130) v = *(const u32x4*)(halo + (size_t)item * 1024 + (r - 128) * 256 + ch);
            else v = *(const u32x4*)(proj + (r0 + r - 2) * LDP + col);
            *(u32x4*)(tile + r * 256 + ch) = v;
        }
        __syncthreads();
        for (int i = tid; i < 128 * 32; i += NT) {
            const int co = i & 31, r = i >> 5, ch = co * 8;
            const int col = 2048 + (ch >> 7) * 512 + g * 128 + (ch & 127);
            float acc[8];
            { const f32x4 b0 = *(const f32x4*)(P.ssd_conv_b + col), b1 = *(const f32x4*)(P.ssd_conv_b + col + 4);
#pragma unroll
              for (int j = 0; j < 4; ++j) { acc[j] = b0[j]; acc[4 + j] = b1[j]; } }
#pragma unroll
            for (int k = 0; k < 5; ++k) {
                float xv[8]; unpack8(*(const u32x4*)(tile + (r + k) * 256 + ch), xv);
                const f32x4 w0 = *(const f32x4*)(P.ssd_conv_w + k * 3072 + col), w1 = *(const f32x4*)(P.ssd_conv_w + k * 3072 + col + 4);
#pragma unroll
                for (int j = 0; j < 4; ++j) { acc[j] += xv[j] * w0[j]; acc[4 + j] += xv[4 + j] * w1[j]; }
            }
            u32x4 o;
#pragma unroll
            for (int j = 0; j < 4; ++j) o[j] = pg8::cvt_pk_bf16(acc[2 * j] * fsig(acc[2 * j]), acc[2 * j + 1] * fsig(acc[2 * j + 1]));
            *(u32x4*)(cv + r * 264 + ch) = o;
            if (ch >= 128) *(u32x4*)(proj + (r0 + r) * LDP + col) = o;
        }
        __syncthreads();
        for (int i = tid; i < 2048; i += NT) {
            const int n = i >> 4, to = (i & 15) * 8; u32x4 o;
#pragma unroll
            for (int j = 0; j < 4; ++j) o[j] = (unsigned)cv[(to + 2 * j) * 264 + n] | ((unsigned)cv[(to + 2 * j + 1) * 264 + n] << 16);
            *(u32x4*)(proj + (r0 + n) * LDP + 2048 + g * 128 + to) = o;
        }
        bf16x8 af[4];
#pragma unroll
        for (int ks = 0; ks < 4; ++ks) af[ks] = *(const bf16x8*)(cv + (16 * wid + fr) * 264 + 32 * ks + 8 * q);
        bf16_t* cbo = CBg + (size_t)item * 16384;
#pragma unroll
        for (int lt = 0; lt < 8; ++lt) {
            f32x4 acc = {0.f, 0.f, 0.f, 0.f};
#pragma unroll
            for (int ks = 0; ks < 4; ++ks) { const bf16x8 bfr = *(const bf16x8*)(cv + (16 * lt + fr) * 264 + 128 + 32 * ks + 8 * q); acc = __builtin_amdgcn_mfma_f32_16x16x32_bf16(af[ks], bfr, acc, 0, 0, 0); }
            u32x2 o; o.x = pg8::cvt_pk_bf16(acc[0], acc[1]); o.y = pg8::cvt_pk_bf16(acc[2], acc[3]);
            *(u32x2*)(cbo + (16 * lt + fr) * 128 + 16 * wid + 4 * q) = o;
        }
    }
}
__device__ __forceinline__ void ph_ssd_scan_naive(const Params& P, unsigned char* ldsraw) {
    const bf16_t* proj = (const bf16_t*)(P.ws + OFF_R);
    bf16_t* Bs = (bf16_t*)ldsraw;
    bf16_t* Cs = Bs + 64 * 128;
    float* xs = (float*)(Cs + 64 * 128);
    float* dts = xs + 64 * 64;
    const int tid = threadIdx.x, p = tid >> 3, ng = tid & 7;
    for (int item = blockIdx.x; item < 256; item += gridDim.x) {
        const int d = item & 1, hh = (item >> 1) & 31, b = item >> 6, g = hh >> 3;
        const float a = -__expf(P.ssd_a_log[d * 32 + hh]), dsk = P.ssd_d[hh];
        bf16_t* Y = d ? (bf16_t*)P.out : (bf16_t*)(P.ws + OFF_YF);
        float h[16];
#pragma unroll
        for (int j = 0; j < 16; ++j) h[j] = 0.f;
        for (int blk = 0; blk < SEQ / 64; ++blk) {
            __syncthreads();
            for (int i = tid; i < 64 * 128; i += NT) {
                const int n = i & 127, r = i >> 7; const int lt = d ? SEQ - 1 - (blk * 64 + r) : blk * 64 + r;
                const size_t ro = (size_t)(b * SEQ + lt) * LDP;
                Bs[i] = proj[(size_t)(b * SEQ + (lt & ~127) + n) * LDP + 2048 + g * 128 + (lt & 127)]; Cs[i] = proj[ro + 2560 + g * 128 + n];
            }
            for (int i = tid; i < 64 * 64; i += NT) {
                const int pp = i & 63, r = i >> 6; const int lt = d ? SEQ - 1 - (blk * 64 + r) : blk * 64 + r;
                const int col = hh * 64 + pp;
                float acc = P.ssd_conv_b[col];
#pragma unroll
                for (int k = 0; k < 5; ++k) { const int l2 = lt + k - 2; if (l2 >= 0 && l2 < SEQ) acc += bf2f(proj[(size_t)(b * SEQ + l2) * LDP + col]) * P.ssd_conv_w[k * 3072 + col]; }
                xs[i] = siluf(acc);
            }
            if (tid < 64) { const int lt = d ? SEQ - 1 - (blk * 64 + tid) : blk * 64 + tid; dts[tid] = ((const float*)(proj + (size_t)(b * SEQ + lt) * LDP + 3136))[d * 32 + hh]; }
            __syncthreads();
            for (int r = 0; r < 64; ++r) {
                const float dt = dts[r], xv = xs[r * 64 + p], dA = __expf(dt * a), dx = dt * xv;
                float part = 0.f;
#pragma unroll
                for (int j = 0; j < 16; ++j) { h[j] = h[j] * dA + dx * bf2f(Bs[r * 128 + ng * 16 + j]); part += bf2f(Cs[r * 128 + ng * 16 + j]) * h[j]; }
                part += __shfl_xor(part, 1); part += __shfl_xor(part, 2); part += __shfl_xor(part, 4);
                if (ng == 0) { const int lt = d ? SEQ - 1 - (blk * 64 + r) : blk * 64 + r; Y[(size_t)(b * SEQ + lt) * 2048 + hh * 64 + p] = f2bf(part + (d == 0 ? dsk * xv : 0.f)); }
            }
        }
    }
}
#define LDS_BAR() do { asm volatile("s_waitcnt lgkmcnt(0)" ::: "memory"); __builtin_amdgcn_s_barrier(); asm volatile("" ::: "memory"); } while (0)
__device__ __forceinline__ void ph_ssd_scan(const Params& P, unsigned char* ldsraw) {
    const bf16_t* proj = (const bf16_t*)(P.ws + OFF_R); const bf16_t* CBg = (const bf16_t*)(P.ws + OFF_CB);
    bf16_t* xdT = (bf16_t*)ldsraw;
    bf16_t* xdwT = xdT + 64 * 144;
    bf16_t* stb = xdwT + 64 * 144;
    bf16_t* xraw = stb + 64 * 144;
    float* cs = (float*)(xraw + 132 * 72);
    float* dts = cs + 128;
    float* tot = dts + 128;
    float* cwl = tot + 4;
    float* csA = cwl + 384;
    float* dtsA = csA + 32 * 128;
    float* totA = dtsA + 32 * 128;
    const int tid = threadIdx.x, lane = tid & 63, wid = tid >> 6, fr = lane & 15, q = lane >> 4;
    const int ltile = (wid < 4) ? wid : 11 - wid;
    for (int item = blockIdx.x; item < 256; item += gridDim.x) {
        const int d = item & 1, hh = (item >> 1) & 31, b = item >> 6, g = hh >> 3;
        const float a = -__expf(P.ssd_a_log[d * 32 + hh]), dsk = P.ssd_d[hh];
        bf16_t* Y = d ? (bf16_t*)P.out : (bf16_t*)(P.ws + OFF_YF);
        __syncthreads();
        for (int i = tid; i < 384; i += NT) cwl[i] = (i < 320) ? P.ssd_conv_w[(i >> 6) * 3072 + hh * 64 + (i & 63)] : P.ssd_conv_b[hh * 64 + i - 320];
        for (int k4 = 0; k4 < 4; ++k4) {
            const int cc = wid + 8 * k4; const size_t t0_ = (size_t)b * SEQ + cc * 128;
            const float dta = ((const float*)(proj + (t0_ + 2 * lane) * LDP + 3136))[d * 32 + hh], dtb = ((const float*)(proj + (t0_ + 2 * lane + 1) * LDP + 3136))[d * 32 + hh];
            const float ad0 = dta * a * 1.4426950408889634f, ad1 = dtb * a * 1.4426950408889634f, v = ad0 + ad1; float inc = v;
#pragma unroll
            for (int o = 1; o < 64; o <<= 1) { const float t = __shfl_up(inc, o); if (lane >= o) inc += t; }
            const float excl = inc - v, totl = __shfl(inc, 63);
            if (d == 0) { csA[cc * 128 + 2 * lane] = excl + ad0; csA[cc * 128 + 2 * lane + 1] = inc; } else { csA[cc * 128 + 2 * lane] = totl - excl; csA[cc * 128 + 2 * lane + 1] = totl - excl - ad0; }
            dtsA[cc * 128 + 2 * lane] = dta; dtsA[cc * 128 + 2 * lane + 1] = dtb; if (lane == 0) totA[cc] = totl;
        }
        f32x4 st[4];
#pragma unroll
        for (int pt = 0; pt < 4; ++pt) st[pt] = (f32x4){0.f, 0.f, 0.f, 0.f};
        u32x4 xp[3]; u32x4 cbv[4]; bf16x8 cmf[4], btf[4];
        const int whs = __builtin_amdgcn_readfirstlane(ltile) >> 1;
#pragma unroll
        for (int k0_ = 0; k0_ < 4; ++k0_) cbv[k0_] = (u32x4){0u, 0u, 0u, 0u};
#define SCAN_LOAD_A(cc) do { const size_t t0_ = (size_t)b * SEQ + (cc) * 128; \
            _Pragma("unroll") for (int e_ = 0; e_ < 3; ++e_) { const int i_ = tid + e_ * NT; const int r_ = i_ >> 3, pc_ = (i_ & 7) * 8; const int lt_ = (cc) * 128 + r_ - 2; \
                xp[e_] = (u32x4){0u, 0u, 0u, 0u}; if (i_ < 132 * 8 && lt_ >= 0 && lt_ < SEQ) xp[e_] = *(const u32x4*)(proj + ((size_t)b * SEQ + lt_) * LDP + hh * 64 + pc_); } } while (0)
#define SCAN_LOAD_C(cc) do { const size_t t0_ = (size_t)b * SEQ + (cc) * 128; const int l_ = 16 * ltile + fr, n_ = 16 * wid + fr; \
            const bf16_t* cbrow_ = CBg + (size_t)((b * 32 + (cc)) * 4 + g) * 16384 + l_ * 128 + 8 * q; const bf16_t* cmrow_ = proj + (t0_ + l_) * LDP + 2560 + g * 128 + 8 * q; \
            const bf16_t* btrow_ = proj + (t0_ + n_) * LDP + 2048 + g * 128 + 8 * q; \
            _Pragma("unroll") for (int ks_ = 0; ks_ < 4; ++ks_) { if (d ? (ks_ >= whs) : (ks_ <= whs)) cbv[ks_] = *(const u32x4*)(cbrow_ + 32 * ks_); cmf[ks_] = *(const bf16x8*)(cmrow_ + 32 * ks_); btf[ks_] = *(const bf16x8*)(btrow_ + 32 * ks_); } } while (0)
#define SCAN_CH(i_) (d ? 31 - ((i_) < 31 ? (i_) : 31) : ((i_) < 31 ? (i_) : 31))
#define SCAN_XRAW_WRITE() do { _Pragma("unroll") for (int e = 0; e < 3; ++e) { const int i = tid + e * NT; if (i < 132 * 8) *(u32x4*)(xraw + (i >> 3) * 72 + (i & 7) * 8) = xp[e]; } } while (0)
        { const int c0_ = SCAN_CH(0), c1_ = SCAN_CH(1); SCAN_LOAD_A(c0_); SCAN_LOAD_C(c0_); SCAN_XRAW_WRITE(); SCAN_LOAD_A(c1_); }
        __syncthreads();
        for (int ci = 0; ci < 32; ++ci) {
            const int c = d ? 31 - ci : ci; const size_t tok0 = (size_t)b * SEQ + c * 128;
            const int cn = SCAN_CH(ci + 1), cnn = SCAN_CH(ci + 2);
            const float* cs = csA + c * 128; const float* dts = dtsA + c * 128;
#pragma unroll
            for (int pt = 0; pt < 4; ++pt) { u32x2 o; o.x = pg8::cvt_pk_bf16(st[pt][0], st[pt][1]); o.y = pg8::cvt_pk_bf16(st[pt][2], st[pt][3]); *(u32x2*)(stb + (16 * pt + fr) * 144 + 16 * wid + 4 * q) = o; }
            const float total = totA[c];
            {
                const int tp = tid & 63, oc = (tid >> 6) * 8;
                float w5[5][8], accA[8], accB[8];
#pragma unroll
                for (int k = 0; k < 5; ++k) { const f32x4 w0 = *(const f32x4*)(cwl + k * 64 + oc), w1 = *(const f32x4*)(cwl + k * 64 + oc + 4);
#pragma unroll
                    for (int j = 0; j < 4; ++j) { w5[k][j] = w0[j]; w5[k][4 + j] = w1[j]; } }
                { const f32x4 b0 = *(const f32x4*)(cwl + 320 + oc), b1 = *(const f32x4*)(cwl + 320 + oc + 4);
#pragma unroll
                  for (int j = 0; j < 4; ++j) { accA[j] = b0[j]; accA[4 + j] = b1[j]; accB[j] = b0[j]; accB[4 + j] = b1[j]; } }
#pragma unroll
                for (int k = 0; k < 6; ++k) {
                    float xr[8]; unpack8(*(const u32x4*)(xraw + (2 * tp + k) * 72 + oc), xr);
#pragma unroll
                    for (int j = 0; j < 8; ++j) { if (k < 5) accA[j] += xr[j] * w5[k < 5 ? k : 0][j]; if (k > 0) accB[j] += xr[j] * w5[k > 0 ? k - 1 : 0][j]; }
                }
                const float dtA = dts[2 * tp], dtB = dts[2 * tp + 1], wA = __builtin_amdgcn_exp2f(total - cs[2 * tp]), wB = __builtin_amdgcn_exp2f(total - cs[2 * tp + 1]);
#pragma unroll
                for (int j = 0; j < 8; ++j) {
                    const float xa = accA[j] * fsig(accA[j]) * dtA, xb_ = accB[j] * fsig(accB[j]) * dtB;
                    ((unsigned*)(xdT + (oc + j) * 144))[tp] = pg8::cvt_pk_bf16(xa, xb_);
                    ((unsigned*)(xdwT + (oc + j) * 144))[tp] = pg8::cvt_pk_bf16(xa * wA, xb_ * wB);
                }
            }
            LDS_BAR();
            {
                int l = 16 * ltile + fr; asm volatile("" : "+v"(l));
                const float csl = cs[l], el = __builtin_amdgcn_exp2f(csl), ddt = dsk * __builtin_amdgcn_rcpf(dts[l]);
                f32x4 y2[4], y3[4];
#pragma unroll
                for (int pt = 0; pt < 4; ++pt) { y2[pt] = (f32x4){0.f, 0.f, 0.f, 0.f}; y3[pt] = (f32x4){0.f, 0.f, 0.f, 0.f}; }
                const int whalf = __builtin_amdgcn_readfirstlane(ltile) >> 1;
#pragma unroll
                for (int ks = 0; ks < 4; ++ks) {
                  if (d ? (ks >= whalf) : (ks <= whalf)) {
                    const f32x4 c0 = *(const f32x4*)(cs + 32 * ks + 8 * q), c1 = *(const f32x4*)(cs + 32 * ks + 8 * q + 4);
                    float gv[8];
#pragma unroll
                    for (int j = 0; j < 8; ++j) {
                        const int sx = 32 * ks + 8 * q + j; const float cb = (j & 1) ? __uint_as_float(cbv[ks][j >> 1] & 0xffff0000u) : __uint_as_float(cbv[ks][j >> 1] << 16);
                        const float css = (j < 4) ? c0[j & 3] : c1[j & 3];
                        float val = cb * __builtin_amdgcn_exp2f(csl - css);
                        if (ks == whalf) {
                            const bool keep = d ? (sx >= l) : (sx <= l);
                            val = keep ? val : 0.f;
                            if (d == 0 && sx == l) val += ddt;
                        }
                        gv[j] = val;
                    }
                    union { u32x4 u; bf16x8 h; } gf; gf.u = (u32x4){pg8::cvt_pk_bf16(gv[0], gv[1]), pg8::cvt_pk_bf16(gv[2], gv[3]), pg8::cvt_pk_bf16(gv[4], gv[5]), pg8::cvt_pk_bf16(gv[6], gv[7])};
#pragma unroll
                    for (int pt = 0; pt < 4; ++pt) { const bf16x8 xf = *(const bf16x8*)(xdT + (16 * pt + fr) * 144 + 32 * ks + 8 * q); y2[pt] = __builtin_amdgcn_mfma_f32_16x16x32_bf16(xf, gf.h, y2[pt], 0, 0, 0); }
                  }
#pragma unroll
                    for (int pt = 0; pt < 4; ++pt) { const bf16x8 sf = *(const bf16x8*)(stb + (16 * pt + fr) * 144 + 32 * ks + 8 * q); y3[pt] = __builtin_amdgcn_mfma_f32_16x16x32_bf16(sf, cmf[ks], y3[pt], 0, 0, 0); }
                }
#pragma unroll
                for (int pt = 0; pt < 4; ++pt) {
                    const f32x4 v = y2[pt] + el * y3[pt]; u32x2 o; o.x = pg8::cvt_pk_bf16(v[0], v[1]); o.y = pg8::cvt_pk_bf16(v[2], v[3]);
                    *(u32x2*)(Y + (tok0 + l) * 2048 + hh * 64 + 16 * pt + 4 * q) = o;
                }
                const float etot = __builtin_amdgcn_exp2f(total);
#pragma unroll
                for (int pt = 0; pt < 4; ++pt) st[pt] *= etot;
#pragma unroll
                for (int ks = 0; ks < 4; ++ks) {
#pragma unroll
                    for (int pt = 0; pt < 4; ++pt) { const bf16x8 xf = *(const bf16x8*)(xdwT + (16 * pt + fr) * 144 + 32 * ks + 8 * q); st[pt] = __builtin_amdgcn_mfma_f32_16x16x32_bf16(btf[ks], xf, st[pt], 0, 0, 0); }
                }
            }
            SCAN_LOAD_C(cn);
            SCAN_XRAW_WRITE();
            SCAN_LOAD_A(cnn);
            LDS_BAR();
        }
#undef SCAN_LOAD_A
#undef SCAN_CH
#undef SCAN_XRAW_WRITE
#undef SCAN_LOAD_C
    }
}
__device__ __forceinline__ void ph_gn_scale(const Params& P) {
    bf16_t* proj = (bf16_t*)(P.ws + OFF_R);
    const int lane = threadIdx.x & 63, wid = threadIdx.x >> 6;
    for (int it = blockIdx.x * 8 + wid; it < T_TOK * 4; it += gridDim.x * 8) {
        const int row = it >> 2, grp = it & 3;
        bf16_t* ptr = proj + (size_t)row * LDP + grp * 512 + lane * 8;
        const u32x4 v = *(const u32x4*)ptr; float f[8]; float ss = 0.f;
#pragma unroll
        for (int j = 0; j < 4; ++j) { f[2 * j] = __uint_as_float(v[j] << 16); f[2 * j + 1] = __uint_as_float(v[j] & 0xffff0000u); ss += f[2 * j] * f[2 * j] + f[2 * j + 1] * f[2 * j + 1]; }
        ss = wave_sum(ss);
        const float rstd = rsqrtf(ss * (1.0f / 512.f) + EPS);
        const float* w = P.ssd_norm_w + grp * 512 + lane * 8; u32x4 o;
#pragma unroll
        for (int j = 0; j < 4; ++j) o[j] = pack2(f[2 * j] * rstd * w[2 * j], f[2 * j + 1] * rstd * w[2 * j + 1]);
        *(u32x4*)ptr = o;
    }
}
__device__ __forceinline__ void ph_ffn_conv(const Params& P, int layer, int half) {
    const bf16_t* hup = (const bf16_t*)(P.ws + OFF_R); bf16_t* gout = (bf16_t*)(P.ws + OFF_G);
    const float* cw = P.ffn_conv_w + (size_t)layer * 3 * 5632; const float* cb = P.ffn_conv_b + (size_t)layer * 5632;
    for (int it = blockIdx.x * NT + threadIdx.x; it < (T_TOK / 16) * (FH / 8); it += gridDim.x * NT) {
        const int oc = (it % (FH / 8)) * 8, t0 = (it / (FH / 8)) * 16, lt0 = t0 & (SEQ - 1);
        const int pn = oc >> 7, w = oc & 127, gcol = pn * 256 + w, vcol = gcol + 128;
        const int gch = half * FH + oc, vch = 2816 + gch;
        float wg[3][8], wv[3][8], bg[8], bv[8];
#pragma unroll
        for (int k = 0; k < 3; ++k) {
            const f32x4 a0 = *(const f32x4*)(cw + k * 5632 + gch), a1 = *(const f32x4*)(cw + k * 5632 + gch + 4), c0 = *(const f32x4*)(cw + k * 5632 + vch), c1 = *(const f32x4*)(cw + k * 5632 + vch + 4);
#pragma unroll
            for (int j = 0; j < 4; ++j) { wg[k][j] = a0[j]; wg[k][4 + j] = a1[j]; wv[k][j] = c0[j]; wv[k][4 + j] = c1[j]; }
        }
        { const f32x4 a0 = *(const f32x4*)(cb + gch), a1 = *(const f32x4*)(cb + gch + 4), c0 = *(const f32x4*)(cb + vch), c1 = *(const f32x4*)(cb + vch + 4);
#pragma unroll
          for (int j = 0; j < 4; ++j) { bg[j] = a0[j]; bg[4 + j] = a1[j]; bv[j] = c0[j]; bv[4 + j] = c1[j]; } }
        const bf16_t* base = hup + (size_t)t0 * 2816;
        float gp[8], vp[8], gc[8], vc[8];
        const u32x4 z4 = {0u, 0u, 0u, 0u};
        unpack8(lt0 > 0 ? *(const u32x4*)(base - 2816 + gcol) : z4, gp); unpack8(lt0 > 0 ? *(const u32x4*)(base - 2816 + vcol) : z4, vp);
        unpack8(*(const u32x4*)(base + gcol), gc); unpack8(*(const u32x4*)(base + vcol), vc);
#pragma unroll
        for (int i = 0; i < 16; ++i) {
            float gn[8], vn[8];
            const bool has = (lt0 + i + 1 < SEQ);
            unpack8(has ? *(const u32x4*)(base + (size_t)(i + 1) * 2816 + gcol) : z4, gn); unpack8(has ? *(const u32x4*)(base + (size_t)(i + 1) * 2816 + vcol) : z4, vn);
            u32x4 o;
#pragma unroll
            for (int j = 0; j < 4; ++j) {
                const float g0 = bg[2 * j] + wg[0][2 * j] * gp[2 * j] + wg[1][2 * j] * gc[2 * j] + wg[2][2 * j] * gn[2 * j];
                const float g1 = bg[2 * j + 1] + wg[0][2 * j + 1] * gp[2 * j + 1] + wg[1][2 * j + 1] * gc[2 * j + 1] + wg[2][2 * j + 1] * gn[2 * j + 1];
                const float v0 = bv[2 * j] + wv[0][2 * j] * vp[2 * j] + wv[1][2 * j] * vc[2 * j] + wv[2][2 * j] * vn[2 * j];
                const float v1 = bv[2 * j + 1] + wv[0][2 * j + 1] * vp[2 * j + 1] + wv[1][2 * j + 1] * vc[2 * j + 1] + wv[2][2 * j + 1] * vn[2 * j + 1];
                o[j] = pg8::cvt_pk_bf16(g0 * fsig(g0) * v0, g1 * fsig(g1) * v1);
            }
            *(u32x4*)(gout + (size_t)(t0 + i) * FH + oc) = o;
#pragma unroll
            for (int j = 0; j < 8; ++j) { gp[j] = gc[j]; vp[j] = vc[j]; gc[j] = gn[j]; vc[j] = vn[j]; }
        }
    }
}
__device__ __forceinline__ void ph_s5_naive(const Params& P) {
    const bf16_t* u = (const bf16_t*)(P.ws + OFF_ABUF); float* scr = (float*)(P.ws + OFF_R); bf16_t* gout = (bf16_t*)(P.ws + OFF_G);
    const int lane = threadIdx.x & 63, wid = threadIdx.x >> 6;
    for (int item = blockIdx.x + gridDim.x * wid; item < 256; item += gridDim.x * 8) {
        const int g = item & 63, b = item >> 6;
        for (int d = 0; d < 2; ++d) {
            const float lr = P.s5_a_re[(d * 64 + g) * 64 + lane], li = P.s5_a_im[(d * 64 + g) * 64 + lane];
            const float step = expf(P.s5_log_step[d * 64 + g]);
            const float mag = expf(lr * step), ang = li * step;
            const double angd = (double)ang, two_pi = 6.283185307179586476925;
            const float angr = (float)(angd - two_pi * rint(angd / two_pi));
            const float lbr = mag * cosf(angr), lbi = mag * sinf(angr);
            const float nr = lbr - 1.0f, den = lr * lr + li * li;
            const float qr = (nr * lr + lbi * li) / den, qi = (lbi * lr - nr * li) / den;
            float Br[16], Bi[16], Cr[16], Ci[16];
#pragma unroll
            for (int h = 0; h < 16; ++h) {
                const float br = P.s5_b_re[(g * 64 + lane) * 16 + h], bi = P.s5_b_im[(g * 64 + lane) * 16 + h];
                Br[h] = qr * br - qi * bi; Bi[h] = qr * bi + qi * br;
                Cr[h] = P.s5_c_re[((d * 64 + g) * 16 + h) * 64 + lane]; Ci[h] = P.s5_c_im[((d * 64 + g) * 16 + h) * 64 + lane];
            }
            float hr = 0.f, hi = 0.f;
            for (int s = 0; s < SEQ; ++s) {
                const int lt = d ? SEQ - 1 - s : s; const size_t tok = (size_t)b * SEQ + lt;
                const float uv = bf2f(u[tok * DM + g * 16 + (lane & 15)]);
                float dr = 0.f, di = 0.f;
#pragma unroll
                for (int h = 0; h < 16; ++h) { const float uh = __shfl(uv, h); dr += Br[h] * uh; di += Bi[h] * uh; }
                const float nhr = lbr * hr - lbi * hi + dr, nhi = lbr * hi + lbi * hr + di; hr = nhr; hi = nhi;
                float yv = 0.f;
#pragma unroll
                for (int h = 0; h < 16; ++h) { const float s1 = wave_sum(hr * Cr[h] - hi * Ci[h]); if ((lane & 15) == h) yv = s1; }
                if (lane < 16) {
                    if (d == 0) scr[tok * DM + g * 16 + lane] = yv;
                    else { const float y = scr[tok * DM + g * 16 + lane] + yv + P.s5_d[g * 16 + lane] * uv;
                           const float ge = 0.5f * y * (1.0f + tanhf(0.7978845608028654f * (y + 0.044715f * y * y * y)));
                           gout[tok * DM + g * 16 + lane] = f2bf(ge); }
                }
            }
        }
    }
}

constexpr size_t OFF_S5M = OFF_R + 96 * MiB;
__device__ __forceinline__ void s5_lambda(const Params& P, int d, int g, int p, float& lbr, float& lbi, float& qr, float& qi) {
    const float lr = P.s5_a_re[(d * 64 + g) * 64 + p], li = P.s5_a_im[(d * 64 + g) * 64 + p];
    const float step = expf(P.s5_log_step[d * 64 + g]);
    const float mag = expf(lr * step), ang = li * step;
    const double angd = (double)ang, two_pi = 6.283185307179586476925;
    const float angr = (float)(angd - two_pi * rint(angd / two_pi));
    lbr = mag * cosf(angr); lbi = mag * sinf(angr);
    const float nr = lbr - 1.0f, den = lr * lr + li * li;
    qr = (nr * lr + lbi * li) / den; qi = (lbi * lr - nr * li) / den;
}
__device__ __forceinline__ void ph_s5_setup(const Params& P, unsigned char* ldsraw) {
    float* pw = (float*)ldsraw;
    float* Bb = pw + 2 * 17 * 64 * 2;
    float* Cc = Bb + 2 * 64 * 16 * 2;
    float* Kt = Cc + 2 * 16 * 64 * 2;
    const int tid = threadIdx.x;
    for (int item = blockIdx.x; item < 256; item += gridDim.x) {
        const int g = item >> 2, part = item & 3;
        bf16_t* A1 = (bf16_t*)(P.ws + OFF_S5M) + (size_t)g * (65536 + 131072); bf16_t* A2 = A1 + 65536;
        __syncthreads();
        if (tid < 128) {
            const int d = tid >> 6, p = tid & 63; float lbr, lbi, qr, qi; s5_lambda(P, d, g, p, lbr, lbi, qr, qi);
            float pr = 1.f, pi = 0.f;
            for (int j = 0; j <= 16; ++j) { pw[((d * 17 + j) * 64 + p) * 2] = pr; pw[((d * 17 + j) * 64 + p) * 2 + 1] = pi; const float t = pr * lbr - pi * lbi; pi = pr * lbi + pi * lbr; pr = t; }
            for (int h = 0; h < 16; ++h) {
                const float br = P.s5_b_re[(g * 64 + p) * 16 + h], bi = P.s5_b_im[(g * 64 + p) * 16 + h];
                Bb[((d * 64 + p) * 16 + h) * 2] = qr * br - qi * bi; Bb[((d * 64 + p) * 16 + h) * 2 + 1] = qr * bi + qi * br;
                Cc[((d * 16 + h) * 64 + p) * 2] = P.s5_c_re[((d * 64 + g) * 16 + h) * 64 + p]; Cc[((d * 16 + h) * 64 + p) * 2 + 1] = P.s5_c_im[((d * 64 + g) * 16 + h) * 64 + p];
            }
        }
        __syncthreads();
        for (int i = tid; i < 16384; i += NT) {
            const int k = i & 255, R = 64 * part + (i >> 8), sx = k >> 4, hp = k & 15, d = R >> 7, ri = (R >> 6) & 1, p = R & 63;
            const int e = d ? sx : 15 - sx;
            const float pr = pw[((d * 17 + e) * 64 + p) * 2], pi = pw[((d * 17 + e) * 64 + p) * 2 + 1], br = Bb[((d * 64 + p) * 16 + hp) * 2], bi = Bb[((d * 64 + p) * 16 + hp) * 2 + 1];
            A1[(size_t)R * 256 + k] = f2bf(ri ? (pr * bi + pi * br) : (pr * br - pi * bi));
        }
        for (int i = tid; i < 2048; i += NT) {
            const int hp = i & 15, hl = (i >> 4) & 3, j = (i >> 6) & 15, d = i >> 10, h = 4 * part + hl;
            float acc = 0.f;
            for (int p = 0; p < 64; ++p) {
                const float pr = pw[((d * 17 + j) * 64 + p) * 2], pi = pw[((d * 17 + j) * 64 + p) * 2 + 1], br = Bb[((d * 64 + p) * 16 + hp) * 2], bi = Bb[((d * 64 + p) * 16 + hp) * 2 + 1];
                const float er = pr * br - pi * bi, ei = pr * bi + pi * br;
                acc += Cc[((d * 16 + h) * 64 + p) * 2] * er - Cc[((d * 16 + h) * 64 + p) * 2 + 1] * ei;
            }
            Kt[i] = acc;
        }
        __syncthreads();
        for (int i = tid; i < 16384; i += NT) {
            const int k = i & 255, rr = i >> 8, tau = rr >> 2, hl = rr & 3, h = 4 * part + hl, row = tau * 16 + h, sx = k >> 4, hp = k & 15;
            float v = 0.f;
            if (sx <= tau) v += Kt[(((tau - sx)) * 4 + hl) * 16 + hp];
            if (sx >= tau) v += Kt[((16 + sx - tau) * 4 + hl) * 16 + hp];
            if (sx == tau && hp == h) v += P.s5_d[g * 16 + h];
            A2[(size_t)row * 512 + k] = f2bf(v);
        }
        for (int i = tid; i < 16384; i += NT) {
            const int kk = i & 255, rr = i >> 8, tau = rr >> 2, h = 4 * part + (rr & 3), row = tau * 16 + h, d = kk >> 7, ri = kk & 1, p = (kk >> 1) & 63;
            const int e = d ? 16 - tau : tau + 1;
            const float pr = pw[((d * 17 + e) * 64 + p) * 2], pi = pw[((d * 17 + e) * 64 + p) * 2 + 1], cr = Cc[((d * 16 + h) * 64 + p) * 2], ci = Cc[((d * 16 + h) * 64 + p) * 2 + 1];
            A2[(size_t)row * 512 + 256 + kk] = f2bf(ri ? -(cr * pi + ci * pr) : (cr * pr - ci * pi));
        }
    }
}
__device__ __forceinline__ void ph_s5_main(const Params& P, unsigned char* ldsraw) {
    const bf16_t* u = (const bf16_t*)(P.ws + OFF_ABUF); float* scr = (float*)(P.ws + OFF_R); bf16_t* gout = (bf16_t*)(P.ws + OFF_G);
    bf16_t* Sc = (bf16_t*)ldsraw;
    float* tbuf = (float*)(ldsraw + 256 * 264 * 2);
    bf16_t* atile = (bf16_t*)(ldsraw + 256 * 264 * 2 + 8192);
    const int tid = threadIdx.x, lane = tid & 63, wid = tid >> 6, fr = lane & 15, q = lane >> 4;
    for (int item = blockIdx.x; item < 256; item += gridDim.x) {
        const int g = (item & 7) + 8 * (item >> 5), b = (item >> 3) & 3;
        const bf16_t* A1 = (const bf16_t*)(P.ws + OFF_S5M) + (size_t)g * (65536 + 131072); const bf16_t* A2 = A1 + 65536;
        float* sl = scr + (size_t)item * 65536;
        bf16x8 uf[2][8];
#pragma unroll
        for (int ct = 0; ct < 2; ++ct)
#pragma unroll
            for (int ks = 0; ks < 8; ++ks) {
                const int c = 32 * wid + 16 * ct + fr; const size_t tok = (size_t)b * SEQ + c * 16 + 2 * ks + (q >> 1);
                uf[ct][ks] = *(const bf16x8*)(u + tok * DM + g * 16 + 8 * (q & 1));
            }
        {
            const int srow = tid >> 5, spc = (tid & 31) * 8;
            *(u32x4*)(atile + srow * 264 + spc) = *(const u32x4*)(A1 + (size_t)srow * 256 + spc);
            u32x4 r0, r1 = *(const u32x4*)(A1 + (size_t)(16 + srow) * 256 + spc), r2 = *(const u32x4*)(A1 + (size_t)(32 + srow) * 256 + spc), r3 = *(const u32x4*)(A1 + (size_t)(48 + srow) * 256 + spc);
            __syncthreads();
#define S5A_STEP(Rt, RL, RW) do { \
                RL = *(const u32x4*)(A1 + (size_t)((((Rt) + 4) & 15) * 16 + srow) * 256 + spc); \
                const bf16_t* at = atile + ((Rt) & 1) * (16 * 264) + fr * 264 + 8 * q; \
                f32x4 a0 = {0.f, 0.f, 0.f, 0.f}, a1 = {0.f, 0.f, 0.f, 0.f}; \
                _Pragma("unroll") for (int ks = 0; ks < 8; ++ks) { const bf16x8 af = *(const bf16x8*)(at + ks * 32); \
                    a0 = __builtin_amdgcn_mfma_f32_16x16x32_bf16(af, uf[0][ks], a0, 0, 0, 0); a1 = __builtin_amdgcn_mfma_f32_16x16x32_bf16(af, uf[1][ks], a1, 0, 0, 0); } \
                *(f32x4*)(sl + (size_t)(32 * wid + fr) * 256 + (Rt) * 16 + 4 * q) = a0; \
                *(f32x4*)(sl + (size_t)(32 * wid + 16 + fr) * 256 + (Rt) * 16 + 4 * q) = a1; \
                *(u32x4*)(atile + (((Rt) + 1) & 1) * (16 * 264) + srow * 264 + spc) = RW; \
                LDS_BAR(); } while (0)
            for (int R4 = 0; R4 < 16; R4 += 4) { S5A_STEP(R4, r0, r1); S5A_STEP(R4 + 1, r1, r2); S5A_STEP(R4 + 2, r2, r3); S5A_STEP(R4 + 3, r3, r0); }
#undef S5A_STEP
        }
        asm volatile("s_waitcnt vmcnt(0)" ::: "memory");
        __syncthreads();
        {
            float L0r, L0i, L1r, L1i, qr_, qi_;
            s5_lambda(P, 0, g, lane, L0r, L0i, qr_, qi_); s5_lambda(P, 1, g, lane, L1r, L1i, qr_, qi_);
#pragma unroll
            for (int i = 0; i < 4; ++i) { float t = L0r * L0r - L0i * L0i; L0i = 2.f * L0r * L0i; L0r = t; t = L1r * L1r - L1i * L1i; L1i = 2.f * L1r * L1i; L1r = t; }
            float h0r = 0.f, h0i = 0.f, h1r = 0.f, h1i = 0.f;
            for (int j0 = 0; j0 < 32; j0 += 8) {
                float x0r[8], x0i[8], x1r[8], x1i[8];
#pragma unroll
                for (int i = 0; i < 8; ++i) { const int j = 32 * wid + j0 + i, c0 = j, c1 = 255 - j;
                    x0r[i] = sl[(size_t)c0 * 256 + lane]; x0i[i] = sl[(size_t)c0 * 256 + 64 + lane]; x1r[i] = sl[(size_t)c1 * 256 + 128 + lane]; x1i[i] = sl[(size_t)c1 * 256 + 192 + lane]; }
#pragma unroll
                for (int i = 0; i < 8; ++i) { float t = L0r * h0r - L0i * h0i + x0r[i]; h0i = L0r * h0i + L0i * h0r + x0i[i]; h0r = t; t = L1r * h1r - L1i * h1i + x1r[i]; h1i = L1r * h1i + L1i * h1r + x1i[i]; h1r = t; }
            }
            *(f32x4*)(tbuf + ((wid * 64 + lane) * 4)) = (f32x4){h0r, h0i, h1r, h1i};
            __syncthreads();
            float P0r = L0r, P0i = L0i, P1r = L1r, P1i = L1i;
#pragma unroll
            for (int i = 0; i < 5; ++i) { float t = P0r * P0r - P0i * P0i; P0i = 2.f * P0r * P0i; P0r = t; t = P1r * P1r - P1i * P1i; P1i = 2.f * P1r * P1i; P1r = t; }
            h0r = 0.f; h0i = 0.f; h1r = 0.f; h1i = 0.f;
            for (int w2 = 0; w2 < wid; ++w2) { const f32x4 tv = *(const f32x4*)(tbuf + ((w2 * 64 + lane) * 4));
                float t = P0r * h0r - P0i * h0i + tv[0]; h0i = P0r * h0i + P0i * h0r + tv[1]; h0r = t; t = P1r * h1r - P1i * h1i + tv[2]; h1i = P1r * h1i + P1i * h1r + tv[3]; h1r = t; }
            for (int j0 = 0; j0 < 32; j0 += 8) {
                float x0r[8], x0i[8], x1r[8], x1i[8];
#pragma unroll
                for (int i = 0; i < 8; ++i) { const int j = 32 * wid + j0 + i, c0 = j, c1 = 255 - j;
                    x0r[i] = sl[(size_t)c0 * 256 + lane]; x0i[i] = sl[(size_t)c0 * 256 + 64 + lane]; x1r[i] = sl[(size_t)c1 * 256 + 128 + lane]; x1i[i] = sl[(size_t)c1 * 256 + 192 + lane]; }
#pragma unroll
                for (int i = 0; i < 8; ++i) { const int j = 32 * wid + j0 + i, c0 = j, c1 = 255 - j;
                    ((unsigned*)(Sc + c0 * 264))[lane] = pg8::cvt_pk_bf16(h0r, h0i); ((unsigned*)(Sc + c1 * 264 + 128))[lane] = pg8::cvt_pk_bf16(h1r, h1i);
                    float t = L0r * h0r - L0i * h0i + x0r[i]; h0i = L0r * h0i + L0i * h0r + x0i[i]; h0r = t; t = L1r * h1r - L1i * h1i + x1r[i]; h1i = L1r * h1i + L1i * h1r + x1i[i]; h1r = t; }
            }
        }
        __syncthreads();
        {
            const int srow = tid >> 5, spc = (tid & 31) * 8;
#define S5C_SRC(h) (A2 + (size_t)((((h) & 31) >> 1) * 16 + srow) * 512 + ((h) & 1) * 256 + spc)
            *(u32x4*)(atile + srow * 264 + spc) = *(const u32x4*)S5C_SRC(0);
            u32x4 r0, r1 = *(const u32x4*)S5C_SRC(1), r2 = *(const u32x4*)S5C_SRC(2), r3 = *(const u32x4*)S5C_SRC(3);
            __syncthreads();
            f32x4 a0 = {0.f, 0.f, 0.f, 0.f}, a1 = {0.f, 0.f, 0.f, 0.f};
#define S5C_STEP(hs, RL, RW) do { \
                RL = *(const u32x4*)S5C_SRC((hs) + 4); \
                const bf16_t* at = atile + ((hs) & 1) * (16 * 264) + fr * 264 + 8 * q; \
                if (((hs) & 1) == 0) { \
                    _Pragma("unroll") for (int ks = 0; ks < 8; ++ks) { const bf16x8 af = *(const bf16x8*)(at + ks * 32); \
                        a0 = __builtin_amdgcn_mfma_f32_16x16x32_bf16(af, uf[0][ks], a0, 0, 0, 0); a1 = __builtin_amdgcn_mfma_f32_16x16x32_bf16(af, uf[1][ks], a1, 0, 0, 0); } \
                } else { \
                    _Pragma("unroll") for (int ks = 0; ks < 8; ++ks) { const bf16x8 af = *(const bf16x8*)(at + ks * 32); \
                        const bf16x8 b0 = *(const bf16x8*)(Sc + (32 * wid + fr) * 264 + ks * 32 + 8 * q), b1 = *(const bf16x8*)(Sc + (32 * wid + 16 + fr) * 264 + ks * 32 + 8 * q); \
                        a0 = __builtin_amdgcn_mfma_f32_16x16x32_bf16(af, b0, a0, 0, 0, 0); a1 = __builtin_amdgcn_mfma_f32_16x16x32_bf16(af, b1, a1, 0, 0, 0); } \
                    const int ch = g * 16 + 4 * q, rt = (hs) >> 1; \
                    _Pragma("unroll") for (int ct = 0; ct < 2; ++ct) { \
                        const int c = 32 * wid + 16 * ct + fr; const size_t tok = (size_t)b * SEQ + c * 16 + rt; \
                        const f32x4 av = ct ? a1 : a0; float y[4]; \
                        _Pragma("unroll") for (int r = 0; r < 4; ++r) { const float yy = av[r]; y[r] = yy * fsig(1.5957691216057308f * (yy + 0.044715f * yy * yy * yy)); } \
                        u32x2 o; o.x = pg8::cvt_pk_bf16(y[0], y[1]); o.y = pg8::cvt_pk_bf16(y[2], y[3]); \
                        *(u32x2*)(gout + tok * DM + ch) = o; } \
                    a0 = (f32x4){0.f, 0.f, 0.f, 0.f}; a1 = (f32x4){0.f, 0.f, 0.f, 0.f}; \
                } \
                *(u32x4*)(atile + (((hs) + 1) & 1) * (16 * 264) + srow * 264 + spc) = RW; \
                LDS_BAR(); } while (0)
            for (int h4 = 0; h4 < 32; h4 += 4) { S5C_STEP(h4, r0, r1); S5C_STEP(h4 + 1, r1, r2); S5C_STEP(h4 + 2, r2, r3); S5C_STEP(h4 + 3, r3, r0); }
#undef S5C_STEP
#undef S5C_SRC
        }
        __syncthreads();
    }
}

#define XB_TMO      128
#define XB_XCNT(j)  (256  + 64 * (j))
#define XB_XSUB(j)  (1280 + 64 * (j))
#define XB_XGEN(j)  (2304 + 64 * (j))
#define XB_TOP      3328
#define XB_TOPGEN   3392
#define XCD_BAR_WORDS 3456
#define XB_SPIN_CAP (1u << 18)
constexpr size_t OFF_BAR = 255 * MiB;
constexpr int LDS_ST_OFF = (int)LDS_BYTES - 16;
__device__ __forceinline__ unsigned xb_ld(unsigned* p)              { return __hip_atomic_load(p, __ATOMIC_RELAXED, __HIP_MEMORY_SCOPE_AGENT); }
__device__ __forceinline__ unsigned xb_add(unsigned* p, unsigned v) { return __hip_atomic_fetch_add(p, v, __ATOMIC_RELAXED, __HIP_MEMORY_SCOPE_AGENT); }
__device__ __forceinline__ unsigned xb_xcc_id() { return (unsigned)__builtin_amdgcn_s_getreg((3 << 11) | 20) & 0xFu; }
#define XB_SPIN(cond, bar) do { unsigned _sp = 0; while (cond) { __builtin_amdgcn_s_sleep(1); \
    if ((++_sp & 255u) == 0u) { if (xb_ld(&(bar)[XB_TMO])) break; if (_sp > XB_SPIN_CAP) { atomicAdd(&(bar)[XB_TMO], 1u); break; } } } } while (0)
struct XcdBarrier { unsigned* bar; unsigned x; volatile PG8_LAS unsigned* st; };
__device__ __forceinline__ XcdBarrier xcd_barrier_post(unsigned* bar, volatile PG8_LAS unsigned* st) {
    XcdBarrier b; b.bar = bar; b.x = xb_xcc_id(); b.st = st;
    if (threadIdx.x == 0) (void)xb_add(&bar[XB_XCNT(b.x)], 1u);
    return b;
}
__device__ __forceinline__ void xcd_barrier_complete(unsigned* bar, unsigned x, unsigned& nloc, unsigned& nx) {
    const unsigned G = gridDim.x * gridDim.y * gridDim.z;
    unsigned sum, cnt, mine, sp = 0u;
    for (;;) {
        sum = 0u; cnt = 0u; mine = 0u;
#pragma unroll
        for (unsigned j = 0; j < 16; ++j) { const unsigned c = xb_ld(&bar[XB_XCNT(j)]); sum += c; cnt += (c > 0u) ? 1u : 0u; mine = (j == x) ? c : mine; }
        if (sum == G) break;
        __builtin_amdgcn_s_sleep(1);
        if ((++sp & 255u) == 0u) { if (xb_ld(&bar[XB_TMO])) break; if (sp > XB_SPIN_CAP) { atomicAdd(&bar[XB_TMO], 1u); break; } }
    }
    nloc = mine > 0u ? mine : 1u; nx = cnt > 0u ? cnt : 1u;
}
__device__ __forceinline__ void xcd_barrier(const XcdBarrier& b) {
    asm volatile("s_waitcnt vmcnt(0)" ::: "memory");
    __syncthreads();
    if (threadIdx.x == 0) {
        unsigned* bar = b.bar;
        __builtin_amdgcn_s_waitcnt(0);
        unsigned nloc = b.st[0], nx = b.st[1];
        if (nloc == 0u) { xcd_barrier_complete(bar, b.x, nloc, nx); b.st[0] = nloc; b.st[1] = nx; }
        const unsigned old = xb_add(&bar[XB_XSUB(b.x)], 1u);
        const unsigned gen = old / nloc;
        if (old + 1u == (gen + 1u) * nloc) {
            __builtin_amdgcn_fence(__ATOMIC_RELEASE, "agent");
            asm volatile("s_waitcnt vmcnt(0)" ::: "memory");
            const unsigned og = xb_add(&bar[XB_TOP], 1u);
            const unsigned tg = og / nx;
            if (og + 1u == (tg + 1u) * nx) xb_add(&bar[XB_TOPGEN], 1u);
            else XB_SPIN(xb_ld(&bar[XB_TOPGEN]) == tg, bar);
            __builtin_amdgcn_fence(__ATOMIC_ACQUIRE, "agent");
            xb_add(&bar[XB_XGEN(b.x)], 1u);
            asm volatile("s_waitcnt vmcnt(0)" ::: "memory");
        } else {
            XB_SPIN(xb_ld(&bar[XB_XGEN(b.x)]) == gen, bar);
            __builtin_amdgcn_fence(__ATOMIC_ACQUIRE, "agent");
            asm volatile("s_waitcnt vmcnt(0)" ::: "memory");
        }
    }
    __syncthreads();
}

constexpr int NPH = 32;
#define PH(k, body) if (lo <= (k) && (k) < hi) { { unsigned char* ws = P.ws; bf16_t* abuf = (bf16_t*)(ws + OFF_ABUF); bf16_t* proj = (bf16_t*)(ws + OFF_R); bf16_t* gbuf = (bf16_t*)(ws + OFF_G); bf16_t* hbuf = (bf16_t*)P.out; (void)abuf; (void)proj; (void)gbuf; (void)hbuf; body; } if ((k) + 1 < hi) xcd_barrier(xbar); }
#ifndef USE_NAIVE_GEMM
#define USE_NAIVE_GEMM 0
#endif
#define GEMM(A_, lda_, B_, ldb_, M_, N_, K_, EPI_, ...) { const GemmArgs g_ = mkgemm(A_, lda_, B_, ldb_, M_, N_, K_, EPI_, __VA_ARGS__); if (USE_NAIVE_GEMM) gemm_naive(g_, (float*)lds); else gemm_pg8<EPI_>((PG8_LAS unsigned char*)lds, g_); }
#define W_UPL ((bf16_t*)(ws + (layer ? W_UP1 : W_UP0)))
#define W_DNL ((bf16_t*)(ws + (layer ? W_DN1 : W_DN0)))
#define W_GTL ((bf16_t*)(ws + (layer ? W_GT1 : W_GT0)))
#define W_PPL ((bf16_t*)(ws + (layer ? W_PP1 : W_PP0)))
#define PPBUF ((bf16_t*)(ws + OFF_R))
#define PBF ((bf16_t*)(ws + OFF_R + 64 * MiB))
__device__ __forceinline__ void ffn_section(const Params& P, const int layer, const int base, const int lo, const int hi, const XcdBarrier& xbar, unsigned char* lds) {
    PH(base + 0, { if (layer == 0) ph_s5_setup(P, lds); ph_norm16(hbuf, P.ffn_norm_w + layer * DM, abuf, nullptr); })
    PH(base + 1, GEMM(abuf, DM, W_UPL, DM, T_TOK, 2816, DM, EPI_BF16, proj, 2816))
    PH(base + 2, ph_ffn_conv(P, layer, 0))
    PH(base + 3, GEMM(abuf, DM, W_UPL + (size_t)2816 * DM, DM, T_TOK, 2816, DM, EPI_BF16, proj, 2816))
    PH(base + 4, GEMM(gbuf, FH, W_DNL, 2816, T_TOK, DM, FH, EPI_RES16, hbuf, DM, (const float*)hbuf))
    PH(base + 5, ph_ffn_conv(P, layer, 1))
    PH(base + 6, GEMM(gbuf, FH, W_DNL + FH, 2816, T_TOK, DM, FH, EPI_RES16, hbuf, DM, (const float*)hbuf))
    PH(base + 7, { ph_norm16(hbuf, P.ple_norm_w + layer * DM, abuf, nullptr); ph_cvt_copy(P.p + (size_t)layer * T_TOK * 256, PBF, (size_t)T_TOK * 256); })
    PH(base + 8, { GEMM(PBF, 256, W_PPL, 256, T_TOK, DM, 256, EPI_BF16, PPBUF, DM) GEMM(abuf, DM, W_GTL, DM, T_TOK, DM, DM, EPI_PLE16, (layer ? gbuf : hbuf), DM, (const float*)hbuf, (const float*)PPBUF) })
}

__global__ void __launch_bounds__(NT, 2) mega(Params P) {
    extern __shared__ __attribute__((aligned(16))) unsigned char lds[];
    cg::grid_group grid = cg::this_grid();
    const int lo = P.ph_lo, hi = P.ph_hi;
    if (lo < 0) grid.sync();
    volatile PG8_LAS unsigned* xst = (volatile PG8_LAS unsigned*)((PG8_LAS unsigned char*)lds + LDS_ST_OFF);
    if (threadIdx.x < 4) xst[threadIdx.x] = 0u;
    __syncthreads();
    const XcdBarrier xbar = xcd_barrier_post((unsigned*)(P.ws + OFF_BAR), xst);
    PH(0, { cvt_weights0(P, (float*)lds); ph_norm(P.x, P.mix_norm_w, abuf, nullptr); })
    PH(1, GEMM(abuf, DM, (bf16_t*)(ws + W_IN) + (size_t)2048 * DM, DM, T_TOK, LDP, DM, EPI_BF16, proj, LDP))
    PH(2, ph_ssd_halo(P))
    PH(3, ph_ssd_bcconv(P, lds))
    PH(4, ph_ssd_scan(P, lds))
    PH(5, GEMM(abuf, DM, (bf16_t*)(ws + W_IN), DM, T_TOK, 2048, DM, EPI_ZGATE, proj, LDP, nullptr, nullptr, (const bf16_t*)(ws + OFF_YF), (const bf16_t*)P.out))
    PH(6, { ph_gn_scale(P); cvt_weights1(P, (float*)lds); })
    PH(7, GEMM(proj, LDP, (bf16_t*)(ws + W_OUT), 2048, T_TOK, DM, 2048, EPI_RESX, hbuf, DM, P.x))
    ffn_section(P, 0, 8, lo, hi, xbar, lds);
    PH(18, ph_norm16(hbuf, P.mix_norm_w + DM, abuf, nullptr))
    PH(19, ph_s5_main(P, lds))
    PH(20, GEMM(gbuf, DM, (bf16_t*)(ws + W_GLU), DM, T_TOK, 2048, DM, EPI_GLU16, hbuf, DM, (const float*)hbuf, nullptr, nullptr, nullptr, P.s5_b_glu))
    ffn_section(P, 1, 21, lo, hi, xbar, lds);
    PH(31, ph_norm16(gbuf, P.final_norm_w, nullptr, P.out))
}

extern "C" void kernel_launch(void* const* d_in, const int* in_sizes, int n_in, void* d_out, int out_size, void* d_ws, size_t ws_size, hipStream_t stream) {
    static int grid_blocks = 0;
    if (!grid_blocks) {
        int dev = 0, cus = 0, per_cu = 0;
        hipGetDevice(&dev);
        hipDeviceGetAttribute(&cus, hipDeviceAttributeMultiprocessorCount, dev);
        hipFuncSetAttribute((const void*)mega, hipFuncAttributeMaxDynamicSharedMemorySize, (int)LDS_BYTES);
        hipOccupancyMaxActiveBlocksPerMultiprocessor(&per_cu, (const void*)mega, NT, LDS_BYTES);
        if (per_cu < 1) per_cu = 1;
        grid_blocks = cus * per_cu;
        if (ws_size < 256 * MiB) fprintf(stderr, "workspace too small: %zu\n", ws_size);
    }
    Params P{};
    const float** pp = (const float**)&P;
    for (int i = 0; i < 30; ++i) pp[i] = (const float*)d_in[i];
    P.out = (float*)d_out; P.ws = (unsigned char*)d_ws;
#if COOP
    (void)hipMemsetAsync((unsigned char*)d_ws + OFF_BAR, 0, XCD_BAR_WORDS * 4, stream);
    P.ph_lo = 0; P.ph_hi = NPH;
    void* args[] = {&P};
    hipError_t e = hipLaunchCooperativeKernel((const void*)mega, dim3(grid_blocks), dim3(NT), args, LDS_BYTES, stream);
    if (e != hipSuccess) fprintf(stderr, "cooperative launch failed: %s (grid %d)\n", hipGetErrorString(e), grid_blocks);
#else
    for (int ph = 0; ph < NPH; ++ph) {
        P.ph_lo = ph; P.ph_hi = ph + 1;
        hipLaunchKernelGGL(mega, dim3(grid_blocks), dim3(NT), LDS_BYTES, stream, P);
    }
#endif
}
```

```cpp
#include <hip/hip_runtime.h>
#include <hip/hip_cooperative_groups.h>
#include <cstdio>
namespace cg = cooperative_groups;

#ifndef COOP
#define COOP 1
#endif

typedef unsigned short bf16_t;
typedef float f32x4 __attribute__((ext_vector_type(4)));
typedef unsigned u32x4 __attribute__((ext_vector_type(4)));
typedef unsigned u32x2 __attribute__((ext_vector_type(2)));

constexpr int NT = 512;
constexpr int T_TOK = 16384, DM = 1024, SEQ = 4096, NB = 4;
constexpr int LDP = 3328;
constexpr int FH = 1408;
constexpr float EPS = 1e-6f;
constexpr size_t MiB = 1u << 20;
constexpr size_t OFF_W0 = 0;
constexpr size_t W_IN = OFF_W0, W_OUT = W_IN + (size_t)5376 * 1024 * 2, W_UP0 = W_OUT + 4 * MiB, W_DN0 = W_UP0 + 11 * MiB, W_GT0 = W_DN0 + (size_t)1024 * 2816 * 2, W_PP0 = W_GT0 + 2 * MiB;
constexpr size_t OFF_ABUF = 34 * MiB;
constexpr size_t OFF_R = 66 * MiB;
constexpr size_t OFF_G = 186 * MiB;
constexpr size_t OFF_W1 = 230 * MiB;
constexpr size_t W_GLU = OFF_W1, W_UP1 = W_GLU + 4 * MiB, W_DN1 = W_UP1 + 11 * MiB, W_GT1 = W_DN1 + (size_t)1024 * 2816 * 2, W_PP1 = W_GT1 + 2 * MiB;
constexpr size_t OFF_YF = 186 * MiB;
constexpr size_t OFF_SMALL = 253 * MiB;
constexpr size_t LDS_BYTES = 160 * 1024;

struct Params {
    const float *x, *p, *ssd_w_in, *ssd_conv_w, *ssd_conv_b, *ssd_dt_bias, *ssd_a_log, *ssd_d, *ssd_norm_w, *ssd_w_out;
    const float *s5_a_re, *s5_a_im, *s5_log_step, *s5_b_re, *s5_b_im, *s5_c_re, *s5_c_im, *s5_d, *s5_w_glu, *s5_b_glu;
    const float *mix_norm_w, *ffn_norm_w, *ffn_w_up, *ffn_conv_w, *ffn_conv_b, *ffn_w_down, *ple_norm_w, *ple_w_gate, *ple_w_proj, *final_norm_w;
    float* out; unsigned char* ws;
    int ph_lo, ph_hi;
};

__device__ __forceinline__ int otid() { int t = (int)__builtin_amdgcn_workitem_id_x(); asm volatile("" : "+v"(t)); return t & (NT - 1); }
__device__ __forceinline__ float bf2f(bf16_t b) { return __uint_as_float(((unsigned)b) << 16); }
__device__ __forceinline__ bf16_t f2bf(float f) { unsigned u = __float_as_uint(f); u += 0x7FFFu + ((u >> 16) & 1u); return (bf16_t)(u >> 16); }
__device__ __forceinline__ unsigned pack2(float lo, float hi) { return (unsigned)f2bf(lo) | ((unsigned)f2bf(hi) << 16); }
__device__ __forceinline__ float siluf(float v) { return v / (1.0f + __expf(-v)); }
__device__ __forceinline__ float sigmf(float v) { return 1.0f / (1.0f + __expf(-v)); }
__device__ __forceinline__ float wave_sum(float v) {
#pragma unroll
    for (int o = 32; o >= 1; o >>= 1) v += __shfl_xor(v, o);
    return v;
}

#define PG8_LAS __attribute__((address_space(3)))
typedef short bf16x8 __attribute__((ext_vector_type(8)));
namespace pg8 {
constexpr int BM = 256, BK = 64, HALF = 128, HTB = HALF * BK * 2, STAGE_BYTES = 8 * HTB, NXCD = 8, WGM = 8;
__device__ __forceinline__ int lds_byte(int r, int c) { const int st = (r >> 4) * 2 + (c >> 5), rr = r & 15, cc = c & 31, ob = rr * 64 + cc * 2; return st * 1024 + (ob ^ (((ob >> 9) & 1) << 5)); }
__device__ __forceinline__ void stage_rc(int b, int& R, int& C) { const int st = b / 1024, sb = b % 1024, swz = sb ^ (((sb >> 9) & 1) << 5); R = (st >> 1) * 16 + swz / 64; C = (st & 1) * 32 + (swz % 64) / 2; }
__device__ __forceinline__ int perm32(int rho) { const int n = rho >> 4, i = rho & 15; return 8 * (i >> 2) + 4 * n + (i & 3); }
struct Unit { int pm, pn; };
struct StaticOrder {
    int nM, nN, nwg, G, c;
    __device__ void init(int M, int N, int G_, int c_) { nM = M / BM; nN = N / BM; nwg = nM * nN; G = G_; c = c_; }
    __device__ bool next(int i, Unit& u) const {
        const long L = (long)i * G + c; if (L >= nwg) return false;
        int wgid = (int)L; { const int q = nwg / NXCD, r = nwg % NXCD, xcd = wgid % NXCD, off = wgid / NXCD; wgid = (xcd < r ? xcd * (q + 1) : r * (q + 1) + (xcd - r) * q) + off; }
        const int nig = WGM * nN, gid = wgid / nig, fm = gid * WGM, gsz = (nM - fm) < WGM ? (nM - fm) : WGM;
        u.pm = fm + ((wgid % nig) % gsz); u.pn = (wgid % nig) / gsz; return true;
    }
};
typedef __bf16 bf16x2_t __attribute__((ext_vector_type(2)));
typedef float f32x2_t __attribute__((ext_vector_type(2)));
__device__ __forceinline__ unsigned cvt_pk_bf16(float lo, float hi) { const f32x2_t v = {lo, hi}; union { bf16x2_t b; unsigned u; } r; r.b = __builtin_convertvector(v, bf16x2_t); return r.u; }
}
__device__ __forceinline__ float fsig(float v) { return __builtin_amdgcn_rcpf(1.0f + __expf(-v)); }
__device__ __forceinline__ void unpack8(const u32x4 v, float (&f)[8]) {
#pragma unroll
    for (int j = 0; j < 4; ++j) { f[2 * j] = __uint_as_float(v[j] << 16); f[2 * j + 1] = __uint_as_float(v[j] & 0xffff0000u); }
}
__device__ __forceinline__ f32x4 bf4lo(unsigned a, unsigned b) { return (f32x4){__uint_as_float(a << 16), __uint_as_float(a & 0xffff0000u), __uint_as_float(b << 16), __uint_as_float(b & 0xffff0000u)}; }

struct WDesc { const float* W; bf16_t* Wt; int K, Nsrc, Ndst, mode, H, ntiles; };
__device__ __forceinline__ void cvt_tile(const WDesc& d, int tile, float* lds) {
    const int tid = threadIdx.x, nnt = d.Ndst / 64;
    const int n0 = (tile % nnt) * 64, k0 = (tile / nnt) * 64;
    int src0;
    if (d.mode == 0) src0 = (n0 < d.Nsrc) ? n0 : -1;
    else { const int pn = n0 / 256, w = n0 % 256; src0 = (w < 128) ? pn * 128 + w : d.H + pn * 128 + (w - 128); }
    __syncthreads();
#pragma unroll
    for (int i = 0; i < 2; ++i) {
        const int r = (tid >> 4) + 32 * i, c4 = (tid & 15) * 4;
        f32x4 v = {0.f, 0.f, 0.f, 0.f};
        if (src0 >= 0) v = *(const f32x4*)(d.W + (size_t)(k0 + r) * d.Nsrc + src0 + c4);
#pragma unroll
        for (int j = 0; j < 4; ++j) lds[r * 65 + c4 + j] = v[j];
    }
    __syncthreads();
    {
        const int nr = tid >> 3, kp = (tid & 7) * 8;
        u32x4 o;
#pragma unroll
        for (int j = 0; j < 4; ++j) o[j] = pg8::cvt_pk_bf16(lds[(kp + 2 * j) * 65 + nr], lds[(kp + 2 * j + 1) * 65 + nr]);
        *(u32x4*)(d.Wt + (size_t)(n0 + nr) * d.K + k0 + kp) = o;
    }
}
__device__ __forceinline__ WDesc mkdesc(const float* W, bf16_t* Wt, int K, int Nsrc, int Ndst, int mode, int H) { WDesc d; d.W = W; d.Wt = Wt; d.K = K; d.Nsrc = Nsrc; d.Ndst = Ndst; d.mode = mode; d.H = H; d.ntiles = (K / 64) * (Ndst / 64); return d; }
#define CVT_ONE(W, Wt, K, Ns, Nd, mode, H) { const int n_ = ((K) / 64) * ((Nd) / 64); if (tt >= 0 && tt < n_) { const WDesc d_ = mkdesc(W, Wt, K, Ns, Nd, mode, H); cvt_tile(d_, tt, lds); } tt -= n_; }
__device__ __forceinline__ void cvt_weights0(const Params& P, float* lds) {
    unsigned char* ws = P.ws;
    for (int t = blockIdx.x; t < 1344 + 512 + 1408 + 704 + 256 + 64; t += gridDim.x) {
        int tt = t;
        CVT_ONE(P.ssd_w_in, (bf16_t*)(ws + W_IN), 1024, 5184, 5376, 0, 0)
        CVT_ONE(P.ssd_w_out, (bf16_t*)(ws + W_OUT), 2048, 1024, 1024, 0, 0)
        CVT_ONE(P.ffn_w_up, (bf16_t*)(ws + W_UP0), 1024, 5632, 5632, 1, 2816)
        CVT_ONE(P.ffn_w_down, (bf16_t*)(ws + W_DN0), 2816, 1024, 1024, 0, 0)
        CVT_ONE(P.ple_w_gate, (bf16_t*)(ws + W_GT0), 1024, 1024, 1024, 0, 0)
        CVT_ONE(P.ple_w_proj, (bf16_t*)(ws + W_PP0), 256, 1024, 1024, 0, 0)
    }
}
__device__ __forceinline__ void cvt_weights1(const Params& P, float* lds) {
    unsigned char* ws = P.ws;
    for (int t = blockIdx.x; t < 512 + 1408 + 704 + 256 + 64; t += gridDim.x) {
        int tt = t;
        CVT_ONE(P.s5_w_glu, (bf16_t*)(ws + W_GLU), 1024, 2048, 2048, 1, 1024)
        CVT_ONE(P.ffn_w_up + (size_t)1024 * 5632, (bf16_t*)(ws + W_UP1), 1024, 5632, 5632, 1, 2816)
        CVT_ONE(P.ffn_w_down + (size_t)2816 * 1024, (bf16_t*)(ws + W_DN1), 2816, 1024, 1024, 0, 0)
        CVT_ONE(P.ple_w_gate + (size_t)1024 * 1024, (bf16_t*)(ws + W_GT1), 1024, 1024, 1024, 0, 0)
        CVT_ONE(P.ple_w_proj + (size_t)256 * 1024, (bf16_t*)(ws + W_PP1), 256, 1024, 1024, 0, 0)
    }
}
__device__ __forceinline__ void ph_norm(const float* src, const float* w, bf16_t* dstb, float* dstf) {
    const int lane = threadIdx.x & 63, wid = threadIdx.x >> 6;
    for (int row = blockIdx.x * 8 + wid; row < T_TOK; row += gridDim.x * 8) {
        const float* s = src + (size_t)row * DM;
        f32x4 v[4]; float ss = 0.f;
#pragma unroll
        for (int i = 0; i < 4; ++i) { v[i] = *(const f32x4*)(s + lane * 4 + 256 * i); ss += v[i][0] * v[i][0] + v[i][1] * v[i][1] + v[i][2] * v[i][2] + v[i][3] * v[i][3]; }
        ss = wave_sum(ss);
        const float rstd = rsqrtf(ss * (1.0f / DM) + EPS);
#pragma unroll
        for (int i = 0; i < 4; ++i) {
            const f32x4 wv = *(const f32x4*)(w + lane * 4 + 256 * i);
            const f32x4 o = v[i] * rstd * wv;
            if (dstb) { u32x2 pk; pk.x = pack2(o[0], o[1]); pk.y = pack2(o[2], o[3]); *(u32x2*)(dstb + (size_t)row * DM + lane * 4 + 256 * i) = pk; }
            else *(f32x4*)(dstf + (size_t)row * DM + lane * 4 + 256 * i) = o;
        }
    }
}
__device__ __forceinline__ void ph_norm16(const bf16_t* src, const float* w, bf16_t* dstb, float* dstf) {
    const int lane = threadIdx.x & 63, wid = threadIdx.x >> 6;
    for (int row = blockIdx.x * 8 + wid; row < T_TOK; row += gridDim.x * 8) {
        const bf16_t* sp = src + (size_t)row * DM;
        float v[2][8]; float ss = 0.f;
#pragma unroll
        for (int i = 0; i < 2; ++i) { unpack8(*(const u32x4*)(sp + lane * 8 + 512 * i), v[i]);
#pragma unroll
            for (int j = 0; j < 8; ++j) ss += v[i][j] * v[i][j]; }
        ss = wave_sum(ss);
        const float rstd = rsqrtf(ss * (1.0f / DM) + EPS);
#pragma unroll
        for (int i = 0; i < 2; ++i) {
            const f32x4 w0 = *(const f32x4*)(w + lane * 8 + 512 * i), w1 = *(const f32x4*)(w + lane * 8 + 512 * i + 4);
            float o[8];
#pragma unroll
            for (int j = 0; j < 4; ++j) { o[j] = v[i][j] * rstd * w0[j]; o[4 + j] = v[i][4 + j] * rstd * w1[j]; }
            if (dstb) { u32x4 pk; pk.x = pg8::cvt_pk_bf16(o[0], o[1]); pk.y = pg8::cvt_pk_bf16(o[2], o[3]); pk.z = pg8::cvt_pk_bf16(o[4], o[5]); pk.w = pg8::cvt_pk_bf16(o[6], o[7]); *(u32x4*)(dstb + (size_t)row * DM + lane * 8 + 512 * i) = pk; }
            else { *(f32x4*)(dstf + (size_t)row * DM + lane * 8 + 512 * i) = (f32x4){o[0], o[1], o[2], o[3]}; *(f32x4*)(dstf + (size_t)row * DM + lane * 8 + 512 * i + 4) = (f32x4){o[4], o[5], o[6], o[7]}; }
        }
    }
}
__device__ __forceinline__ void ph_cvt_copy(const float* src, bf16_t* dst, size_t n) {
    for (size_t i = ((size_t)blockIdx.x * NT + threadIdx.x) * 4; i < n; i += (size_t)gridDim.x * NT * 4) {
        const f32x4 v = *(const f32x4*)(src + i); u32x2 pk; pk.x = pack2(v[0], v[1]); pk.y = pack2(v[2], v[3]); *(u32x2*)(dst + i) = pk;
    }
}

enum { EPI_BF16 = 0, EPI_RES = 1, EPI_F32 = 2, EPI_PLE = 3, EPI_GLU = 4, EPI_ZGATE = 5, EPI_RESX = 6, EPI_RES16 = 7, EPI_PLE16 = 8, EPI_GLU16 = 9 };
struct GemmArgs {
    const bf16_t* A; int lda; const bf16_t* Bt; int ldb; int M, N, K; int epi;
    void* out; int ldc; const float* res; const float* aux; const bf16_t* y1; const bf16_t* y2; const float* bias;
};
__device__ __forceinline__ void epi_store(const GemmArgs& g, int row, int pn, int tc, float acc, float accp) {
    const int col = pn * 256 + tc;
    switch (g.epi) {
        case EPI_BF16: ((bf16_t*)g.out)[(size_t)row * g.ldc + col] = f2bf(acc); break;
        case EPI_RES: { const size_t o = (size_t)row * g.ldc + col; ((float*)g.out)[o] = g.res[o] + acc; } break;
        case EPI_F32: ((float*)g.out)[(size_t)row * g.ldc + col] = acc; break;
        case EPI_PLE: { const size_t o = (size_t)row * g.ldc + col; ((float*)g.out)[o] = g.res[o] + g.aux[o] * sigmf(acc); } break;
        case EPI_GLU: { const int oc = pn * 128 + tc; const size_t o = (size_t)row * g.ldc + oc; ((float*)g.out)[o] = g.res[o] + (acc + g.bias[oc]) * sigmf(accp + g.bias[1024 + oc]); } break;
        case EPI_ZGATE: { const size_t yo = (size_t)row * 2048 + col; ((bf16_t*)g.out)[(size_t)row * g.ldc + col] = f2bf((bf2f(g.y1[yo]) + bf2f(g.y2[yo])) * siluf(acc)); } break;
    }
}
__device__ __forceinline__ void gemm_naive(const GemmArgs& g, float* lds) {
    float* As = lds;
    float* Bs = lds + 32 * 132;
    const int tid = threadIdx.x, ty = tid >> 4, tx = tid & 15;
    const int nM = g.M / 128, nN = g.N / 256;
    for (int tile = blockIdx.x; tile < nM * nN; tile += gridDim.x) {
        const int pm = tile % nM, pn = tile / nM;
        float acc[4][16];
#pragma unroll
        for (int i = 0; i < 4; ++i)
#pragma unroll
            for (int j = 0; j < 16; ++j) acc[i][j] = 0.f;
        for (int k0 = 0; k0 < g.K; k0 += 32) {
            __syncthreads();
            { const int r = tid >> 2, kk = (tid & 3) * 8;
              const u32x4 v = *(const u32x4*)(g.A + (size_t)(pm * 128 + r) * g.lda + k0 + kk);
#pragma unroll
              for (int j = 0; j < 4; ++j) { As[(kk + 2 * j) * 132 + r] = __uint_as_float(v[j] << 16); As[(kk + 2 * j + 1) * 132 + r] = __uint_as_float(v[j] & 0xffff0000u); } }
#pragma unroll
            for (int h = 0; h < 2; ++h) { const int r = (tid >> 2) + 128 * h, kk = (tid & 3) * 8;
              const u32x4 v = *(const u32x4*)(g.Bt + (size_t)(pn * 256 + r) * g.ldb + k0 + kk);
#pragma unroll
              for (int j = 0; j < 4; ++j) { Bs[(kk + 2 * j) * 260 + r] = __uint_as_float(v[j] << 16); Bs[(kk + 2 * j + 1) * 260 + r] = __uint_as_float(v[j] & 0xffff0000u); } }
            __syncthreads();
#pragma unroll 4
            for (int kk = 0; kk < 32; ++kk) {
                const f32x4 a = *(const f32x4*)(As + kk * 132 + ty * 4);
                const f32x4 b0 = *(const f32x4*)(Bs + kk * 260 + tx * 8), b1 = *(const f32x4*)(Bs + kk * 260 + tx * 8 + 4);
                const f32x4 b2 = *(const f32x4*)(Bs + kk * 260 + 128 + tx * 8), b3 = *(const f32x4*)(Bs + kk * 260 + 128 + tx * 8 + 4);
#pragma unroll
                for (int i = 0; i < 4; ++i)
#pragma unroll
                    for (int j = 0; j < 4; ++j) { acc[i][j] += a[i] * b0[j]; acc[i][4 + j] += a[i] * b1[j]; acc[i][8 + j] += a[i] * b2[j]; acc[i][12 + j] += a[i] * b3[j]; }
            }
        }
#pragma unroll
        for (int i = 0; i < 4; ++i) {
            const int row = pm * 128 + ty * 4 + i;
#pragma unroll
            for (int j = 0; j < 8; ++j) {
                if (g.epi == EPI_GLU) epi_store(g, row, pn, tx * 8 + j, acc[i][j], acc[i][8 + j]);
                else { epi_store(g, row, pn, tx * 8 + j, acc[i][j], 0.f); epi_store(g, row, pn, 128 + tx * 8 + j, acc[i][8 + j], 0.f); }
            }
        }
    }
}
__device__ __forceinline__ GemmArgs mkgemm(const bf16_t* A, int lda, const bf16_t* Bt, int ldb, int M, int N, int K, int epi, void* out, int ldc,
                                           const float* res = nullptr, const float* aux = nullptr, const bf16_t* y1 = nullptr, const bf16_t* y2 = nullptr, const float* bias = nullptr) {
    GemmArgs g; g.A = A; g.lda = lda; g.Bt = Bt; g.ldb = ldb; g.M = M; g.N = N; g.K = K; g.epi = epi; g.out = out; g.ldc = ldc; g.res = res; g.aux = aux; g.y1 = y1; g.y2 = y2; g.bias = bias; return g;
}

template <int EPI>
__device__ __forceinline__ void epi_tile(const GemmArgs& g, const f32x4 (&acc)[2][2][4][2], const pg8::Unit& u, int wr, int wc, int fr, int fq) {
    const int row0 = u.pm * 256 + wr * 64 + fr;
    if constexpr (EPI == EPI_RESX || EPI == EPI_RES16 || EPI == EPI_PLE16 || EPI == EPI_GLU16) {
        constexpr int NBJ = (EPI == EPI_GLU16) ? 1 : 2;
        const int col0 = (EPI == EPI_GLU16 ? u.pn * 128 : u.pn * 256) + wc * 32 + 8 * fq;
        f32x4 bv[2] = {{0.f, 0.f, 0.f, 0.f}, {0.f, 0.f, 0.f, 0.f}}, bg[2] = {{0.f, 0.f, 0.f, 0.f}, {0.f, 0.f, 0.f, 0.f}};
        if constexpr (EPI == EPI_GLU16) {
#pragma unroll
            for (int n = 0; n < 2; ++n) { bv[n] = *(const f32x4*)(g.bias + col0 + 4 * n); bg[n] = *(const f32x4*)(g.bias + 1024 + col0 + 4 * n); }
        }
#pragma unroll
        for (int ai = 0; ai < 2; ++ai)
#pragma unroll
            for (int m = 0; m < 4; ++m) {
                const int row = row0 + ai * 128 + m * 16;
#pragma unroll
                for (int bj = 0; bj < NBJ; ++bj) {
                    const size_t o = (size_t)row * g.ldc + col0 + bj * 128;
                    f32x4 r0, r1;
                    if constexpr (EPI == EPI_RESX) { r0 = *(const f32x4*)(g.res + o); r1 = *(const f32x4*)(g.res + o + 4); }
                    else { const u32x4 rr = *(const u32x4*)((const bf16_t*)g.res + o); r0 = bf4lo(rr[0], rr[1]); r1 = bf4lo(rr[2], rr[3]); }
                    f32x4 v0 = acc[ai][bj][m][0], v1 = acc[ai][bj][m][1];
                    if constexpr (EPI == EPI_PLE16) {
                        const u32x4 aa = *(const u32x4*)((const bf16_t*)g.aux + o); const f32x4 a0 = bf4lo(aa[0], aa[1]), a1 = bf4lo(aa[2], aa[3]);
#pragma unroll
                        for (int j = 0; j < 4; ++j) { v0[j] = a0[j] * fsig(v0[j]); v1[j] = a1[j] * fsig(v1[j]); }
                    }
                    if constexpr (EPI == EPI_GLU16) {
                        const f32x4 g0 = acc[ai][1][m][0] + bg[0], g1 = acc[ai][1][m][1] + bg[1];
                        v0 += bv[0]; v1 += bv[1];
#pragma unroll
                        for (int j = 0; j < 4; ++j) { v0[j] *= fsig(g0[j]); v1[j] *= fsig(g1[j]); }
                    }
                    v0 += r0; v1 += r1;
                    u32x4 w; w.x = pg8::cvt_pk_bf16(v0[0], v0[1]); w.y = pg8::cvt_pk_bf16(v0[2], v0[3]); w.z = pg8::cvt_pk_bf16(v1[0], v1[1]); w.w = pg8::cvt_pk_bf16(v1[2], v1[3]);
                    *(u32x4*)((bf16_t*)g.out + o) = w;
                }
                asm volatile("" ::: "memory");
            }
    } else if constexpr (EPI == EPI_BF16 || EPI == EPI_ZGATE) {
        const int col0 = u.pn * 256 + wc * 32 + 8 * fq;
#pragma unroll
        for (int ai = 0; ai < 2; ++ai)
#pragma unroll
            for (int m = 0; m < 4; ++m) {
                const int row = row0 + ai * 128 + m * 16;
#pragma unroll
                for (int bj = 0; bj < 2; ++bj) {
                    f32x4 v0 = acc[ai][bj][m][0], v1 = acc[ai][bj][m][1];
                    const int col = col0 + bj * 128;
                    if constexpr (EPI == EPI_ZGATE) {
                        const u32x4 a = *(const u32x4*)(g.y1 + (size_t)row * 2048 + col), b = *(const u32x4*)(g.y2 + (size_t)row * 2048 + col);
                        const f32x4 y0 = bf4lo(a[0], a[1]) + bf4lo(b[0], b[1]), y1v = bf4lo(a[2], a[3]) + bf4lo(b[2], b[3]);
#pragma unroll
                        for (int j = 0; j < 4; ++j) { v0[j] = y0[j] * v0[j] * fsig(v0[j]); v1[j] = y1v[j] * v1[j] * fsig(v1[j]); }
                    }
                    u32x4 w; w.x = pg8::cvt_pk_bf16(v0[0], v0[1]); w.y = pg8::cvt_pk_bf16(v0[2], v0[3]); w.z = pg8::cvt_pk_bf16(v1[0], v1[1]); w.w = pg8::cvt_pk_bf16(v1[2], v1[3]);
                    *(u32x4*)((bf16_t*)g.out + (size_t)row * g.ldc + col) = w;
                }
                if constexpr (EPI == EPI_ZGATE) asm volatile("" ::: "memory");
            }
    } else if constexpr (EPI == EPI_GLU) {
        const int col0 = u.pn * 128 + wc * 32 + 4 * fq;
        f32x4 bv[2], bg[2];
#pragma unroll
        for (int n = 0; n < 2; ++n) { bv[n] = *(const f32x4*)(g.bias + col0 + 16 * n); bg[n] = *(const f32x4*)(g.bias + 1024 + col0 + 16 * n); }
#pragma unroll
        for (int ai = 0; ai < 2; ++ai)
#pragma unroll
            for (int m = 0; m < 4; ++m) {
                const int row = row0 + ai * 128 + m * 16;
#pragma unroll
                for (int n = 0; n < 2; ++n) {
                    const size_t o = (size_t)row * g.ldc + col0 + 16 * n;
                    const f32x4 r = *(const f32x4*)(g.res + o), v = acc[ai][0][m][n] + bv[n], gt = acc[ai][1][m][n] + bg[n];
                    f32x4 ov;
#pragma unroll
                    for (int j = 0; j < 4; ++j) ov[j] = r[j] + v[j] * fsig(gt[j]);
                    *(f32x4*)((float*)g.out + o) = ov;
                }
                asm volatile("" ::: "memory");
            }
    } else {
        const int col0 = u.pn * 256 + wc * 32 + 4 * fq;
#pragma unroll
        for (int ai = 0; ai < 2; ++ai)
#pragma unroll
            for (int m = 0; m < 4; ++m) {
                const int row = row0 + ai * 128 + m * 16;
#pragma unroll
                for (int bj = 0; bj < 2; ++bj)
#pragma unroll
                    for (int n = 0; n < 2; ++n) {
                        const size_t o = (size_t)row * g.ldc + col0 + bj * 128 + n * 16;
                        f32x4 ov = acc[ai][bj][m][n];
                        if constexpr (EPI == EPI_RES) ov += *(const f32x4*)(g.res + o);
                        if constexpr (EPI == EPI_PLE) { const f32x4 r = *(const f32x4*)(g.res + o), a = *(const f32x4*)(g.aux + o);
#pragma unroll
                            for (int j = 0; j < 4; ++j) ov[j] = r[j] + a[j] * fsig(ov[j]); }
                        *(f32x4*)((float*)g.out + o) = ov;
                    }
                if constexpr (EPI != EPI_F32) asm volatile("" ::: "memory");
            }
    }
}

template <int EPI>
__device__ __forceinline__ void gemm_pg8(PG8_LAS unsigned char* lds, const GemmArgs g) {
    using namespace pg8;
    constexpr bool PERM = (EPI == EPI_BF16 || EPI == EPI_ZGATE || EPI == EPI_RESX || EPI == EPI_RES16 || EPI == EPI_PLE16 || EPI == EPI_GLU16);
    const int tid = otid(), wid = __builtin_amdgcn_readfirstlane(tid >> 6), lane = tid & 63, wr = wid >> 2, wc = wid & 3, fr = lane & 15, fq = lane >> 4;
    const int K = g.K, nt = K / BK;
    StaticOrder S; S.init(g.M, g.N, (int)gridDim.x, (int)blockIdx.x);
    unsigned voffA[2], voffB[2];
#pragma unroll
    for (int i = 0; i < 2; ++i) { int R, C; stage_rc(tid * 16 + i * 8192, R, C); const int Rb = PERM ? ((R & ~31) + perm32(R & 31)) : R;
        voffA[i] = (unsigned)(R * g.lda + C) * 2u; voffB[i] = (unsigned)(Rb * g.ldb + C) * 2u; }
    const size_t kstep = (size_t)(BK * 2);
    const size_t hstepA = (size_t)HALF * g.lda * 2, hstepB = (size_t)HALF * g.ldb * 2;
    const size_t tstepA = 2 * hstepA, tstepB = 2 * hstepB;
    const unsigned ldsw = (unsigned)wid * 1024u;
    const int aoff = lds_byte(wr * 64 + fr, fq * 8), boff = lds_byte(wc * 32 + fr, fq * 8);
#define PG8_SA(b, h) (((b) * 2 + (h)) * HTB)
#define PG8_SB(b, h) ((4 + (b) * 2 + (h)) * HTB)
#define PG8_STAGE(bufoff, gbase, voff) do { _Pragma("unroll") for (int _i = 0; _i < 2; ++_i) \
        __builtin_amdgcn_global_load_lds((const unsigned*)((const char*)(gbase) + (voff)[_i]), (PG8_LAS unsigned*)(lds + (bufoff) + ldsw + _i * 8192), 16, 0, 0); } while (0)
#define PG8_LDA(dst, b, h) do { _Pragma("unroll") for (int m = 0; m < 4; ++m) _Pragma("unroll") for (int k = 0; k < 2; ++k) dst[m][k] = *(const PG8_LAS bf16x8*)(lds + PG8_SA(b, h) + aoff + m * 2048 + k * 1024); } while (0)
#define PG8_LDB(dst, b, h) do { _Pragma("unroll") for (int n = 0; n < 2; ++n) _Pragma("unroll") for (int k = 0; k < 2; ++k) dst[n][k] = *(const PG8_LAS bf16x8*)(lds + PG8_SB(b, h) + boff + n * 2048 + k * 1024); } while (0)
#define PG8_MMA(ai, bj, At, Bt) do { __builtin_amdgcn_s_setprio(1); _Pragma("unroll") for (int m = 0; m < 4; ++m) _Pragma("unroll") for (int n = 0; n < 2; ++n) _Pragma("unroll") for (int k = 0; k < 2; ++k) \
        acc[ai][bj][m][n] = __builtin_amdgcn_mfma_f32_16x16x32_bf16(Bt[n][k], At[m][k], acc[ai][bj][m][n], 0, 0, 0); __builtin_amdgcn_s_setprio(0); } while (0)
#define PG8_WAIT_V(n) asm volatile("s_waitcnt vmcnt(" #n ")" ::: "memory")
#define PG8_WAIT_L(n) asm volatile("s_waitcnt lgkmcnt(" #n ")" ::: "memory")
#define PG8_BAR __builtin_amdgcn_s_barrier()
#define PG8_SCHED __builtin_amdgcn_sched_barrier(0)
    Unit cur, nxt; int ui = 0;
    if (!S.next(0, cur)) return;
    f32x4 acc[2][2][4][2];
#pragma unroll
    for (int a = 0; a < 2; ++a)
#pragma unroll
        for (int b = 0; b < 2; ++b)
#pragma unroll
            for (int m = 0; m < 4; ++m)
#pragma unroll
                for (int n = 0; n < 2; ++n) acc[a][b][m][n] = (f32x4){0.f, 0.f, 0.f, 0.f};
    bf16x8 At[4][2], B0[2][2], B1[2][2];
    const char* cA = (const char*)g.A + (size_t)cur.pm * tstepA; const char* cB = (const char*)g.Bt + (size_t)cur.pn * tstepB;
    PG8_STAGE(PG8_SB(0, 0), cB, voffB); PG8_STAGE(PG8_SA(0, 0), cA, voffA); PG8_STAGE(PG8_SB(0, 1), cB + hstepB, voffB); PG8_STAGE(PG8_SA(0, 1), cA + hstepA, voffA);
    if (wr == 1) PG8_BAR;
    PG8_WAIT_V(4); PG8_BAR;
    PG8_STAGE(PG8_SB(1, 0), cB + kstep, voffB); PG8_STAGE(PG8_SA(1, 0), cA + kstep, voffA); PG8_STAGE(PG8_SB(1, 1), cB + hstepB + kstep, voffB);
    PG8_WAIT_V(6); PG8_BAR;
    for (;;) {
        const bool has_next = S.next(ui + 1, nxt);
        const char* nA = has_next ? (const char*)g.A + (size_t)nxt.pm * tstepA : cA; const char* nB = has_next ? (const char*)g.Bt + (size_t)nxt.pn * tstepB : cB;
        for (int t = 0; t < nt; t += 2) {
            const bool last = (t == nt - 2);
            const char* a1 = cA + (size_t)(t + 1) * kstep;
            const char* a2 = last ? nA : cA + (size_t)(t + 2) * kstep; const char* b2 = last ? nB : cB + (size_t)(t + 2) * kstep;
            const char* a3 = a2 + kstep; const char* b3 = b2 + kstep;
            PG8_LDB(B0, 0, 0); PG8_SCHED; PG8_LDA(At, 0, 0); PG8_STAGE(PG8_SA(1, 1), a1 + hstepA, voffA);
            PG8_WAIT_L(8); PG8_BAR; PG8_WAIT_L(0); PG8_MMA(0, 0, At, B0); PG8_BAR; PG8_SCHED;
            PG8_LDB(B1, 0, 1); PG8_STAGE(PG8_SB(0, 0), b2, voffB);
            PG8_BAR; PG8_WAIT_L(0); PG8_MMA(0, 1, At, B1); PG8_BAR;
            PG8_LDA(At, 0, 1); PG8_STAGE(PG8_SA(0, 0), a2, voffA);
            PG8_BAR; PG8_WAIT_L(0); PG8_MMA(1, 0, At, B0); PG8_BAR; PG8_SCHED;
            PG8_STAGE(PG8_SB(0, 1), b2 + hstepB, voffB);
            PG8_WAIT_V(6); PG8_BAR; PG8_MMA(1, 1, At, B1); PG8_BAR;
            PG8_LDB(B0, 1, 0); PG8_SCHED; PG8_LDA(At, 1, 0); PG8_STAGE(PG8_SA(0, 1), a2 + hstepA, voffA);
            PG8_WAIT_L(8); PG8_BAR; PG8_WAIT_L(0); PG8_MMA(0, 0, At, B0); PG8_BAR; PG8_SCHED;
            PG8_LDB(B1, 1, 1); PG8_STAGE(PG8_SB(1, 0), b3, voffB);
            PG8_BAR; PG8_WAIT_L(0); PG8_MMA(0, 1, At, B1); PG8_BAR;
            PG8_LDA(At, 1, 1); PG8_STAGE(PG8_SA(1, 0), a3, voffA);
            PG8_BAR; PG8_WAIT_L(0); PG8_MMA(1, 0, At, B0); PG8_BAR; PG8_SCHED;
            PG8_STAGE(PG8_SB(1, 1), b3 + hstepB, voffB);
            PG8_WAIT_V(6); PG8_BAR; PG8_MMA(1, 1, At, B1); PG8_BAR;
        }
        epi_tile<EPI>(g, acc, cur, wr, wc, fr, fq);
        if (!has_next) break;
#pragma unroll
        for (int a = 0; a < 2; ++a)
#pragma unroll
            for (int b = 0; b < 2; ++b)
#pragma unroll
                for (int m = 0; m < 4; ++m)
#pragma unroll
                    for (int n = 0; n < 2; ++n) acc[a][b][m][n] = (f32x4){0.f, 0.f, 0.f, 0.f};
        cur = nxt; cA = nA; cB = nB; ++ui;
    }
    PG8_WAIT_V(0);
    if (wr == 0) PG8_BAR;
    PG8_BAR;
#undef PG8_SA
#undef PG8_SB
#undef PG8_STAGE
#undef PG8_LDA
#undef PG8_LDB
#undef PG8_MMA
#undef PG8_WAIT_V
#undef PG8_WAIT_L
#undef PG8_BAR
#undef PG8_SCHED
}

__device__ __forceinline__ void ph_ssd_halo(const Params& P) {
    bf16_t* proj = (bf16_t*)(P.ws + OFF_R); bf16_t* halo = (bf16_t*)(P.ws + OFF_SMALL);
    const int gt = blockIdx.x * NT + threadIdx.x, gs = gridDim.x * NT;
    for (int i = gt; i < 512 * 4 * 256; i += gs) {
        const int ch = i & 255, hr = (i >> 8) & 3, item = i >> 10;
        const int g = item & 3, c = (item >> 2) & 31, b = item >> 7;
        const int lt = c * 128 + (hr < 2 ? hr - 2 : 126 + hr);
        const int col = 2048 + (ch >> 7) * 512 + g * 128 + (ch & 127);
        bf16_t v = 0;
        if (lt >= 0 && lt < SEQ) v = proj[(size_t)(b * SEQ + lt) * LDP + col];
        halo[i] = v;
    }
    for (int i = gt; i < T_TOK * 64; i += gs) {
        const int j = i & 63, t = i >> 6;
        const float xr = bf2f(proj[(size_t)t * LDP + 3072 + j]) + P.ssd_dt_bias[j];
        const float sp = fmaxf(xr, 0.f) + log1pf(__expf(-fabsf(xr)));
        ((float*)(proj + (size_t)t * LDP + 3136))[j] = sp;
    }
}
constexpr size_t OFF_CB = OFF_R + 104 * MiB;
__device__ __forceinline__ void ph_ssd_bcconv(const Params& P, unsigned char* ldsraw) {
    bf16_t* proj = (bf16_t*)(P.ws + OFF_R); const bf16_t* halo = (const bf16_t*)(P.ws + OFF_SMALL); bf16_t* CBg = (bf16_t*)(P.ws + OFF_CB);
    bf16_t* tile = (bf16_t*)ldsraw;
    bf16_t* cv = tile + 132 * 256;
    const int tid = threadIdx.x, lane = tid & 63, wid = tid >> 6, fr = lane & 15, q = lane >> 4;
    for (int item = blockIdx.x; item < 512; item += gridDim.x) {
        const int g = item & 3, c = (item >> 2) & 31, b = item >> 7;
        const size_t r0 = (size_t)b * SEQ + c * 128;
        __syncthreads();
        for (int i = tid; i < 132 * 32; i += NT) {
            const int co = i & 31, r = i >> 5, ch = co * 8;
            const int col = 2048 + (ch >> 7) * 512 + g * 128 + (ch & 127);
            u32x4 v;
            if (r < 2) v = *(const u32x4*)(halo + (size_t)item * 1024 + r * 256 + ch);
            else if (r >= 130) v = *(const u32x4*)(halo + (size_t)item * 1024 + (r - 128) * 256 + ch);
            else v = *(const u32x4*)(proj + (r0 + r - 2) * LDP + col);
            *(u32x4*)(tile + r * 256 + ch) = v;
        }
        __syncthreads();
        for (int i = tid; i < 128 * 32; i += NT) {
            const int co = i & 31, r = i >> 5, ch = co * 8;
            const int col = 2048 + (ch >> 7) * 512 + g * 128 + (ch & 127);
            float acc[8];
            { const f32x4 b0 = *(const f32x4*)(P.ssd_conv_b + col), b1 = *(const f32x4*)(P.ssd_conv_b + col + 4);
#pragma unroll
              for (int j = 0; j < 4; ++j) { acc[j] = b0[j]; acc[4 + j] = b1[j]; } }
#pragma unroll
            for (int k = 0; k < 5; ++k) {
                float xv[8]; unpack8(*(const u32x4*)(tile + (r + k) * 256 + ch), xv);
                const f32x4 w0 = *(const f32x4*)(P.ssd_conv_w + k * 3072 + col), w1 = *(const f32x4*)(P.ssd_conv_w + k * 3072 + col + 4);
#pragma unroll
                for (int j = 0; j < 4; ++j) { acc[j] += xv[j] * w0[j]; acc[4 + j] += xv[4 + j] * w1[j]; }
            }
            u32x4 o;
#pragma unroll
            for (int j = 0; j < 4; ++j) o[j] = pg8::cvt_pk_bf16(acc[2 * j] * fsig(acc[2 * j]), acc[2 * j + 1] * fsig(acc[2 * j + 1]));
            *(u32x4*)(cv + r * 264 + ch) = o;
            if (ch >= 128) *(u32x4*)(proj + (r0 + r) * LDP + col) = o;
        }
        __syncthreads();
        for (int i = tid; i < 2048; i += NT) {
            const int n = i >> 4, to = (i & 15) * 8; u32x4 o;
#pragma unroll
            for (int j = 0; j < 4; ++j) o[j] = (unsigned)cv[(to + 2 * j) * 264 + n] | ((unsigned)cv[(to + 2 * j + 1) * 264 + n] << 16);
            *(u32x4*)(proj + (r0 + n) * LDP + 2048 + g * 128 + to) = o;
        }
        bf16x8 af[4];
#pragma unroll
        for (int ks = 0; ks < 4; ++ks) af[ks] = *(const bf16x8*)(cv + (16 * wid + fr) * 264 + 32 * ks + 8 * q);
        bf16_t* cbo = CBg + (size_t)item * 16384;
#pragma unroll
        for (int lt = 0; lt < 8; ++lt) {
            f32x4 acc = {0.f, 0.f, 0.f, 0.f};
#pragma unroll
            for (int ks = 0; ks < 4; ++ks) { const bf16x8 bfr = *(const bf16x8*)(cv + (16 * lt + fr) * 264 + 128 + 32 * ks + 8 * q); acc = __builtin_amdgcn_mfma_f32_16x16x32_bf16(af[ks], bfr, acc, 0, 0, 0); }
            u32x2 o; o.x = pg8::cvt_pk_bf16(acc[0], acc[1]); o.y = pg8::cvt_pk_bf16(acc[2], acc[3]);
            *(u32x2*)(cbo + (16 * lt + fr) * 128 + 16 * wid + 4 * q) = o;
        }
    }
}
__device__ __forceinline__ void ph_ssd_scan_naive(const Params& P, unsigned char* ldsraw) {
    const bf16_t* proj = (const bf16_t*)(P.ws + OFF_R);
    bf16_t* Bs = (bf16_t*)ldsraw;
    bf16_t* Cs = Bs + 64 * 128;
    float* xs = (float*)(Cs + 64 * 128);
    float* dts = xs + 64 * 64;
    const int tid = threadIdx.x, p = tid >> 3, ng = tid & 7;
    for (int item = blockIdx.x; item < 256; item += gridDim.x) {
        const int d = item & 1, hh = (item >> 1) & 31, b = item >> 6, g = hh >> 3;
        const float a = -__expf(P.ssd_a_log[d * 32 + hh]), dsk = P.ssd_d[hh];
        bf16_t* Y = d ? (bf16_t*)P.out : (bf16_t*)(P.ws + OFF_YF);
        float h[16];
#pragma unroll
        for (int j = 0; j < 16; ++j) h[j] = 0.f;
        for (int blk = 0; blk < SEQ / 64; ++blk) {
            __syncthreads();
            for (int i = tid; i < 64 * 128; i += NT) {
                const int n = i & 127, r = i >> 7; const int lt = d ? SEQ - 1 - (blk * 64 + r) : blk * 64 + r;
                const size_t ro = (size_t)(b * SEQ + lt) * LDP;
                Bs[i] = proj[(size_t)(b * SEQ + (lt & ~127) + n) * LDP + 2048 + g * 128 + (lt & 127)]; Cs[i] = proj[ro + 2560 + g * 128 + n];
            }
            for (int i = tid; i < 64 * 64; i += NT) {
                const int pp = i & 63, r = i >> 6; const int lt = d ? SEQ - 1 - (blk * 64 + r) : blk * 64 + r;
                const int col = hh * 64 + pp;
                float acc = P.ssd_conv_b[col];
#pragma unroll
                for (int k = 0; k < 5; ++k) { const int l2 = lt + k - 2; if (l2 >= 0 && l2 < SEQ) acc += bf2f(proj[(size_t)(b * SEQ + l2) * LDP + col]) * P.ssd_conv_w[k * 3072 + col]; }
                xs[i] = siluf(acc);
            }
            if (tid < 64) { const int lt = d ? SEQ - 1 - (blk * 64 + tid) : blk * 64 + tid; dts[tid] = ((const float*)(proj + (size_t)(b * SEQ + lt) * LDP + 3136))[d * 32 + hh]; }
            __syncthreads();
            for (int r = 0; r < 64; ++r) {
                const float dt = dts[r], xv = xs[r * 64 + p], dA = __expf(dt * a), dx = dt * xv;
                float part = 0.f;
#pragma unroll
                for (int j = 0; j < 16; ++j) { h[j] = h[j] * dA + dx * bf2f(Bs[r * 128 + ng * 16 + j]); part += bf2f(Cs[r * 128 + ng * 16 + j]) * h[j]; }
                part += __shfl_xor(part, 1); part += __shfl_xor(part, 2); part += __shfl_xor(part, 4);
                if (ng == 0) { const int lt = d ? SEQ - 1 - (blk * 64 + r) : blk * 64 + r; Y[(size_t)(b * SEQ + lt) * 2048 + hh * 64 + p] = f2bf(part + (d == 0 ? dsk * xv : 0.f)); }
            }
        }
    }
}
#define LDS_BAR() do { asm volatile("s_waitcnt lgkmcnt(0)" ::: "memory"); __builtin_amdgcn_s_barrier(); asm volatile("" ::: "memory"); } while (0)
__device__ __forceinline__ void ph_ssd_scan(const Params& P, unsigned char* ldsraw) {
    const bf16_t* proj = (const bf16_t*)(P.ws + OFF_R); const bf16_t* CBg = (const bf16_t*)(P.ws + OFF_CB);
    bf16_t* xdT = (bf16_t*)ldsraw;
    bf16_t* xdwT = xdT + 64 * 144;
    bf16_t* stb = xdwT + 64 * 144;
    bf16_t* xraw = stb + 64 * 144;
    float* cs = (float*)(xraw + 132 * 72);
    float* dts = cs + 128;
    float* tot = dts + 128;
    float* cwl = tot + 4;
    float* csA = cwl + 384;
    float* dtsA = csA + 32 * 128;
    float* totA = dtsA + 32 * 128;
    const int tid = threadIdx.x, lane = tid & 63, wid = tid >> 6, fr = lane & 15, q = lane >> 4;
    const int ltile = (wid < 4) ? wid : 11 - wid;
    for (int item = blockIdx.x; item < 256; item += gridDim.x) {
        const int d = item & 1, hh = (item >> 1) & 31, b = item >> 6, g = hh >> 3;
        const float a = -__expf(P.ssd_a_log[d * 32 + hh]), dsk = P.ssd_d[hh];
        bf16_t* Y = d ? (bf16_t*)P.out : (bf16_t*)(P.ws + OFF_YF);
        __syncthreads();
        for (int i = tid; i < 384; i += NT) cwl[i] = (i < 320) ? P.ssd_conv_w[(i >> 6) * 3072 + hh * 64 + (i & 63)] : P.ssd_conv_b[hh * 64 + i - 320];
        for (int k4 = 0; k4 < 4; ++k4) {
            const int cc = wid + 8 * k4; const size_t t0_ = (size_t)b * SEQ + cc * 128;
            const float dta = ((const float*)(proj + (t0_ + 2 * lane) * LDP + 3136))[d * 32 + hh], dtb = ((const float*)(proj + (t0_ + 2 * lane + 1) * LDP + 3136))[d * 32 + hh];
            const float ad0 = dta * a * 1.4426950408889634f, ad1 = dtb * a * 1.4426950408889634f, v = ad0 + ad1; float inc = v;
#pragma unroll
            for (int o = 1; o < 64; o <<= 1) { const float t = __shfl_up(inc, o); if (lane >= o) inc += t; }
            const float excl = inc - v, totl = __shfl(inc, 63);
            if (d == 0) { csA[cc * 128 + 2 * lane] = excl + ad0; csA[cc * 128 + 2 * lane + 1] = inc; } else { csA[cc * 128 + 2 * lane] = totl - excl; csA[cc * 128 + 2 * lane + 1] = totl - excl - ad0; }
            dtsA[cc * 128 + 2 * lane] = dta; dtsA[cc * 128 + 2 * lane + 1] = dtb; if (lane == 0) totA[cc] = totl;
        }
        f32x4 st[4];
#pragma unroll
        for (int pt = 0; pt < 4; ++pt) st[pt] = (f32x4){0.f, 0.f, 0.f, 0.f};
        u32x4 xp[3]; u32x4 cbv[4]; bf16x8 cmf[4], btf[4];
        const int whs = __builtin_amdgcn_readfirstlane(ltile) >> 1;
#pragma unroll
        for (int k0_ = 0; k0_ < 4; ++k0_) cbv[k0_] = (u32x4){0u, 0u, 0u, 0u};
#define SCAN_LOAD_A(cc) do { const size_t t0_ = (size_t)b * SEQ + (cc) * 128; \
            _Pragma("unroll") for (int e_ = 0; e_ < 3; ++e_) { const int i_ = tid + e_ * NT; const int r_ = i_ >> 3, pc_ = (i_ & 7) * 8; const int lt_ = (cc) * 128 + r_ - 2; \
                xp[e_] = (u32x4){0u, 0u, 0u, 0u}; if (i_ < 132 * 8 && lt_ >= 0 && lt_ < SEQ) xp[e_] = *(const u32x4*)(proj + ((size_t)b * SEQ + lt_) * LDP + hh * 64 + pc_); } } while (0)
#define SCAN_LOAD_C(cc) do { const size_t t0_ = (size_t)b * SEQ + (cc) * 128; const int l_ = 16 * ltile + fr, n_ = 16 * wid + fr; \
            const bf16_t* cbrow_ = CBg + (size_t)((b * 32 + (cc)) * 4 + g) * 16384 + l_ * 128 + 8 * q; const bf16_t* cmrow_ = proj + (t0_ + l_) * LDP + 2560 + g * 128 + 8 * q; \
            const bf16_t* btrow_ = proj + (t0_ + n_) * LDP + 2048 + g * 128 + 8 * q; \
            _Pragma("unroll") for (int ks_ = 0; ks_ < 4; ++ks_) { if (d ? (ks_ >= whs) : (ks_ <= whs)) cbv[ks_] = *(const u32x4*)(cbrow_ + 32 * ks_); cmf[ks_] = *(const bf16x8*)(cmrow_ + 32 * ks_); btf[ks_] = *(const bf16x8*)(btrow_ + 32 * ks_); } } while (0)
#define SCAN_CH(i_) (d ? 31 - ((i_) < 31 ? (i_) : 31) : ((i_) < 31 ? (i_) : 31))
#define SCAN_XRAW_WRITE() do { _Pragma("unroll") for (int e = 0; e < 3; ++e) { const int i = tid + e * NT; if (i < 132 * 8) *(u32x4*)(xraw + (i >> 3) * 72 + (i & 7) * 8) = xp[e]; } } while (0)
        { const int c0_ = SCAN_CH(0), c1_ = SCAN_CH(1); SCAN_LOAD_A(c0_); SCAN_LOAD_C(c0_); SCAN_XRAW_WRITE(); SCAN_LOAD_A(c1_); }
        __syncthreads();
        for (int ci = 0; ci < 32; ++ci) {
            const int c = d ? 31 - ci : ci; const size_t tok0 = (size_t)b * SEQ + c * 128;
            const int cn = SCAN_CH(ci + 1), cnn = SCAN_CH(ci + 2);
            const float* cs = csA + c * 128; const float* dts = dtsA + c * 128;
#pragma unroll
            for (int pt = 0; pt < 4; ++pt) { u32x2 o; o.x = pg8::cvt_pk_bf16(st[pt][0], st[pt][1]); o.y = pg8::cvt_pk_bf16(st[pt][2], st[pt][3]); *(u32x2*)(stb + (16 * pt + fr) * 144 + 16 * wid + 4 * q) = o; }
            const float total = totA[c];
            {
                const int tp = tid & 63, oc = (tid >> 6) * 8;
                float w5[5][8], accA[8], accB[8];
#pragma unroll
                for (int k = 0; k < 5; ++k) { const f32x4 w0 = *(const f32x4*)(cwl + k * 64 + oc), w1 = *(const f32x4*)(cwl + k * 64 + oc + 4);
#pragma unroll
                    for (int j = 0; j < 4; ++j) { w5[k][j] = w0[j]; w5[k][4 + j] = w1[j]; } }
                { const f32x4 b0 = *(const f32x4*)(cwl + 320 + oc), b1 = *(const f32x4*)(cwl + 320 + oc + 4);
#pragma unroll
                  for (int j = 0; j < 4; ++j) { accA[j] = b0[j]; accA[4 + j] = b1[j]; accB[j] = b0[j]; accB[4 + j] = b1[j]; } }
#pragma unroll
                for (int k = 0; k < 6; ++k) {
                    float xr[8]; unpack8(*(const u32x4*)(xraw + (2 * tp + k) * 72 + oc), xr);
#pragma unroll
                    for (int j = 0; j < 8; ++j) { if (k < 5) accA[j] += xr[j] * w5[k < 5 ? k : 0][j]; if (k > 0) accB[j] += xr[j] * w5[k > 0 ? k - 1 : 0][j]; }
                }
                const float dtA = dts[2 * tp], dtB = dts[2 * tp + 1], wA = __builtin_amdgcn_exp2f(total - cs[2 * tp]), wB = __builtin_amdgcn_exp2f(total - cs[2 * tp + 1]);
#pragma unroll
                for (int j = 0; j < 8; ++j) {
                    const float xa = accA[j] * fsig(accA[j]) * dtA, xb_ = accB[j] * fsig(accB[j]) * dtB;
                    ((unsigned*)(xdT + (oc + j) * 144))[tp] = pg8::cvt_pk_bf16(xa, xb_);
                    ((unsigned*)(xdwT + (oc + j) * 144))[tp] = pg8::cvt_pk_bf16(xa * wA, xb_ * wB);
                }
            }
            LDS_BAR();
            {
                int l = 16 * ltile + fr; asm volatile("" : "+v"(l));
                const float csl = cs[l], el = __builtin_amdgcn_exp2f(csl), ddt = dsk * __builtin_amdgcn_rcpf(dts[l]);
                f32x4 y2[4], y3[4];
#pragma unroll
                for (int pt = 0; pt < 4; ++pt) { y2[pt] = (f32x4){0.f, 0.f, 0.f, 0.f}; y3[pt] = (f32x4){0.f, 0.f, 0.f, 0.f}; }
                const int whalf = __builtin_amdgcn_readfirstlane(ltile) >> 1;
#pragma unroll
                for (int ks = 0; ks < 4; ++ks) {
                  if (d ? (ks >= whalf) : (ks <= whalf)) {
                    const f32x4 c0 = *(const f32x4*)(cs + 32 * ks + 8 * q), c1 = *(const f32x4*)(cs + 32 * ks + 8 * q + 4);
                    float gv[8];
#pragma unroll
                    for (int j = 0; j < 8; ++j) {
                        const int sx = 32 * ks + 8 * q + j; const float cb = (j & 1) ? __uint_as_float(cbv[ks][j >> 1] & 0xffff0000u) : __uint_as_float(cbv[ks][j >> 1] << 16);
                        const float css = (j < 4) ? c0[j & 3] : c1[j & 3];
                        float val = cb * __builtin_amdgcn_exp2f(csl - css);
                        if (ks == whalf) {
                            const bool keep = d ? (sx >= l) : (sx <= l);
                            val = keep ? val : 0.f;
                            if (d == 0 && sx == l) val += ddt;
                        }
                        gv[j] = val;
                    }
                    union { u32x4 u; bf16x8 h; } gf; gf.u = (u32x4){pg8::cvt_pk_bf16(gv[0], gv[1]), pg8::cvt_pk_bf16(gv[2], gv[3]), pg8::cvt_pk_bf16(gv[4], gv[5]), pg8::cvt_pk_bf16(gv[6], gv[7])};
#pragma unroll
                    for (int pt = 0; pt < 4; ++pt) { const bf16x8 xf = *(const bf16x8*)(xdT + (16 * pt + fr) * 144 + 32 * ks + 8 * q); y2[pt] = __builtin_amdgcn_mfma_f32_16x16x32_bf16(xf, gf.h, y2[pt], 0, 0, 0); }
                  }
#pragma unroll
                    for (int pt = 0; pt < 4; ++pt) { const bf16x8 sf = *(const bf16x8*)(stb + (16 * pt + fr) * 144 + 32 * ks + 8 * q); y3[pt] = __builtin_amdgcn_mfma_f32_16x16x32_bf16(sf, cmf[ks], y3[pt], 0, 0, 0); }
                }
#pragma unroll
                for (int pt = 0; pt < 4; ++pt) {
                    const f32x4 v = y2[pt] + el * y3[pt]; u32x2 o; o.x = pg8::cvt_pk_bf16(v[0], v[1]); o.y = pg8::cvt_pk_bf16(v[2], v[3]);
                    *(u32x2*)(Y + (tok0 + l) * 2048 + hh * 64 + 16 * pt + 4 * q) = o;
                }
                const float etot = __builtin_amdgcn_exp2f(total);
#pragma unroll
                for (int pt = 0; pt < 4; ++pt) st[pt] *= etot;
#pragma unroll
                for (int ks = 0; ks < 4; ++ks) {
#pragma unroll
                    for (int pt = 0; pt < 4; ++pt) { const bf16x8 xf = *(const bf16x8*)(xdwT + (16 * pt + fr) * 144 + 32 * ks + 8 * q); st[pt] = __builtin_amdgcn_mfma_f32_16x16x32_bf16(btf[ks], xf, st[pt], 0, 0, 0); }
                }
            }
            SCAN_LOAD_C(cn);
            SCAN_XRAW_WRITE();
            SCAN_LOAD_A(cnn);
            LDS_BAR();
        }
#undef SCAN_LOAD_A
#undef SCAN_CH
#undef SCAN_XRAW_WRITE
#undef SCAN_LOAD_C
    }
}
__device__ __forceinline__ void ph_gn_scale(const Params& P) {
    bf16_t* proj = (bf16_t*)(P.ws + OFF_R);
    const int lane = threadIdx.x & 63, wid = threadIdx.x >> 6;
    for (int it = blockIdx.x * 8 + wid; it < T_TOK * 4; it += gridDim.x * 8) {
        const int row = it >> 2, grp = it & 3;
        bf16_t* ptr = proj + (size_t)row * LDP + grp * 512 + lane * 8;
        const u32x4 v = *(const u32x4*)ptr; float f[8]; float ss = 0.f;
#pragma unroll
        for (int j = 0; j < 4; ++j) { f[2 * j] = __uint_as_float(v[j] << 16); f[2 * j + 1] = __uint_as_float(v[j] & 0xffff0000u); ss += f[2 * j] * f[2 * j] + f[2 * j + 1] * f[2 * j + 1]; }
        ss = wave_sum(ss);
        const float rstd = rsqrtf(ss * (1.0f / 512.f) + EPS);
        const float* w = P.ssd_norm_w + grp * 512 + lane * 8; u32x4 o;
#pragma unroll
        for (int j = 0; j < 4; ++j) o[j] = pack2(f[2 * j] * rstd * w[2 * j], f[2 * j + 1] * rstd * w[2 * j + 1]);
        *(u32x4*)ptr = o;
    }
}
__device__ __forceinline__ void ph_ffn_conv(const Params& P, int layer, int half) {
    const bf16_t* hup = (const bf16_t*)(P.ws + OFF_R); bf16_t* gout = (bf16_t*)(P.ws + OFF_G);
    const float* cw = P.ffn_conv_w + (size_t)layer * 3 * 5632; const float* cb = P.ffn_conv_b + (size_t)layer * 5632;
    for (int it = blockIdx.x * NT + threadIdx.x; it < (T_TOK / 16) * (FH / 8); it += gridDim.x * NT) {
        const int oc = (it % (FH / 8)) * 8, t0 = (it / (FH / 8)) * 16, lt0 = t0 & (SEQ - 1);
        const int pn = oc >> 7, w = oc & 127, gcol = pn * 256 + w, vcol = gcol + 128;
        const int gch = half * FH + oc, vch = 2816 + gch;
        float wg[3][8], wv[3][8], bg[8], bv[8];
#pragma unroll
        for (int k = 0; k < 3; ++k) {
            const f32x4 a0 = *(const f32x4*)(cw + k * 5632 + gch), a1 = *(const f32x4*)(cw + k * 5632 + gch + 4), c0 = *(const f32x4*)(cw + k * 5632 + vch), c1 = *(const f32x4*)(cw + k * 5632 + vch + 4);
#pragma unroll
            for (int j = 0; j < 4; ++j) { wg[k][j] = a0[j]; wg[k][4 + j] = a1[j]; wv[k][j] = c0[j]; wv[k][4 + j] = c1[j]; }
        }
        { const f32x4 a0 = *(const f32x4*)(cb + gch), a1 = *(const f32x4*)(cb + gch + 4), c0 = *(const f32x4*)(cb + vch), c1 = *(const f32x4*)(cb + vch + 4);
#pragma unroll
          for (int j = 0; j < 4; ++j) { bg[j] = a0[j]; bg[4 + j] = a1[j]; bv[j] = c0[j]; bv[4 + j] = c1[j]; } }
        const bf16_t* base = hup + (size_t)t0 * 2816;
        float gp[8], vp[8], gc[8], vc[8];
        const u32x4 z4 = {0u, 0u, 0u, 0u};
        unpack8(lt0 > 0 ? *(const u32x4*)(base - 2816 + gcol) : z4, gp); unpack8(lt0 > 0 ? *(const u32x4*)(base - 2816 + vcol) : z4, vp);
        unpack8(*(const u32x4*)(base + gcol), gc); unpack8(*(const u32x4*)(base + vcol), vc);
#pragma unroll
        for (int i = 0; i < 16; ++i) {
            float gn[8], vn[8];
            const bool has = (lt0 + i + 1 < SEQ);
            unpack8(has ? *(const u32x4*)(base + (size_t)(i + 1) * 2816 + gcol) : z4, gn); unpack8(has ? *(const u32x4*)(base + (size_t)(i + 1) * 2816 + vcol) : z4, vn);
            u32x4 o;
#pragma unroll
            for (int j = 0; j < 4; ++j) {
                const float g0 = bg[2 * j] + wg[0][2 * j] * gp[2 * j] + wg[1][2 * j] * gc[2 * j] + wg[2][2 * j] * gn[2 * j];
                const float g1 = bg[2 * j + 1] + wg[0][2 * j + 1] * gp[2 * j + 1] + wg[1][2 * j + 1] * gc[2 * j + 1] + wg[2][2 * j + 1] * gn[2 * j + 1];
                const float v0 = bv[2 * j] + wv[0][2 * j] * vp[2 * j] + wv[1][2 * j] * vc[2 * j] + wv[2][2 * j] * vn[2 * j];
                const float v1 = bv[2 * j + 1] + wv[0][2 * j + 1] * vp[2 * j + 1] + wv[1][2 * j + 1] * vc[2 * j + 1] + wv[2][2 * j + 1] * vn[2 * j + 1];
                o[j] = pg8::cvt_pk_bf16(g0 * fsig(g0) * v0, g1 * fsig(g1) * v1);
            }
            *(u32x4*)(gout + (size_t)(t0 + i) * FH + oc) = o;
#pragma unroll
            for (int j = 0; j < 8; ++j) { gp[j] = gc[j]; vp[j] = vc[j]; gc[j] = gn[j]; vc[j] = vn[j]; }
        }
    }
}
__device__ __forceinline__ void ph_s5_naive(const Params& P) {
    const bf16_t* u = (const bf16_t*)(P.ws + OFF_ABUF); float* scr = (float*)(P.ws + OFF_R); bf16_t* gout = (bf16_t*)(P.ws + OFF_G);
    const int lane = threadIdx.x & 63, wid = threadIdx.x >> 6;
    for (int item = blockIdx.x + gridDim.x * wid; item < 256; item += gridDim.x * 8) {
        const int g = item & 63, b = item >> 6;
        for (int d = 0; d < 2; ++d) {
            const float lr = P.s5_a_re[(d * 64 + g) * 64 + lane], li = P.s5_a_im[(d * 64 + g) * 64 + lane];
            const float step = expf(P.s5_log_step[d * 64 + g]);
            const float mag = expf(lr * step), ang = li * step;
            const double angd = (double)ang, two_pi = 6.283185307179586476925;
            const float angr = (float)(angd - two_pi * rint(angd / two_pi));
            const float lbr = mag * cosf(angr), lbi = mag * sinf(angr);
            const float nr = lbr - 1.0f, den = lr * lr + li * li;
            const float qr = (nr * lr + lbi * li) / den, qi = (lbi * lr - nr * li) / den;
            float Br[16], Bi[16], Cr[16], Ci[16];
#pragma unroll
            for (int h = 0; h < 16; ++h) {
                const float br = P.s5_b_re[(g * 64 + lane) * 16 + h], bi = P.s5_b_im[(g * 64 + lane) * 16 + h];
                Br[h] = qr * br - qi * bi; Bi[h] = qr * bi + qi * br;
                Cr[h] = P.s5_c_re[((d * 64 + g) * 16 + h) * 64 + lane]; Ci[h] = P.s5_c_im[((d * 64 + g) * 16 + h) * 64 + lane];
            }
            float hr = 0.f, hi = 0.f;
            for (int s = 0; s < SEQ; ++s) {
                const int lt = d ? SEQ - 1 - s : s; const size_t tok = (size_t)b * SEQ + lt;
                const float uv = bf2f(u[tok * DM + g * 16 + (lane & 15)]);
                float dr = 0.f, di = 0.f;
#pragma unroll
                for (int h = 0; h < 16; ++h) { const float uh = __shfl(uv, h); dr += Br[h] * uh; di += Bi[h] * uh; }
                const float nhr = lbr * hr - lbi * hi + dr, nhi = lbr * hi + lbi * hr + di; hr = nhr; hi = nhi;
                float yv = 0.f;
#pragma unroll
                for (int h = 0; h < 16; ++h) { const float s1 = wave_sum(hr * Cr[h] - hi * Ci[h]); if ((lane & 15) == h) yv = s1; }
                if (lane < 16) {
                    if (d == 0) scr[tok * DM + g * 16 + lane] = yv;
                    else { const float y = scr[tok * DM + g * 16 + lane] + yv + P.s5_d[g * 16 + lane] * uv;
                           const float ge = 0.5f * y * (1.0f + tanhf(0.7978845608028654f * (y + 0.044715f * y * y * y)));
                           gout[tok * DM + g * 16 + lane] = f2bf(ge); }
                }
            }
        }
    }
}

constexpr size_t OFF_S5M = OFF_R + 96 * MiB;
__device__ __forceinline__ void s5_lambda(const Params& P, int d, int g, int p, float& lbr, float& lbi, float& qr, float& qi) {
    const float lr = P.s5_a_re[(d * 64 + g) * 64 + p], li = P.s5_a_im[(d * 64 + g) * 64 + p];
    const float step = expf(P.s5_log_step[d * 64 + g]);
    const float mag = expf(lr * step), ang = li * step;
    const double angd = (double)ang, two_pi = 6.283185307179586476925;
    const float angr = (float)(angd - two_pi * rint(angd / two_pi));
    lbr = mag * cosf(angr); lbi = mag * sinf(angr);
    const float nr = lbr - 1.0f, den = lr * lr + li * li;
    qr = (nr * lr + lbi * li) / den; qi = (lbi * lr - nr * li) / den;
}
__device__ __forceinline__ void ph_s5_setup(const Params& P, unsigned char* ldsraw) {
    float* pw = (float*)ldsraw;
    float* Bb = pw + 2 * 17 * 64 * 2;
    float* Cc = Bb + 2 * 64 * 16 * 2;
    float* Kt = Cc + 2 * 16 * 64 * 2;
    const int tid = threadIdx.x;
    for (int item = blockIdx.x; item < 256; item += gridDim.x) {
        const int g = item >> 2, part = item & 3;
        bf16_t* A1 = (bf16_t*)(P.ws + OFF_S5M) + (size_t)g * (65536 + 131072); bf16_t* A2 = A1 + 65536;
        __syncthreads();
        if (tid < 128) {
            const int d = tid >> 6, p = tid & 63; float lbr, lbi, qr, qi; s5_lambda(P, d, g, p, lbr, lbi, qr, qi);
            float pr = 1.f, pi = 0.f;
            for (int j = 0; j <= 16; ++j) { pw[((d * 17 + j) * 64 + p) * 2] = pr; pw[((d * 17 + j) * 64 + p) * 2 + 1] = pi; const float t = pr * lbr - pi * lbi; pi = pr * lbi + pi * lbr; pr = t; }
            for (int h = 0; h < 16; ++h) {
                const float br = P.s5_b_re[(g * 64 + p) * 16 + h], bi = P.s5_b_im[(g * 64 + p) * 16 + h];
                Bb[((d * 64 + p) * 16 + h) * 2] = qr * br - qi * bi; Bb[((d * 64 + p) * 16 + h) * 2 + 1] = qr * bi + qi * br;
                Cc[((d * 16 + h) * 64 + p) * 2] = P.s5_c_re[((d * 64 + g) * 16 + h) * 64 + p]; Cc[((d * 16 + h) * 64 + p) * 2 + 1] = P.s5_c_im[((d * 64 + g) * 16 + h) * 64 + p];
            }
        }
        __syncthreads();
        for (int i = tid; i < 16384; i += NT) {
            const int k = i & 255, R = 64 * part + (i >> 8), sx = k >> 4, hp = k & 15, d = R >> 7, ri = (R >> 6) & 1, p = R & 63;
            const int e = d ? sx : 15 - sx;
            const float pr = pw[((d * 17 + e) * 64 + p) * 2], pi = pw[((d * 17 + e) * 64 + p) * 2 + 1], br = Bb[((d * 64 + p) * 16 + hp) * 2], bi = Bb[((d * 64 + p) * 16 + hp) * 2 + 1];
            A1[(size_t)R * 256 + k] = f2bf(ri ? (pr * bi + pi * br) : (pr * br - pi * bi));
        }
        for (int i = tid; i < 2048; i += NT) {
            const int hp = i & 15, hl = (i >> 4) & 3, j = (i >> 6) & 15, d = i >> 10, h = 4 * part + hl;
            float acc = 0.f;
            for (int p = 0; p < 64; ++p) {
                const float pr = pw[((d * 17 + j) * 64 + p) * 2], pi = pw[((d * 17 + j) * 64 + p) * 2 + 1], br = Bb[((d * 64 + p) * 16 + hp) * 2], bi = Bb[((d * 64 + p) * 16 + hp) * 2 + 1];
                const float er = pr * br - pi * bi, ei = pr * bi + pi * br;
                acc += Cc[((d * 16 + h) * 64 + p) * 2] * er - Cc[((d * 16 + h) * 64 + p) * 2 + 1] * ei;
            }
            Kt[i] = acc;
        }
        __syncthreads();
        for (int i = tid; i < 16384; i += NT) {
            const int k = i & 255, rr = i >> 8, tau = rr >> 2, hl = rr & 3, h = 4 * part + hl, row = tau * 16 + h, sx = k >> 4, hp = k & 15;
            float v = 0.f;
            if (sx <= tau) v += Kt[(((tau - sx)) * 4 + hl) * 16 + hp];
            if (sx >= tau) v += Kt[((16 + sx - tau) * 4 + hl) * 16 + hp];
            if (sx == tau && hp == h) v += P.s5_d[g * 16 + h];
            A2[(size_t)row * 512 + k] = f2bf(v);
        }
        for (int i = tid; i < 16384; i += NT) {
            const int kk = i & 255, rr = i >> 8, tau = rr >> 2, h = 4 * part + (rr & 3), row = tau * 16 + h, d = kk >> 7, ri = kk & 1, p = (kk >> 1) & 63;
            const int e = d ? 16 - tau : tau + 1;
            const float pr = pw[((d * 17 + e) * 64 + p) * 2], pi = pw[((d * 17 + e) * 64 + p) * 2 + 1], cr = Cc[((d * 16 + h) * 64 + p) * 2], ci = Cc[((d * 16 + h) * 64 + p) * 2 + 1];
            A2[(size_t)row * 512 + 256 + kk] = f2bf(ri ? -(cr * pi + ci * pr) : (cr * pr - ci * pi));
        }
    }
}
__device__ __forceinline__ void ph_s5_main(const Params& P, unsigned char* ldsraw) {
    const bf16_t* u = (const bf16_t*)(P.ws + OFF_ABUF); float* scr = (float*)(P.ws + OFF_R); bf16_t* gout = (bf16_t*)(P.ws + OFF_G);
    bf16_t* Sc = (bf16_t*)ldsraw;
    float* tbuf = (float*)(ldsraw + 256 * 272 * 2);
    bf16_t* atile = (bf16_t*)(ldsraw + 256 * 272 * 2);
    const int tid = threadIdx.x, lane = tid & 63, wid = tid >> 6, fr = lane & 15, q = lane >> 4;
    for (int item = blockIdx.x; item < 256; item += gridDim.x) {
        const int g = (item & 7) + 8 * (item >> 5), b = (item >> 3) & 3;
        const bf16_t* A1 = (const bf16_t*)(P.ws + OFF_S5M) + (size_t)g * (65536 + 131072); const bf16_t* A2 = A1 + 65536;
        float* sl = scr + (size_t)item * 65536;
        bf16x8 uf[2][8];
#pragma unroll
        for (int ct = 0; ct < 2; ++ct)
#pragma unroll
            for (int ks = 0; ks < 8; ++ks) {
                const int c = 32 * wid + 16 * ct + fr; const size_t tok = (size_t)b * SEQ + c * 16 + 2 * ks + (q >> 1);
                uf[ct][ks] = *(const bf16x8*)(u + tok * DM + g * 16 + 8 * (q & 1));
            }
        {
            const int srow = tid >> 5, spc = (tid & 31) * 8;
            *(u32x4*)(atile + srow * 272 + spc) = *(const u32x4*)(A1 + (size_t)srow * 256 + spc);
            u32x4 r0, r1 = *(const u32x4*)(A1 + (size_t)(16 + srow) * 256 + spc), r2 = *(const u32x4*)(A1 + (size_t)(32 + srow) * 256 + spc), r3 = *(const u32x4*)(A1 + (size_t)(48 + srow) * 256 + spc);
            __syncthreads();
#define S5A_STEP(Rt, RL, RW) do { \
                RL = *(const u32x4*)(A1 + (size_t)((((Rt) + 4) & 15) * 16 + srow) * 256 + spc); \
                const bf16_t* at = atile + ((Rt) & 1) * (16 * 272) + fr * 272 + 8 * q; \
                f32x4 a0 = {0.f, 0.f, 0.f, 0.f}, a1 = {0.f, 0.f, 0.f, 0.f}; \
                _Pragma("unroll") for (int ks = 0; ks < 8; ++ks) { const bf16x8 af = *(const bf16x8*)(at + ks * 32); \
                    a0 = __builtin_amdgcn_mfma_f32_16x16x32_bf16(af, uf[0][ks], a0, 0, 0, 0); a1 = __builtin_amdgcn_mfma_f32_16x16x32_bf16(af, uf[1][ks], a1, 0, 0, 0); } \
                *(f32x4*)(sl + (size_t)(32 * wid + fr) * 256 + (Rt) * 16 + 4 * q) = a0; \
                *(f32x4*)(sl + (size_t)(32 * wid + 16 + fr) * 256 + (Rt) * 16 + 4 * q) = a1; \
                *(u32x4*)(atile + (((Rt) + 1) & 1) * (16 * 272) + srow * 272 + spc) = RW; \
                LDS_BAR(); } while (0)
            for (int R4 = 0; R4 < 16; R4 += 4) { S5A_STEP(R4, r0, r1); S5A_STEP(R4 + 1, r1, r2); S5A_STEP(R4 + 2, r2, r3); S5A_STEP(R4 + 3, r3, r0); }
#undef S5A_STEP
        }
        asm volatile("s_waitcnt vmcnt(0)" ::: "memory");
        __syncthreads();
        {
            float L0r, L0i, L1r, L1i, qr_, qi_;
            s5_lambda(P, 0, g, lane, L0r, L0i, qr_, qi_); s5_lambda(P, 1, g, lane, L1r, L1i, qr_, qi_);
#pragma unroll
            for (int i = 0; i < 4; ++i) { float t = L0r * L0r - L0i * L0i; L0i = 2.f * L0r * L0i; L0r = t; t = L1r * L1r - L1i * L1i; L1i = 2.f * L1r * L1i; L1r = t; }
            float h0r = 0.f, h0i = 0.f, h1r = 0.f, h1i = 0.f;
            for (int j0 = 0; j0 < 32; j0 += 8) {
                float x0r[8], x0i[8], x1r[8], x1i[8];
#pragma unroll
                for (int i = 0; i < 8; ++i) { const int j = 32 * wid + j0 + i, c0 = j, c1 = 255 - j;
                    x0r[i] = sl[(size_t)c0 * 256 + lane]; x0i[i] = sl[(size_t)c0 * 256 + 64 + lane]; x1r[i] = sl[(size_t)c1 * 256 + 128 + lane]; x1i[i] = sl[(size_t)c1 * 256 + 192 + lane]; }
#pragma unroll
                for (int i = 0; i < 8; ++i) { float t = L0r * h0r - L0i * h0i + x0r[i]; h0i = L0r * h0i + L0i * h0r + x0i[i]; h0r = t; t = L1r * h1r - L1i * h1i + x1r[i]; h1i = L1r * h1i + L1i * h1r + x1i[i]; h1r = t; }
            }
            *(f32x4*)(tbuf + ((wid * 64 + lane) * 4)) = (f32x4){h0r, h0i, h1r, h1i};
            __syncthreads();
            float P0r = L0r, P0i = L0i, P1r = L1r, P1i = L1i;
#pragma unroll
            for (int i = 0; i < 5; ++i) { float t = P0r * P0r - P0i * P0i; P0i = 2.f * P0r * P0i; P0r = t; t = P1r * P1r - P1i * P1i; P1i = 2.f * P1r * P1i; P1r = t; }
            h0r = 0.f; h0i = 0.f; h1r = 0.f; h1i = 0.f;
            for (int w2 = 0; w2 < wid; ++w2) { const f32x4 tv = *(const f32x4*)(tbuf + ((w2 * 64 + lane) * 4));
                float t = P0r * h0r - P0i * h0i + tv[0]; h0i = P0r * h0i + P0i * h0r + tv[1]; h0r = t; t = P1r * h1r - P1i * h1i + tv[2]; h1i = P1r * h1i + P1i * h1r + tv[3]; h1r = t; }
            for (int j0 = 0; j0 < 32; j0 += 8) {
                float x0r[8], x0i[8], x1r[8], x1i[8];
#pragma unroll
                for (int i = 0; i < 8; ++i) { const int j = 32 * wid + j0 + i, c0 = j, c1 = 255 - j;
                    x0r[i] = sl[(size_t)c0 * 256 + lane]; x0i[i] = sl[(size_t)c0 * 256 + 64 + lane]; x1r[i] = sl[(size_t)c1 * 256 + 128 + lane]; x1i[i] = sl[(size_t)c1 * 256 + 192 + lane]; }
#pragma unroll
                for (int i = 0; i < 8; ++i) { const int j = 32 * wid + j0 + i, c0 = j, c1 = 255 - j;
                    ((unsigned*)(Sc + c0 * 272))[lane] = pg8::cvt_pk_bf16(h0r, h0i); ((unsigned*)(Sc + c1 * 272 + 128))[lane] = pg8::cvt_pk_bf16(h1r, h1i);
                    float t = L0r * h0r - L0i * h0i + x0r[i]; h0i = L0r * h0i + L0i * h0r + x0i[i]; h0r = t; t = L1r * h1r - L1i * h1i + x1r[i]; h1i = L1r * h1i + L1i * h1r + x1i[i]; h1r = t; }
            }
        }
        __syncthreads();
        {
            const int srow = tid >> 5, spc = (tid & 31) * 8;
#define S5C_SRC(h) (A2 + (size_t)((((h) & 31) >> 1) * 16 + srow) * 512 + ((h) & 1) * 256 + spc)
            *(u32x4*)(atile + srow * 272 + spc) = *(const u32x4*)S5C_SRC(0);
            u32x4 r0, r1 = *(const u32x4*)S5C_SRC(1), r2 = *(const u32x4*)S5C_SRC(2), r3 = *(const u32x4*)S5C_SRC(3);
            __syncthreads();
            f32x4 a0 = {0.f, 0.f, 0.f, 0.f}, a1 = {0.f, 0.f, 0.f, 0.f};
#define S5C_STEP(hs, RL, RW) do { \
                RL = *(const u32x4*)S5C_SRC((hs) + 4); \
                const bf16_t* at = atile + ((hs) & 1) * (16 * 272) + fr * 272 + 8 * q; \
                if (((hs) & 1) == 0) { \
                    _Pragma("unroll") for (int ks = 0; ks < 8; ++ks) { const bf16x8 af = *(const bf16x8*)(at + ks * 32); \
                        a0 = __builtin_amdgcn_mfma_f32_16x16x32_bf16(af, uf[0][ks], a0, 0, 0, 0); a1 = __builtin_amdgcn_mfma_f32_16x16x32_bf16(af, uf[1][ks], a1, 0, 0, 0); } \
                } else { \
                    _Pragma("unroll") for (int ks = 0; ks < 8; ++ks) { const bf16x8 af = *(const bf16x8*)(at + ks * 32); \
                        const bf16x8 b0 = *(const bf16x8*)(Sc + (32 * wid + fr) * 272 + ks * 32 + 8 * q), b1 = *(const bf16x8*)(Sc + (32 * wid + 16 + fr) * 272 + ks * 32 + 8 * q); \
                        a0 = __builtin_amdgcn_mfma_f32_16x16x32_bf16(af, b0, a0, 0, 0, 0); a1 = __builtin_amdgcn_mfma_f32_16x16x32_bf16(af, b1, a1, 0, 0, 0); } \
                    const int ch = g * 16 + 4 * q, rt = (hs) >> 1; \
                    _Pragma("unroll") for (int ct = 0; ct < 2; ++ct) { \
                        const int c = 32 * wid + 16 * ct + fr; const size_t tok = (size_t)b * SEQ + c * 16 + rt; \
                        const f32x4 av = ct ? a1 : a0; float y[4]; \
                        _Pragma("unroll") for (int r = 0; r < 4; ++r) { const float yy = av[r]; y[r] = yy * fsig(1.5957691216057308f * (yy + 0.044715f * yy * yy * yy)); } \
                        u32x2 o; o.x = pg8::cvt_pk_bf16(y[0], y[1]); o.y = pg8::cvt_pk_bf16(y[2], y[3]); \
                        *(u32x2*)(gout + tok * DM + ch) = o; } \
                    a0 = (f32x4){0.f, 0.f, 0.f, 0.f}; a1 = (f32x4){0.f, 0.f, 0.f, 0.f}; \
                } \
                *(u32x4*)(atile + (((hs) + 1) & 1) * (16 * 272) + srow * 272 + spc) = RW; \
                LDS_BAR(); } while (0)
            for (int h4 = 0; h4 < 32; h4 += 4) { S5C_STEP(h4, r0, r1); S5C_STEP(h4 + 1, r1, r2); S5C_STEP(h4 + 2, r2, r3); S5C_STEP(h4 + 3, r3, r0); }
#undef S5C_STEP
#undef S5C_SRC
        }
        __syncthreads();
    }
}

#define XB_TMO      128
#define XB_XCNT(j)  (256  + 64 * (j))
#define XB_XSUB(j)  (1280 + 64 * (j))
#define XB_XGEN(j)  (2304 + 64 * (j))
#define XB_TOP      3328
#define XB_TOPGEN   3392
#define XCD_BAR_WORDS 3456
#define XB_SPIN_CAP (1u << 18)
constexpr size_t OFF_BAR = 255 * MiB;
constexpr int LDS_ST_OFF = (int)LDS_BYTES - 16;
__device__ __forceinline__ unsigned xb_ld(unsigned* p)              { return __hip_atomic_load(p, __ATOMIC_RELAXED, __HIP_MEMORY_SCOPE_AGENT); }
__device__ __forceinline__ unsigned xb_add(unsigned* p, unsigned v) { return __hip_atomic_fetch_add(p, v, __ATOMIC_RELAXED, __HIP_MEMORY_SCOPE_AGENT); }
__device__ __forceinline__ unsigned xb_xcc_id() { return (unsigned)__builtin_amdgcn_s_getreg((3 << 11) | 20) & 0xFu; }
#define XB_SPIN(cond, bar) do { unsigned _sp = 0; while (cond) { __builtin_amdgcn_s_sleep(1); \
    if ((++_sp & 255u) == 0u) { if (xb_ld(&(bar)[XB_TMO])) break; if (_sp > XB_SPIN_CAP) { atomicAdd(&(bar)[XB_TMO], 1u); break; } } } } while (0)
struct XcdBarrier { unsigned* bar; unsigned x; volatile PG8_LAS unsigned* st; };
__device__ __forceinline__ XcdBarrier xcd_barrier_post(unsigned* bar, volatile PG8_LAS unsigned* st) {
    XcdBarrier b; b.bar = bar; b.x = xb_xcc_id(); b.st = st;
    if (threadIdx.x == 0) (void)xb_add(&bar[XB_XCNT(b.x)], 1u);
    return b;
}
__device__ __forceinline__ void xcd_barrier_complete(unsigned* bar, unsigned x, unsigned& nloc, unsigned& nx) {
    const unsigned G = gridDim.x * gridDim.y * gridDim.z;
    unsigned sum, cnt, mine, sp = 0u;
    for (;;) {
        sum = 0u; cnt = 0u; mine = 0u;
#pragma unroll
        for (unsigned j = 0; j < 16; ++j) { const unsigned c = xb_ld(&bar[XB_XCNT(j)]); sum += c; cnt += (c > 0u) ? 1u : 0u; mine = (j == x) ? c : mine; }
        if (sum == G) break;
        __builtin_amdgcn_s_sleep(1);
        if ((++sp & 255u) == 0u) { if (xb_ld(&bar[XB_TMO])) break; if (sp > XB_SPIN_CAP) { atomicAdd(&bar[XB_TMO], 1u); break; } }
    }
    nloc = mine > 0u ? mine : 1u; nx = cnt > 0u ? cnt : 1u;
}
__device__ __forceinline__ void xcd_barrier(const XcdBarrier& b) {
    asm volatile("s_waitcnt vmcnt(0)" ::: "memory");
    __syncthreads();
    if (threadIdx.x == 0) {
        unsigned* bar = b.bar;
        __builtin_amdgcn_s_waitcnt(0);
        unsigned nloc = b.st[0], nx = b.st[1];
        if (nloc == 0u) { xcd_barrier_complete(bar, b.x, nloc, nx); b.st[0] = nloc; b.st[1] = nx; }
        const unsigned old = xb_add(&bar[XB_XSUB(b.x)], 1u);
        const unsigned gen = old / nloc;
        if (old + 1u == (gen + 1u) * nloc) {
            __builtin_amdgcn_fence(__ATOMIC_RELEASE, "agent");
            asm volatile("s_waitcnt vmcnt(0)" ::: "memory");
            const unsigned og = xb_add(&bar[XB_TOP], 1u);
            const unsigned tg = og / nx;
            if (og + 1u == (tg + 1u) * nx) xb_add(&bar[XB_TOPGEN], 1u);
            else XB_SPIN(xb_ld(&bar[XB_TOPGEN]) == tg, bar);
            __builtin_amdgcn_fence(__ATOMIC_ACQUIRE, "agent");
            xb_add(&bar[XB_XGEN(b.x)], 1u);
            asm volatile("s_waitcnt vmcnt(0)" ::: "memory");
        } else {
            XB_SPIN(xb_ld(&bar[XB_XGEN(b.x)]) == gen, bar);
            __builtin_amdgcn_fence(__ATOMIC_ACQUIRE, "agent");
            asm volatile("s_waitcnt vmcnt(0)" ::: "memory");
        }
    }
    __syncthreads();
}

constexpr int NPH = 32;
#define PH(k, body) if (lo <= (k) && (k) < hi) { { unsigned char* ws = P.ws; bf16_t* abuf = (bf16_t*)(ws + OFF_ABUF); bf16_t* proj = (bf16_t*)(ws + OFF_R); bf16_t* gbuf = (bf16_t*)(ws + OFF_G); bf16_t* hbuf = (bf16_t*)P.out; (void)abuf; (void)proj; (void)gbuf; (void)hbuf; body; } if ((k) + 1 < hi) xcd_barrier(xbar); }
#ifndef USE_NAIVE_GEMM
#define USE_NAIVE_GEMM 0
#endif
#define GEMM(A_, lda_, B_, ldb_, M_, N_, K_, EPI_, ...) { const GemmArgs g_ = mkgemm(A_, lda_, B_, ldb_, M_, N_, K_, EPI_, __VA_ARGS__); if (USE_NAIVE_GEMM) gemm_naive(g_, (float*)lds); else gemm_pg8<EPI_>((PG8_LAS unsigned char*)lds, g_); }
#define W_UPL ((bf16_t*)(ws + (layer ? W_UP1 : W_UP0)))
#define W_DNL ((bf16_t*)(ws + (layer ? W_DN1 : W_DN0)))
#define W_GTL ((bf16_t*)(ws + (layer ? W_GT1 : W_GT0)))
#define W_PPL ((bf16_t*)(ws + (layer ? W_PP1 : W_PP0)))
#define PPBUF ((bf16_t*)(ws + OFF_R))
#define PBF ((bf16_t*)(ws + OFF_R + 64 * MiB))
__device__ __forceinline__ void ffn_section(const Params& P, const int layer, const int base, const int lo, const int hi, const XcdBarrier& xbar, unsigned char* lds) {
    PH(base + 0, { if (layer == 0) ph_s5_setup(P, lds); ph_norm16(hbuf, P.ffn_norm_w + layer * DM, abuf, nullptr); })
    PH(base + 1, GEMM(abuf, DM, W_UPL, DM, T_TOK, 2816, DM, EPI_BF16, proj, 2816))
    PH(base + 2, ph_ffn_conv(P, layer, 0))
    PH(base + 3, GEMM(abuf, DM, W_UPL + (size_t)2816 * DM, DM, T_TOK, 2816, DM, EPI_BF16, proj, 2816))
    PH(base + 4, GEMM(gbuf, FH, W_DNL, 2816, T_TOK, DM, FH, EPI_RES16, hbuf, DM, (const float*)hbuf))
    PH(base + 5, ph_ffn_conv(P, layer, 1))
    PH(base + 6, GEMM(gbuf, FH, W_DNL + FH, 2816, T_TOK, DM, FH, EPI_RES16, hbuf, DM, (const float*)hbuf))
    PH(base + 7, { ph_norm16(hbuf, P.ple_norm_w + layer * DM, abuf, nullptr); ph_cvt_copy(P.p + (size_t)layer * T_TOK * 256, PBF, (size_t)T_TOK * 256); })
    PH(base + 8, { GEMM(PBF, 256, W_PPL, 256, T_TOK, DM, 256, EPI_BF16, PPBUF, DM) GEMM(abuf, DM, W_GTL, DM, T_TOK, DM, DM, EPI_PLE16, (layer ? gbuf : hbuf), DM, (const float*)hbuf, (const float*)PPBUF) })
}

__global__ void __launch_bounds__(NT, 2) mega(Params P) {
    extern __shared__ __attribute__((aligned(16))) unsigned char lds[];
    cg::grid_group grid = cg::this_grid();
    const int lo = P.ph_lo, hi = P.ph_hi;
    if (lo < 0) grid.sync();
    volatile PG8_LAS unsigned* xst = (volatile PG8_LAS unsigned*)((PG8_LAS unsigned char*)lds + LDS_ST_OFF);
    if (threadIdx.x < 4) xst[threadIdx.x] = 0u;
    __syncthreads();
    const XcdBarrier xbar = xcd_barrier_post((unsigned*)(P.ws + OFF_BAR), xst);
    PH(0, { cvt_weights0(P, (float*)lds); ph_norm(P.x, P.mix_norm_w, abuf, nullptr); })
    PH(1, GEMM(abuf, DM, (bf16_t*)(ws + W_IN) + (size_t)2048 * DM, DM, T_TOK, LDP, DM, EPI_BF16, proj, LDP))
    PH(2, ph_ssd_halo(P))
    PH(3, ph_ssd_bcconv(P, lds))
    PH(4, ph_ssd_scan(P, lds))
    PH(5, GEMM(abuf, DM, (bf16_t*)(ws + W_IN), DM, T_TOK, 2048, DM, EPI_ZGATE, proj, LDP, nullptr, nullptr, (const bf16_t*)(ws + OFF_YF), (const bf16_t*)P.out))
    PH(6, { ph_gn_scale(P); cvt_weights1(P, (float*)lds); })
    PH(7, GEMM(proj, LDP, (bf16_t*)(ws + W_OUT), 2048, T_TOK, DM, 2048, EPI_RESX, hbuf, DM, P.x))
    ffn_section(P, 0, 8, lo, hi, xbar, lds);
    PH(18, ph_norm16(hbuf, P.mix_norm_w + DM, abuf, nullptr))
    PH(19, ph_s5_main(P, lds))
    PH(20, GEMM(gbuf, DM, (bf16_t*)(ws + W_GLU), DM, T_TOK, 2048, DM, EPI_GLU16, hbuf, DM, (const float*)hbuf, nullptr, nullptr, nullptr, P.s5_b_glu))
    ffn_section(P, 1, 21, lo, hi, xbar, lds);
    PH(31, ph_norm16(gbuf, P.final_norm_w, nullptr, P.out))
}

extern "C" void kernel_launch(void* const* d_in, const int* in_sizes, int n_in, void* d_out, int out_size, void* d_ws, size_t ws_size, hipStream_t stream) {
    static int grid_blocks = 0;
    if (!grid_blocks) {
        int dev = 0, cus = 0, per_cu = 0;
        hipGetDevice(&dev);
        hipDeviceGetAttribute(&cus, hipDeviceAttributeMultiprocessorCount, dev);
        hipFuncSetAttribute((const void*)mega, hipFuncAttributeMaxDynamicSharedMemorySize, (int)LDS_BYTES);
        hipOccupancyMaxActiveBlocksPerMultiprocessor(&per_cu, (const void*)mega, NT, LDS_BYTES);
        if (per_cu < 1) per_cu = 1;
        grid_blocks = cus * per_cu;
        if (ws_size < 256 * MiB) fprintf(stderr, "workspace too small: %zu\n", ws_size);
    }
    Params P{};
    const float** pp = (const float**)&P;
    for (int i = 0; i < 30; ++i) pp[i] = (const float*)d_in[i];
    P.out = (float*)d_out; P.ws = (unsigned char*)d_ws;
#if COOP
    (void)hipMemsetAsync((unsigned char*)d_ws + OFF_BAR, 0, XCD_BAR_WORDS * 4, stream);
    P.ph_lo = 0; P.ph_hi = NPH;
    void* args[] = {&P};
    hipError_t e = hipLaunchCooperativeKernel((const void*)mega, dim3(grid_blocks), dim3(NT), args, LDS_BYTES, stream);
    if (e != hipSuccess) fprintf(stderr, "cooperative launch failed: %s (grid %d)\n", hipGetErrorString(e), grid_blocks);
#else
    for (int ph = 0; ph < NPH; ++ph) {
        P.ph_lo = ph; P.ph_hi = ph + 1;
        hipLaunchKernelGGL(mega, dim3(grid_blocks), dim3(NT), LDS_BYTES, stream, P);
    }
#endif
}
```
